# Optimizing an MI355X kernel written in HIP

```python
import jax, jax.numpy as jnp
from jax import lax
import numpy as np

D_MODEL = 1024
BATCH = 4
SEQ = 8192
DEPTH = 2

GRID_W = 64
CTX_LEN = 256
EPS = 1e-6
D_FF = 2816
LRU_WIDTH = 512
LRU_HEADS = 8
LRU_HEAD_DIM = LRU_WIDTH // LRU_HEADS
CONV_WIDTH = 4
CONV_LEFT = 2
RG_C = 8.0
MLP_GROUPS = 4
MLP_GROUP_DIM = 128
MLP_WIDTH = MLP_GROUPS * MLP_GROUP_DIM
CHUNK = 128
ROWS_PER_CHUNK = CHUNK // GRID_W
MIX_WIDTH = LRU_WIDTH + MLP_WIDTH
IN_PROJ_WIDTH = 2 * LRU_WIDTH + 2 * MLP_WIDTH
N_MOD = 9

kernel_name = "hybrid_rglru_chunkmlp_macaron_dit"


def rmsnorm(x, g):
    x32 = x.astype(jnp.float32)
    y = x32 * lax.rsqrt(jnp.mean(x32 * x32, axis=-1, keepdims=True) + EPS)
    return (y * g.astype(jnp.float32)).astype(x.dtype)


def layernorm(x, g):
    x32 = x.astype(jnp.float32)
    mu = jnp.mean(x32, axis=-1, keepdims=True)
    xc = x32 - mu
    y = xc * lax.rsqrt(jnp.mean(xc * xc, axis=-1, keepdims=True) + EPS)
    return (y * g.astype(jnp.float32)).astype(x.dtype)


def modulate(z, shift, scale):
    return z * (1.0 + scale) + shift


def swiglu(z, w_in, w_out):
    gate, up = jnp.split(z @ w_in, 2, axis=-1)
    return (jax.nn.silu(gate) * up) @ w_out


def short_conv(x, w, b):
    n = x.shape[1]
    xp = jnp.pad(x, ((0, 0), (CONV_LEFT, CONV_WIDTH - 1 - CONV_LEFT), (0, 0)))
    y = b
    for k in range(CONV_WIDTH):
        y = y + xp[:, k:k + n] * w[k]
    return y


def rglru_coeffs(xc, w_r, b_r, w_i, b_i, lam):
    bsz, n, _ = xc.shape
    xh = xc.reshape(bsz, n, LRU_HEADS, LRU_HEAD_DIM)
    r = jax.nn.sigmoid(jnp.einsum("bnhd,hde->bnhe", xh, w_r).reshape(bsz, n, LRU_WIDTH) + b_r)
    i = jax.nn.sigmoid(jnp.einsum("bnhd,hde->bnhe", xh, w_i).reshape(bsz, n, LRU_WIDTH) + b_i)
    log_a = (-RG_C * r * jax.nn.softplus(-lam)).astype(jnp.float32)
    a = jnp.exp(log_a)
    b = jnp.sqrt(-jnp.expm1(2.0 * log_a)) * (i * xc).astype(jnp.float32)
    return a, b


def _combine(left, right):
    a_l, b_l = left
    a_r, b_r = right
    return a_l * a_r, a_r * b_l + b_r


def linear_scan(a, b, h0, reverse):
    a_cum, h = lax.associative_scan(_combine, (a, b), reverse=reverse, axis=1)
    return h + a_cum * h0[:, None, :]


def lru_scans(xl, conv_w, conv_b, w_r, b_r, w_i, b_i, lam, h0_f, h0_b):
    xc = short_conv(xl, conv_w, conv_b)
    a_f, b_f = rglru_coeffs(xc, w_r[0], b_r[0], w_i[0], b_i[0], lam[0])
    h_f = linear_scan(a_f, b_f, h0_f, reverse=False)
    a_b, b_b = rglru_coeffs(xc, w_r[1], b_r[1], w_i[1], b_i[1], lam[1])
    h_b = linear_scan(a_b, b_b, h0_b, reverse=True)
    return h_f, h_b


def spatial_gating(u, v, norm_g, w_s, b_s, n_chunks):
    bsz = v.shape[0]
    v = layernorm(v, norm_g)
    vc = v.reshape(bsz, n_chunks, CHUNK, MLP_GROUPS, MLP_GROUP_DIM)
    z = jnp.einsum("gpq,bnqgc->bnpgc", w_s, vc) + b_s.T[None, None, :, :, None]
    return u * z.reshape(u.shape)


def mix_out(p, h_f, h_b, sgu_norm_g, sgu_w, sgu_b, w_out, n_chunks):
    gl = p[..., LRU_WIDTH:2 * LRU_WIDTH]
    u = p[..., 2 * LRU_WIDTH:2 * LRU_WIDTH + MLP_WIDTH]
    v = p[..., 2 * LRU_WIDTH + MLP_WIDTH:]
    y_lru = (h_f + h_b).astype(p.dtype) * jax.nn.gelu(gl)
    y_sgu = spatial_gating(u, v, sgu_norm_g, sgu_w, sgu_b, n_chunks)
    return jnp.concatenate([y_lru, y_sgu], axis=-1) @ w_out


def setup_inputs(seed: int = 0) -> dict:
    key = jax.random.key(seed)
    ks = jax.random.split(key, 32)
    f32 = jnp.float32

    def nrm(k, shape, s):
        return jax.random.normal(k, shape, f32) * s

    def gain(k, shape):
        return 1.0 + 0.02 * jax.random.normal(k, shape, f32)

    u = jax.random.uniform(ks[20], (DEPTH, 2, LRU_WIDTH), f32, minval=0.9, maxval=0.999)
    a0 = u ** (1.0 / RG_C)
    lru_lambda = jnp.log(a0) - jnp.log1p(-a0)

    return {
        "x": nrm(ks[0], (BATCH, SEQ, D_MODEL), 1.0),
        "c": nrm(ks[1], (BATCH, D_MODEL), 1.0),
        "ctx": nrm(ks[2], (BATCH, CTX_LEN, D_MODEL), 1.0),
        "c_ctx": nrm(ks[3], (D_MODEL,), 1.0),
        "w_ada": nrm(ks[4], (DEPTH, D_MODEL, N_MOD * D_MODEL), 0.5 * D_MODEL ** -0.5),
        "b_ada": nrm(ks[5], (DEPTH, N_MOD * D_MODEL), 0.02),
        "ffn1_norm_g": gain(ks[6], (DEPTH, D_MODEL)),
        "ffn1_w_in": nrm(ks[7], (DEPTH, D_MODEL, 2 * D_FF), D_MODEL ** -0.5),
        "ffn1_w_out": nrm(ks[8], (DEPTH, D_FF, D_MODEL), D_FF ** -0.5),
        "mix_norm_g": gain(ks[9], (DEPTH, D_MODEL)),
        "w_in_mix": nrm(ks[10], (DEPTH, D_MODEL, IN_PROJ_WIDTH), D_MODEL ** -0.5),
        "lru_conv_w": nrm(ks[11], (DEPTH, CONV_WIDTH, LRU_WIDTH), CONV_WIDTH ** -0.5),
        "lru_conv_b": nrm(ks[12], (DEPTH, LRU_WIDTH), 0.02),
        "lru_w_r": nrm(ks[13], (DEPTH, 2, LRU_HEADS, LRU_HEAD_DIM, LRU_HEAD_DIM), LRU_HEAD_DIM ** -0.5),
        "lru_b_r": nrm(ks[14], (DEPTH, 2, LRU_WIDTH), 0.02),
        "lru_w_i": nrm(ks[15], (DEPTH, 2, LRU_HEADS, LRU_HEAD_DIM, LRU_HEAD_DIM), LRU_HEAD_DIM ** -0.5),
        "lru_b_i": nrm(ks[16], (DEPTH, 2, LRU_WIDTH), 0.02),
        "lru_lambda": lru_lambda,
        "sgu_norm_g": gain(ks[17], (DEPTH, MLP_WIDTH)),
        "sgu_w": nrm(ks[18], (DEPTH, MLP_GROUPS, CHUNK, CHUNK), CHUNK ** -0.5),
        "sgu_b": nrm(ks[19], (DEPTH, MLP_GROUPS, CHUNK), 0.02),
        "w_out_mix": nrm(ks[21], (DEPTH, MIX_WIDTH, D_MODEL), MIX_WIDTH ** -0.5),
        "ffn2_norm_g": gain(ks[22], (DEPTH, D_MODEL)),
        "ffn2_w_in": nrm(ks[23], (DEPTH, D_MODEL, 2 * D_FF), D_MODEL ** -0.5),
        "ffn2_w_out": nrm(ks[24], (DEPTH, D_FF, D_MODEL), D_FF ** -0.5),
        "final_norm_g": gain(ks[25], (D_MODEL,)),
    }


def reference(x, c, ctx, c_ctx, w_ada, b_ada, ffn1_norm_g, ffn1_w_in, ffn1_w_out,
              mix_norm_g, w_in_mix, lru_conv_w, lru_conv_b, lru_w_r, lru_b_r, lru_w_i,
              lru_b_i, lru_lambda, sgu_norm_g, sgu_w, sgu_b, w_out_mix,
              ffn2_norm_g, ffn2_w_in, ffn2_w_out, final_norm_g):
    bsz, n_lat, _ = x.shape
    rows = n_lat // GRID_W
    n_chunks_lat = rows // ROWS_PER_CHUNK
    n_chunks_ctx = CTX_LEN // CHUNK
    zeros_state = jnp.zeros((bsz, LRU_WIDTH), jnp.float32)

    sc = jax.nn.silu(c)
    scc = jax.nn.silu(c_ctx)[None, :]
    h, hc = x, ctx
    for l in range(DEPTH):
        last = l == DEPTH - 1
        m = jnp.split((sc @ w_ada[l] + b_ada[l])[:, None, :], N_MOD, axis=-1)
        mc = jnp.split((scc @ w_ada[l] + b_ada[l])[:, None, :], N_MOD, axis=-1)

        h = h + 0.5 * m[2] * swiglu(modulate(rmsnorm(h, ffn1_norm_g[l]), m[0], m[1]),
                                    ffn1_w_in[l], ffn1_w_out[l])
        hc = hc + 0.5 * mc[2] * swiglu(modulate(rmsnorm(hc, ffn1_norm_g[l]), mc[0], mc[1]),
                                       ffn1_w_in[l], ffn1_w_out[l])

        lru_p = (lru_conv_w[l], lru_conv_b[l], lru_w_r[l], lru_b_r[l],
                 lru_w_i[l], lru_b_i[l], lru_lambda[l])
        zc = modulate(rmsnorm(hc, mix_norm_g[l]), mc[3], mc[4])
        if not last:
            pc = zc @ w_in_mix[l]
            hf_c, hb_c = lru_scans(pc[..., :LRU_WIDTH], *lru_p, zeros_state, zeros_state)
            hc = hc + mc[5] * mix_out(pc, hf_c, hb_c, sgu_norm_g[l], sgu_w[l], sgu_b[l],
                                      w_out_mix[l], n_chunks_ctx)
        else:
            hf_c, hb_c = lru_scans(zc @ w_in_mix[l][:, :LRU_WIDTH], *lru_p,
                                   zeros_state, zeros_state)
        z = modulate(rmsnorm(h, mix_norm_g[l]), m[3], m[4])
        p = z @ w_in_mix[l]
        hf, hb = lru_scans(p[..., :LRU_WIDTH], *lru_p, hf_c[:, -1], hb_c[:, 0])
        h = h + m[5] * mix_out(p, hf, hb, sgu_norm_g[l], sgu_w[l], sgu_b[l],
                               w_out_mix[l], n_chunks_lat)

        h = h + 0.5 * m[8] * swiglu(modulate(rmsnorm(h, ffn2_norm_g[l]), m[6], m[7]),
                                    ffn2_w_in[l], ffn2_w_out[l])
        if not last:
            hc = hc + 0.5 * mc[8] * swiglu(modulate(rmsnorm(hc, ffn2_norm_g[l]), mc[6], mc[7]),
                                           ffn2_w_in[l], ffn2_w_out[l])

    return rmsnorm(h, final_norm_g)
```

```cpp
#include <hip/hip_runtime.h>
#include <hip/hip_cooperative_groups.h>
#include <cstdio>
#include <cstdint>
namespace cg = cooperative_groups;

#define LAS __attribute__((address_space(3)))
typedef unsigned short bf16_t;
typedef short bf16x8 __attribute__((ext_vector_type(8)));
typedef float f32x4 __attribute__((ext_vector_type(4)));
typedef float f32x2 __attribute__((ext_vector_type(2)));
typedef unsigned u32x4 __attribute__((ext_vector_type(4)));
typedef unsigned u32x2 __attribute__((ext_vector_type(2)));

__device__ __forceinline__ int opaque_tid() { int t = threadIdx.x; asm volatile("" : "+v"(t)); return t; }

namespace pg8 {
constexpr int BM = 256, BK = 64, HALF = 128, HTB = HALF * BK * 2, STAGE_BYTES = 8 * HTB, NXCD = 8, WGM = 4;
__host__ __device__ __forceinline__ int lds_byte(int r, int c) { const int st = (r >> 4) * 2 + (c >> 5), rr = r & 15, cc = c & 31, ob = rr * 64 + cc * 2; return st * 1024 + (ob ^ (((ob >> 9) & 1) << 5)); }
__host__ __device__ __forceinline__ void stage_rc(int b, int& R, int& C) { const int st = b / 1024, sb = b % 1024, swz = sb ^ (((sb >> 9) & 1) << 5); R = (st >> 1) * 16 + swz / 64; C = (st & 1) * 32 + (swz % 64) / 2; }
__host__ __device__ __forceinline__ int perm32(int rho) { const int n = rho >> 4, i = rho & 15; return 8 * (i >> 2) + 4 * n + (i & 3); }
struct Unit { int pm, pn, kc, ui; };
struct Gemm { const bf16_t* A; const bf16_t* Bt; int M, N, K; };

struct Order2 {
    int nN, nlat, cpn, total, G, c, ks;
    __device__ __forceinline__ void init(int nN_, int cpn_, int G_, int c_, int ks_ = 1) { nN = nN_; nlat = 128 * nN_; cpn = cpn_; ks = ks_; total = nlat + 4 * cpn_ * ks_; G = G_; c = c_; }
    __device__ __forceinline__ bool next(int i, Unit& u) const {
        const long L = (long)i * G + c; if (L >= total) return false;
        int pm, pn, kc = -1;
        if (L >= nlat) { int r = (int)L - nlat; if (ks > 1) { kc = r % ks; r /= ks; } pm = 128 + r / cpn; pn = r % cpn; }
        else { int wgid = (int)L; { const int q = nlat / NXCD, xcd = wgid % NXCD, off = wgid / NXCD; wgid = xcd * q + off; }
            const int nig = WGM * nN, gid = wgid / nig, fm = gid * WGM; pm = fm + ((wgid % nig) % WGM); pn = (wgid % nig) / WGM; }
        u.pm = pm; u.pn = pn; u.kc = kc; u.ui = i; return true;
    }
    __device__ __forceinline__ void a_ready(const Unit&) const {}
    __device__ __forceinline__ void done(const Unit&) const {}
};

template <class Epi, class Sched>
__device__ __forceinline__ void gemm_phase(LAS unsigned char* lds, const Gemm g, const Sched& S, const Epi& E) {
    const int tid = opaque_tid(), wid = __builtin_amdgcn_readfirstlane(tid >> 6), lane = tid & 63, wr = wid >> 2, wc = wid & 3, fr = lane & 15, fq = lane >> 4;
    const int K = g.K, ntf = K / BK, nts = S.ks > 1 ? ntf / S.ks : ntf;
    unsigned voffA[2], voffB[2];
#pragma unroll
    for (int i = 0; i < 2; ++i) { int R, C; stage_rc(tid * 16 + i * 8192, R, C); const int Rb = Epi::PERM ? ((R & ~31) + perm32(R & 31)) : R;
        voffA[i] = (unsigned)(R * K + C) * 2u; voffB[i] = (unsigned)(Rb * K + C) * 2u; }
    const size_t kstep = (size_t)(BK * 2);
    const size_t hstep = (size_t)HALF * K * 2;
    const size_t tstep = 2 * hstep;
    const unsigned ldsw = (unsigned)wid * 1024u;
    const int aoff = lds_byte(wr * 64 + fr, fq * 8), boff = lds_byte(wc * 32 + fr, fq * 8);
#define PG8_SA(b, h) (((b) * 2 + (h)) * HTB)
#define PG8_SB(b, h) ((4 + (b) * 2 + (h)) * HTB)
#define PG8_STAGE(bufoff, gbase, voff) do { _Pragma("unroll") for (int _i = 0; _i < 2; ++_i) \
        __builtin_amdgcn_global_load_lds((const unsigned*)((const char*)(gbase) + (voff)[_i]), (LAS unsigned*)(lds + (bufoff) + ldsw + _i * 8192), 16, 0, 0); } while (0)
#define PG8_LDA(dst, b, h) do { _Pragma("unroll") for (int m = 0; m < 4; ++m) _Pragma("unroll") for (int k = 0; k < 2; ++k) dst[m][k] = *(const LAS bf16x8*)(lds + PG8_SA(b, h) + aoff + m * 2048 + k * 1024); } while (0)
#define PG8_LDB(dst, b, h) do { _Pragma("unroll") for (int n = 0; n < 2; ++n) _Pragma("unroll") for (int k = 0; k < 2; ++k) dst[n][k] = *(const LAS bf16x8*)(lds + PG8_SB(b, h) + boff + n * 2048 + k * 1024); } while (0)
#define PG8_MMA(ai, bj, At, Bt) do { __builtin_amdgcn_s_setprio(1); _Pragma("unroll") for (int m = 0; m < 4; ++m) _Pragma("unroll") for (int n = 0; n < 2; ++n) _Pragma("unroll") for (int k = 0; k < 2; ++k) \
        acc[ai][bj][m][n] = __builtin_amdgcn_mfma_f32_16x16x32_bf16(Bt[n][k], At[m][k], acc[ai][bj][m][n], 0, 0, 0); __builtin_amdgcn_s_setprio(0); } while (0)
#define PG8_WAIT_V(n) asm volatile("s_waitcnt vmcnt(" #n ")" ::: "memory")
#define PG8_WAIT_L(n) asm volatile("s_waitcnt lgkmcnt(" #n ")" ::: "memory")
#define PG8_BAR __builtin_amdgcn_s_barrier()
#define PG8_SCHED __builtin_amdgcn_sched_barrier(0)
    Unit cur, nxt; int ui = 0;
    if (!S.next(0, cur)) return;
    f32x4 acc[2][2][4][2];
#pragma unroll
    for (int a = 0; a < 2; ++a)
#pragma unroll
        for (int b = 0; b < 2; ++b)
#pragma unroll
            for (int m = 0; m < 4; ++m)
#pragma unroll
                for (int n = 0; n < 2; ++n) acc[a][b][m][n] = (f32x4){0.f, 0.f, 0.f, 0.f};
    bf16x8 At[4][2], B0[2][2], B1[2][2];
    const char* cA = (const char*)g.A + (size_t)cur.pm * tstep + (cur.kc > 0 ? (size_t)cur.kc * nts * kstep : 0); const char* cB = (const char*)g.Bt + (size_t)cur.pn * tstep + (cur.kc > 0 ? (size_t)cur.kc * nts * kstep : 0);
    S.a_ready(cur);
    PG8_STAGE(PG8_SB(0, 0), cB, voffB); PG8_STAGE(PG8_SB(0, 1), cB + hstep, voffB); PG8_STAGE(PG8_SA(0, 0), cA, voffA); PG8_STAGE(PG8_SA(0, 1), cA + hstep, voffA);
    if (wr == 1) PG8_BAR;
    PG8_WAIT_V(2); PG8_BAR;
    PG8_STAGE(PG8_SB(1, 0), cB + kstep, voffB); PG8_STAGE(PG8_SA(1, 0), cA + kstep, voffA); PG8_STAGE(PG8_SB(1, 1), cB + hstep + kstep, voffB);
    PG8_WAIT_V(6); PG8_BAR;
    for (;;) {
        const bool has_next = S.next(ui + 1, nxt);
        const size_t nko = (has_next && nxt.kc > 0) ? (size_t)nxt.kc * nts * kstep : 0;
        const char* nA = has_next ? (const char*)g.A + (size_t)nxt.pm * tstep + nko : cA; const char* nB = has_next ? (const char*)g.Bt + (size_t)nxt.pn * tstep + nko : cB;
        const int nt = cur.kc >= 0 ? nts : ntf;
        for (int t = 0; t < nt; t += 2) {
            const bool last = (t == nt - 2);
            const char* a1 = cA + (size_t)(t + 1) * kstep;
            const char* a2 = last ? nA : cA + (size_t)(t + 2) * kstep; const char* b2 = last ? nB : cB + (size_t)(t + 2) * kstep;
            const char* a3 = a2 + kstep; const char* b3 = b2 + kstep;
            PG8_LDB(B0, 0, 0); PG8_LDB(B1, 0, 1); PG8_SCHED; PG8_LDA(At, 0, 0); PG8_STAGE(PG8_SA(1, 1), a1 + hstep, voffA);
            PG8_WAIT_V(8); PG8_WAIT_L(0); PG8_BAR; PG8_MMA(0, 0, At, B0); PG8_MMA(0, 1, At, B1); PG8_BAR; PG8_SCHED;
            PG8_LDA(At, 0, 1); PG8_STAGE(PG8_SB(0, 0), b2, voffB); PG8_STAGE(PG8_SB(0, 1), b2 + hstep, voffB); PG8_STAGE(PG8_SA(0, 0), a2, voffA);
            PG8_WAIT_V(8); PG8_WAIT_L(0); PG8_BAR; PG8_MMA(1, 0, At, B0); PG8_MMA(1, 1, At, B1); PG8_BAR; PG8_SCHED;
            PG8_LDB(B0, 1, 0); PG8_LDB(B1, 1, 1); PG8_SCHED; PG8_LDA(At, 1, 0); PG8_STAGE(PG8_SA(0, 1), a2 + hstep, voffA);
            PG8_WAIT_V(8); PG8_WAIT_L(0); PG8_BAR; PG8_MMA(0, 0, At, B0); PG8_MMA(0, 1, At, B1); PG8_BAR; PG8_SCHED;
            PG8_LDA(At, 1, 1); PG8_STAGE(PG8_SB(1, 0), b3, voffB); PG8_STAGE(PG8_SB(1, 1), b3 + hstep, voffB); PG8_STAGE(PG8_SA(1, 0), a3, voffA);
            PG8_WAIT_V(8); PG8_WAIT_L(0); PG8_BAR; PG8_MMA(1, 0, At, B0); PG8_MMA(1, 1, At, B1); PG8_BAR; PG8_SCHED;
        }
        if (wr == 0) PG8_BAR;
        E(acc, cur, wr, wc, fr, fq);
        if (!has_next) break;
#pragma unroll
        for (int a = 0; a < 2; ++a)
#pragma unroll
            for (int b = 0; b < 2; ++b)
#pragma unroll
                for (int m = 0; m < 4; ++m)
#pragma unroll
                    for (int n = 0; n < 2; ++n) acc[a][b][m][n] = (f32x4){0.f, 0.f, 0.f, 0.f};
        cur = nxt; cA = nA; cB = nB; ++ui;
        if (wr == 1) PG8_BAR;
    }
    PG8_WAIT_V(0);
    PG8_BAR;
#undef PG8_SA
#undef PG8_SB
#undef PG8_STAGE
#undef PG8_LDA
#undef PG8_LDB
#undef PG8_MMA
#undef PG8_WAIT_V
#undef PG8_WAIT_L
#undef PG8_BAR
#undef PG8_SCHED
}
}

constexpr int D = 1024, NB = 4, SEQ = 8192, CTXL = 256, DFF = 2816, NLAT = NB * SEQ, NCTX = NB * CTXL, MT = NLAT + NCTX;
constexpr float EPS = 1e-6f;
constexpr size_t OFF_HB = 0;
constexpr size_t OFF_AP = OFF_HB + (size_t)MT * D * 2;
constexpr size_t OFF_Y = OFF_AP + (size_t)MT * D * 2;
constexpr size_t OFF_HID = OFF_Y + (size_t)MT * D * 2;
constexpr size_t OFF_W = OFF_HID + (size_t)MT * DFF * 2;
constexpr size_t LW_WIN1 = 0, LW_WOUT1 = 11534336, LW_WINM = 17301504, LW_WOUTM = 21495808, LW_WIN2 = 23592960, LW_WOUT2 = 35127296, LW_TOTAL = 40894464;
constexpr size_t OFF_WG = OFF_W + 2 * LW_TOTAL;
constexpr size_t OFF_SGW = OFF_WG + 524288;
constexpr size_t OFF_MODV = OFF_SGW + 262144;
constexpr size_t OFF_SW = OFF_MODV + 368640;
constexpr size_t OFF_RSQ = OFF_SW + 532480;
constexpr size_t OFF_VST = OFF_RSQ + (size_t)MT * 16 * 4;
constexpr size_t OFF_SUM = OFF_VST + (size_t)MT * 16 * 4;
constexpr size_t OFF_BAR = OFF_SUM + (size_t)264 * 2048 * 4;
constexpr size_t BAR_BYTES = 16384;
constexpr size_t WS_END = OFF_BAR + BAR_BYTES;
constexpr int RSTD_OFF = 131072 + 16;
constexpr int VEC_OFF = RSTD_OFF + 12 * 256 * 4;
constexpr int LDS_BYTES = VEC_OFF + 12288;

struct Params { const float* in[26]; float* out; unsigned char* ws; };
enum { I_X = 0, I_C, I_CTX, I_CCTX, I_WADA, I_BADA, I_G1, I_W1IN, I_W1OUT, I_GMIX, I_WINM, I_CONVW, I_CONVB, I_WR, I_BR, I_WI, I_BI, I_LAM, I_SGN, I_SGW, I_SGB, I_WOUTM, I_G2, I_W2IN, I_W2OUT, I_GF };

__device__ __forceinline__ unsigned pk2(float lo, float hi) { unsigned r; asm("v_cvt_pk_bf16_f32 %0, %1, %2" : "=v"(r) : "v"(lo), "v"(hi)); return r; }
__device__ __forceinline__ float bflo(unsigned w) { return __uint_as_float(w << 16); }
__device__ __forceinline__ float bfhi(unsigned w) { return __uint_as_float(w & 0xffff0000u); }
__device__ __forceinline__ float sigmoidf_(float v) { return __builtin_amdgcn_rcpf(1.0f + __expf(-v)); }

__device__ __forceinline__ void rows_rstd(const LAS float* tab, int ui, int rl0, float (&rstd)[2][4]) {
#pragma unroll
    for (int ai = 0; ai < 2; ++ai)
#pragma unroll
        for (int m = 0; m < 4; ++m) rstd[ai][m] = tab[ui * 256 + rl0 + ai * 128 + m * 16];
}
template <int MODE, class Sched> __device__ __forceinline__ void fill_tabs(LAS unsigned char* lds, const Sched& S, const float* rsq, const float* v0, const float* v1) {
    const int tid = opaque_tid(); LAS float* tab = (LAS float*)(lds + RSTD_OFF); LAS float* vec = (LAS float*)(lds + VEC_OFF);
    for (int i = 0; i < 12; ++i) { pg8::Unit u; if (!S.next(i, u)) break;
        const int s = u.pm < 128 ? (u.pm >> 5) : 4;
        if (MODE != 2) {
            if (tid < 256) { const float* p = rsq + ((size_t)u.pm * 256 + tid) * 16; float t = 0.f;
#pragma unroll
                for (int j = 0; j < 4; ++j) { const f32x4 v = *(const f32x4*)(p + 4 * j); t += (v.x + v.y) + (v.z + v.w); }
                tab[i * 256 + tid] = rsqrtf(t * (1.0f / 1024.0f) + EPS); }
            else { const int t = tid - 256;
                vec[i * 256 + t] = MODE == 1 ? v0[s * 13312 + (t < 128 ? u.pn * 128 + t : 2816 + u.pn * 128 + (t - 128))] : v0[s * 13312 + u.pn * 256 + t]; }
        } else if (u.kc < 0 && i < 6) {
            vec[i * 512 + tid] = tid < 256 ? v0[s * 9216 + u.pn * 256 + tid] : (v1 ? v1[s * 9216 + u.pn * 256 + tid - 256] : 0.f);
        }
    }
    __syncthreads();
}
struct EpiSwiglu {
    static constexpr bool PERM = true;
    const LAS float* rtab; const LAS float* vtab; bf16_t* hid;
    __device__ __forceinline__ void operator()(const f32x4 (&acc)[2][2][4][2], const pg8::Unit& u, int wr, int wc, int fr_, int fq_) const {
        int fr = fr_, fq = fq_; asm volatile("" : "+v"(fr), "+v"(fq));
        const int s = u.pm < 128 ? (u.pm >> 5) : 4;
        const int row0 = u.pm * 256 + wr * 64 + fr, jc = u.pn * 128 + wc * 32 + fq * 8;
        const LAS float* swp = vtab + u.ui * 256 + wc * 32 + fq * 8;
        const f32x4 g0 = *(const LAS f32x4*)swp, g1 = *(const LAS f32x4*)(swp + 4), u0 = *(const LAS f32x4*)(swp + 128), u1 = *(const LAS f32x4*)(swp + 132);
        float rs[2][4]; rows_rstd(rtab, u.ui, wr * 64 + fr, rs);
#pragma unroll
        for (int ai = 0; ai < 2; ++ai)
#pragma unroll
            for (int m = 0; m < 4; ++m) {
                const int row = row0 + ai * 128 + m * 16; const float rstd = rs[ai][m];
                f32x4 g[2], up[2], e[2];
                g[0] = acc[ai][0][m][0] * rstd + g0; g[1] = acc[ai][0][m][1] * rstd + g1; up[0] = acc[ai][1][m][0] * rstd + u0; up[1] = acc[ai][1][m][1] * rstd + u1;
#pragma unroll
                for (int h = 0; h < 2; ++h) { const f32x4 t = g[h] * -1.4426950408889634f;
                    e[h] = (f32x4){__builtin_amdgcn_exp2f(t.x), __builtin_amdgcn_exp2f(t.y), __builtin_amdgcn_exp2f(t.z), __builtin_amdgcn_exp2f(t.w)}; }
#pragma unroll
                for (int h = 0; h < 2; ++h) { const f32x4 d = e[h] + 1.0f;
                    e[h] = (f32x4){__builtin_amdgcn_rcpf(d.x), __builtin_amdgcn_rcpf(d.y), __builtin_amdgcn_rcpf(d.z), __builtin_amdgcn_rcpf(d.w)}; }
#pragma unroll
                for (int h = 0; h < 2; ++h) g[h] = (g[h] * up[h]) * e[h];
                u32x4 w; w.x = pk2(g[0].x, g[0].y); w.y = pk2(g[0].z, g[0].w); w.z = pk2(g[1].x, g[1].y); w.w = pk2(g[1].z, g[1].w);
                *(u32x4*)(hid + (size_t)row * DFF + jc) = w;
            }
    }
};
struct EpiResid {
    static constexpr bool PERM = true;
    bf16_t* hb; const float* gate; const float* gsn; const LAS float* vtab; bf16_t* ap; float* rsq; float* part;
    __device__ __forceinline__ void operator()(const f32x4 (&acc)[2][2][4][2], const pg8::Unit& u, int wr, int wc, int fr_, int fq_) const {
        int fr = fr_, fq = fq_; asm volatile("" : "+v"(fr), "+v"(fq));
        const int cb0 = u.pn * 256 + wc * 32 + fq * 8;
        if (u.kc >= 0) {
            float* pp = part + ((size_t)u.kc * NCTX + (size_t)(u.pm - 128) * 256 + wr * 64 + fr) * D + cb0;
#pragma unroll
            for (int ai = 0; ai < 2; ++ai)
#pragma unroll
                for (int m = 0; m < 4; ++m)
#pragma unroll
                    for (int bj = 0; bj < 2; ++bj) { float* q = pp + (size_t)(ai * 128 + m * 16) * D + bj * 128; *(f32x4*)q = acc[ai][bj][m][0]; *(f32x4*)(q + 4) = acc[ai][bj][m][1]; }
            return;
        }
        const int s = u.pm < 128 ? (u.pm >> 5) : 4;
        f32x4 gt[2][2], gn[2][2];
#pragma unroll
        for (int bj = 0; bj < 2; ++bj) { const LAS float* gp = vtab + u.ui * 512 + bj * 128 + wc * 32 + fq * 8; gt[bj][0] = *(const LAS f32x4*)gp; gt[bj][1] = *(const LAS f32x4*)(gp + 4);
            gn[bj][0] = *(const LAS f32x4*)(gp + 256); gn[bj][1] = *(const LAS f32x4*)(gp + 260); }
        bf16_t* hbase = hb + ((size_t)u.pm * 256 + wr * 64 + fr) * D + cb0;
        u32x4 hv[2][2];
#pragma unroll
        for (int bj = 0; bj < 2; ++bj) hv[0][bj] = *(const u32x4*)(hbase + bj * 128);
#pragma unroll
        for (int it = 0; it < 8; ++it) {
            const int ai = it >> 2, m = it & 3;
            const size_t roff = (size_t)(ai * 128 + m * 16) * D; const size_t grow = (size_t)u.pm * 256 + ai * 128 + wr * 64 + m * 16 + fr;
            if (it < 7) { const size_t rn = (size_t)(((it + 1) >> 2) * 128 + ((it + 1) & 3) * 16) * D;
#pragma unroll
                for (int bj = 0; bj < 2; ++bj) hv[(it + 1) & 1][bj] = *(const u32x4*)(hbase + rn + bj * 128); }
            float sq = 0.f;
#pragma unroll
            for (int bj = 0; bj < 2; ++bj) {
                const u32x4 r = hv[it & 1][bj];
                const f32x4 o0 = (f32x4){bflo(r.x), bfhi(r.x), bflo(r.y), bfhi(r.y)}, o1 = (f32x4){bflo(r.z), bfhi(r.z), bflo(r.w), bfhi(r.w)};
                const f32x4 n0 = o0 + gt[bj][0] * acc[ai][bj][m][0], n1 = o1 + gt[bj][1] * acc[ai][bj][m][1];
                u32x4 hw; hw.x = pk2(n0.x, n0.y); hw.y = pk2(n0.z, n0.w); hw.z = pk2(n1.x, n1.y); hw.w = pk2(n1.z, n1.w);
                *(u32x4*)(hbase + roff + bj * 128) = hw;
                sq += (n0.x * n0.x + n0.y * n0.y) + (n0.z * n0.z + n0.w * n0.w) + (n1.x * n1.x + n1.y * n1.y) + (n1.z * n1.z + n1.w * n1.w);
                if (gsn) { const f32x4 a0 = n0 * gn[bj][0], a1 = n1 * gn[bj][1]; u32x4 w; w.x = pk2(a0.x, a0.y); w.y = pk2(a0.z, a0.w); w.z = pk2(a1.x, a1.y); w.w = pk2(a1.z, a1.w);
                    *(u32x4*)(ap + grow * D + cb0 + bj * 128) = w; }
            }
            sq += __shfl_xor(sq, 16); sq += __shfl_xor(sq, 32);
            if (fq == 0) rsq[grow * 16 + u.pn * 4 + wc] = sq;
        }
    }
};
struct EpiInproj {
    static constexpr bool PERM = true;
    const LAS float* rtab; const LAS float* vtab; bf16_t* p; float* vst;
    __device__ __forceinline__ void operator()(const f32x4 (&acc)[2][2][4][2], const pg8::Unit& u, int wr, int wc, int fr_, int fq_) const {
        int fr = fr_, fq = fq_; asm volatile("" : "+v"(fr), "+v"(fq));
        const int s = u.pm < 128 ? (u.pm >> 5) : 4;
        const int row0 = u.pm * 256 + wr * 64 + fr, cb0 = u.pn * 256 + wc * 32 + fq * 8;
        f32x4 sw[2][2];
#pragma unroll
        for (int bj = 0; bj < 2; ++bj) { const LAS float* sp = vtab + u.ui * 256 + bj * 128 + wc * 32 + fq * 8; sw[bj][0] = *(const LAS f32x4*)sp; sw[bj][1] = *(const LAS f32x4*)(sp + 4); }
        const bool isv = u.pn >= 6;
        float rs[2][4]; rows_rstd(rtab, u.ui, wr * 64 + fr, rs);
#pragma unroll
        for (int ai = 0; ai < 2; ++ai)
#pragma unroll
            for (int m = 0; m < 4; ++m) {
                const int row = row0 + ai * 128 + m * 16; const float rstd = rs[ai][m];
                float sm = 0.f, sq = 0.f;
#pragma unroll
                for (int bj = 0; bj < 2; ++bj) {
                    const f32x4 v0 = acc[ai][bj][m][0] * rstd + sw[bj][0], v1 = acc[ai][bj][m][1] * rstd + sw[bj][1];
                    u32x4 w; w.x = pk2(v0.x, v0.y); w.y = pk2(v0.z, v0.w); w.z = pk2(v1.x, v1.y); w.w = pk2(v1.z, v1.w);
                    *(u32x4*)(p + (size_t)row * 2048 + cb0 + bj * 128) = w;
                    sm += (v0.x + v0.y) + (v0.z + v0.w) + (v1.x + v1.y) + (v1.z + v1.w);
                    sq += (v0.x * v0.x + v0.y * v0.y) + (v0.z * v0.z + v0.w * v0.w) + (v1.x * v1.x + v1.y * v1.y) + (v1.z * v1.z + v1.w * v1.w);
                }
                if (isv) { sm += __shfl_xor(sm, 16); sm += __shfl_xor(sm, 32); sq += __shfl_xor(sq, 16); sq += __shfl_xor(sq, 32);
                    if (fq == 0) { float* vp = vst + (size_t)row * 16 + ((u.pn - 6) * 4 + wc) * 2; vp[0] = sm; vp[1] = sq; } }
            }
    }
};

__device__ __forceinline__ void gemv5_partial(const float* __restrict__ W, int ldw, int col, int k0, const LAS float* vin, float (&acc)[5]) {
#pragma unroll
    for (int s = 0; s < 5; ++s) acc[s] = 0.f;
#pragma unroll 32
    for (int k = k0; k < k0 + 128; ++k) { const float w = W[(size_t)k * ldw + col];
#pragma unroll
        for (int s = 0; s < 5; ++s) acc[s] += vin[s * 1024 + k] * w; }
}
__device__ __forceinline__ void adaln_item(const Params& P, int it, LAS unsigned char* lds) {
    const int tid = opaque_tid(), w = tid >> 6, lane = tid & 63;
    LAS float* vin = (LAS float*)lds; LAS float* red = (LAS float*)(lds + 20480);
    const int l = it / 144, c0 = (it % 144) * 64;
    for (int idx = tid; idx < 5120; idx += 512) { const int s = idx >> 10, k = idx & 1023; const float cv = s < 4 ? P.in[I_C][s * 1024 + k] : P.in[I_CCTX][k]; vin[idx] = cv / (1.0f + __expf(-cv)); }
    __syncthreads();
    float acc[5]; gemv5_partial(P.in[I_WADA] + (size_t)l * 1024 * 9216, 9216, c0 + lane, w * 128, vin, acc);
#pragma unroll
    for (int s = 0; s < 5; ++s) red[(w * 5 + s) * 64 + lane] = acc[s];
    __syncthreads();
    if (tid < 320) { const int s = tid >> 6; float m = 0.f;
#pragma unroll
        for (int v = 0; v < 8; ++v) m += red[(v * 5 + s) * 64 + lane];
        const int n = c0 + lane, chunk = n >> 10, k = n & 1023; m += P.in[I_BADA][l * 9216 + n];
        float val = m;
        if (chunk == 1) val = P.in[I_G1][l * 1024 + k] * (1.0f + m); else if (chunk == 4) val = P.in[I_GMIX][l * 1024 + k] * (1.0f + m); else if (chunk == 7) val = P.in[I_G2][l * 1024 + k] * (1.0f + m);
        else if (chunk == 2 || chunk == 8) val = 0.5f * m;
        ((float*)(P.ws + OFF_MODV))[((l * 5 + s) * 9 + chunk) * 1024 + k] = val; }
    __syncthreads();
}
__device__ __forceinline__ void shiftw_item(const Params& P, int it, LAS unsigned char* lds) {
    const int tid = opaque_tid(), w = tid >> 6, lane = tid & 63;
    LAS float* vin = (LAS float*)lds; LAS float* red = (LAS float*)(lds + 20480);
    const int l = it / 208; int r = it % 208; const float* W; int ldw, c0, off, chunk;
    if (r < 88) { W = P.in[I_W1IN] + (size_t)l * 1024 * 5632; ldw = 5632; c0 = r * 64; off = 0; chunk = 0; }
    else if (r < 120) { W = P.in[I_WINM] + (size_t)l * 1024 * 2048; ldw = 2048; c0 = (r - 88) * 64; off = 5632; chunk = 3; }
    else { W = P.in[I_W2IN] + (size_t)l * 1024 * 5632; ldw = 5632; c0 = (r - 120) * 64; off = 7680; chunk = 6; }
    const float* modv = (const float*)(P.ws + OFF_MODV);
    for (int idx = tid; idx < 5120; idx += 512) { const int s = idx >> 10, k = idx & 1023; vin[idx] = modv[((l * 5 + s) * 9 + chunk) * 1024 + k]; }
    __syncthreads();
    float acc[5]; gemv5_partial(W, ldw, c0 + lane, w * 128, vin, acc);
#pragma unroll
    for (int s = 0; s < 5; ++s) red[(w * 5 + s) * 64 + lane] = acc[s];
    __syncthreads();
    if (tid < 320) { const int s = tid >> 6; float m = 0.f;
#pragma unroll
        for (int v = 0; v < 8; ++v) m += red[(v * 5 + s) * 64 + lane];
        ((float*)(P.ws + OFF_SW))[(l * 5 + s) * 13312 + off + c0 + lane] = m; }
    __syncthreads();
}
__device__ __forceinline__ void transpose_item(const Params& P, int it, LAS float* scr, int lane) {
    const int l = it / 9984; int r = it % 9984; const float* W; int K, N; size_t dst; bool perm = false;
    if (r < 2816) { W = P.in[I_W1IN] + (size_t)l * 1024 * 5632; K = 1024; N = 5632; dst = LW_WIN1; perm = true; }
    else if ((r -= 2816) < 1408) { W = P.in[I_W1OUT] + (size_t)l * 2816 * 1024; K = 2816; N = 1024; dst = LW_WOUT1; }
    else if ((r -= 1408) < 1024) { W = P.in[I_WINM] + (size_t)l * 1024 * 2048; K = 1024; N = 2048; dst = LW_WINM; }
    else if ((r -= 1024) < 512) { W = P.in[I_WOUTM] + (size_t)l * 1024 * 1024; K = 1024; N = 1024; dst = LW_WOUTM; }
    else if ((r -= 512) < 2816) { W = P.in[I_W2IN] + (size_t)l * 1024 * 5632; K = 1024; N = 5632; dst = LW_WIN2; perm = true; }
    else { r -= 2816; W = P.in[I_W2OUT] + (size_t)l * 2816 * 1024; K = 2816; N = 1024; dst = LW_WOUT2; }
    const int ntn = N / 32, k0 = (r / ntn) * 64, n0 = (r % ntn) * 32;
    const int r0 = perm ? (((n0 % 2816) / 128) * 256 + (n0 / 2816) * 128 + (n0 % 128)) : n0;
    bf16_t* Bt = (bf16_t*)(P.ws + OFF_W + (size_t)l * LW_TOTAL + dst);
    float v[32];
#pragma unroll
    for (int i = 0; i < 32; ++i) { const int kk = 2 * i + (lane >> 5); v[i] = W[(size_t)(k0 + kk) * N + n0 + (lane & 31)]; }
#pragma unroll
    for (int i = 0; i < 32; ++i) { const int kk = 2 * i + (lane >> 5); scr[kk * 33 + (lane & 31)] = v[i]; }
    asm volatile("s_waitcnt lgkmcnt(0)" ::: "memory");
    const int c = lane & 7;
#pragma unroll
    for (int j = 0; j < 4; ++j) { const int n = (lane >> 3) + 8 * j; const LAS float* t = scr + (8 * c) * 33 + n;
        u32x4 o; o.x = pk2(t[0], t[33]); o.y = pk2(t[66], t[99]); o.z = pk2(t[132], t[165]); o.w = pk2(t[198], t[231]);
        *(u32x4*)(Bt + (size_t)(r0 + n) * K + k0 + 8 * c) = o; }
    asm volatile("s_waitcnt lgkmcnt(0)" ::: "memory");
}
__device__ __forceinline__ void prep_item2(const Params& P, int rowA, int rowB, bool hasB, int lane) {
    const int rows[2] = {rowA, hasB ? rowB : rowA};
    f32x4 v[2][4], g[2][4];
#pragma unroll
    for (int q = 0; q < 2; ++q) { const int row = rows[q]; const int s = row < NLAT ? (row >> 13) : 4;
        const float* src = row < NLAT ? P.in[I_X] + (size_t)row * D : P.in[I_CTX] + (size_t)(row - NLAT) * D;
        const float* gs = (const float*)(P.ws + OFF_MODV) + ((0 * 5 + s) * 9 + 1) * 1024;
#pragma unroll
        for (int j = 0; j < 4; ++j) { const int c = (lane + 64 * j) * 4; v[q][j] = *(const f32x4*)(src + c); g[q][j] = *(const f32x4*)(gs + c); } }
#pragma unroll
    for (int q = 0; q < 2; ++q) { if (q == 1 && !hasB) break; const int row = rows[q];
        bf16_t* ap = (bf16_t*)(P.ws + OFF_AP) + (size_t)row * D; bf16_t* hbp = (bf16_t*)(P.ws + OFF_HB) + (size_t)row * D;
        float sq = 0.f;
#pragma unroll
        for (int j = 0; j < 4; ++j) { const int c = (lane + 64 * j) * 4; const f32x4 x = v[q][j], gg = g[q][j];
            sq += (x.x * x.x + x.y * x.y) + (x.z * x.z + x.w * x.w);
            u32x2 o; o.x = pk2(x.x * gg.x, x.y * gg.y); o.y = pk2(x.z * gg.z, x.w * gg.w); *(u32x2*)(ap + c) = o;
            u32x2 hh; hh.x = pk2(x.x, x.y); hh.y = pk2(x.z, x.w); *(u32x2*)(hbp + c) = hh; }
#pragma unroll
        for (int o = 1; o < 64; o <<= 1) sq += __shfl_xor(sq, o);
        if (lane < 16) ((float*)(P.ws + OFF_RSQ))[(size_t)row * 16 + lane] = lane == 0 ? sq : 0.f; }
}
__device__ __forceinline__ void final_item(const Params& P, int it) {
    const int tid = opaque_tid(), w = tid >> 6, lane = tid & 63;
    const float* g = P.in[I_GF];
    u32x2 r[2][4]; f32x4 gg[4]; float t[2];
#pragma unroll
    for (int j = 0; j < 4; ++j) gg[j] = *(const f32x4*)(g + (lane + 64 * j) * 4);
#pragma unroll
    for (int q = 0; q < 2; ++q) { const int row = it * 16 + 2 * w + q;
        t[q] = ((const float*)(P.ws + OFF_RSQ))[(size_t)row * 16 + (lane & 15)];
        const bf16_t* hp = (const bf16_t*)(P.ws + OFF_HB) + (size_t)row * D;
#pragma unroll
        for (int j = 0; j < 4; ++j) r[q][j] = *(const u32x2*)(hp + (lane + 64 * j) * 4); }
#pragma unroll
    for (int q = 0; q < 2; ++q) { const int row = it * 16 + 2 * w + q; float tt = t[q];
        tt += __shfl_xor(tt, 1); tt += __shfl_xor(tt, 2); tt += __shfl_xor(tt, 4); tt += __shfl_xor(tt, 8);
        const float rstd = rsqrtf(tt * (1.0f / 1024.0f) + EPS);
        float* op = P.out + (size_t)row * D;
#pragma unroll
        for (int j = 0; j < 4; ++j) { const int c = (lane + 64 * j) * 4; *(f32x4*)(op + c) = (f32x4){bflo(r[q][j].x), bfhi(r[q][j].x), bflo(r[q][j].y), bfhi(r[q][j].y)} * rstd * gg[j]; } }
}

__device__ __forceinline__ void ctx_fix_row(const Params& P, int r, int lane, int ks, const float* part, const float* gate, const float* gsn) {
    const int c0 = lane * 16; const size_t grow = (size_t)NLAT + r;
    f32x4 sum[4];
#pragma unroll
    for (int i = 0; i < 4; ++i) sum[i] = (f32x4){0.f, 0.f, 0.f, 0.f};
    for (int k = 0; k < ks; ++k) { const float* pp = part + ((size_t)k * NCTX + r) * D + c0;
#pragma unroll
        for (int i = 0; i < 4; ++i) sum[i] += *(const f32x4*)(pp + 4 * i); }
    bf16_t* hp = (bf16_t*)(P.ws + OFF_HB) + grow * D + c0; bf16_t* ap = (bf16_t*)(P.ws + OFF_AP) + grow * D + c0;
    const u32x4 h0 = *(const u32x4*)hp, h1 = *(const u32x4*)(hp + 8);
    const unsigned hw[8] = {h0.x, h0.y, h0.z, h0.w, h1.x, h1.y, h1.z, h1.w};
    float n[16]; float sq = 0.f;
#pragma unroll
    for (int i = 0; i < 4; ++i) { const f32x4 g = *(const f32x4*)(gate + 4 * 9216 + c0 + 4 * i);
        n[4 * i] = bflo(hw[2 * i]) + g.x * sum[i].x; n[4 * i + 1] = bfhi(hw[2 * i]) + g.y * sum[i].y; n[4 * i + 2] = bflo(hw[2 * i + 1]) + g.z * sum[i].z; n[4 * i + 3] = bfhi(hw[2 * i + 1]) + g.w * sum[i].w; }
#pragma unroll
    for (int i = 0; i < 16; ++i) sq += n[i] * n[i];
    u32x4 o0, o1; o0.x = pk2(n[0], n[1]); o0.y = pk2(n[2], n[3]); o0.z = pk2(n[4], n[5]); o0.w = pk2(n[6], n[7]); o1.x = pk2(n[8], n[9]); o1.y = pk2(n[10], n[11]); o1.z = pk2(n[12], n[13]); o1.w = pk2(n[14], n[15]);
    *(u32x4*)hp = o0; *(u32x4*)(hp + 8) = o1;
    if (gsn) {
#pragma unroll
        for (int i = 0; i < 4; ++i) { const f32x4 g = *(const f32x4*)(gsn + 4 * 9216 + c0 + 4 * i); n[4 * i] *= g.x; n[4 * i + 1] *= g.y; n[4 * i + 2] *= g.z; n[4 * i + 3] *= g.w; }
        o0.x = pk2(n[0], n[1]); o0.y = pk2(n[2], n[3]); o0.z = pk2(n[4], n[5]); o0.w = pk2(n[6], n[7]); o1.x = pk2(n[8], n[9]); o1.y = pk2(n[10], n[11]); o1.z = pk2(n[12], n[13]); o1.w = pk2(n[14], n[15]);
        *(u32x4*)ap = o0; *(u32x4*)(ap + 8) = o1; }
    sq += __shfl_xor(sq, 1); sq += __shfl_xor(sq, 2);
    if ((lane & 3) == 0) ((float*)(P.ws + OFF_RSQ))[grow * 16 + (lane >> 2)] = sq;
}

__device__ __forceinline__ void tile_info(int tix, int& row0, int& pos0, int& L, int& b) {
    if (tix < 256) { b = tix >> 6; pos0 = (tix & 63) * 128; row0 = b * SEQ + pos0; L = SEQ; }
    else { const int c = tix - 256; b = c >> 1; pos0 = (c & 1) * 128; row0 = NLAT + b * CTXL + pos0; L = CTXL; }
}
constexpr int SC_WG_OFF = 0, SC_CW_OFF = 36864, SC_CAR_OFF = 38144, SC_WCOMP_OFF = 42752, SC_XL_OFF = 50944, SC_GL_OFF = 67840, SC_XC_OFF = 84224;
struct ScanPre { u32x4 x[3]; u32x4 g[2]; u32x4 cf[8]; };
constexpr size_t COEF_ITEM = 65536, COEF_TAIL_ITEMS = 264;
__device__ __forceinline__ u32x4* coef_base(const Params& P, int item) {
    const size_t off = item < 1056 ? OFF_AP + (size_t)item * COEF_ITEM : (item < 1848 ? OFF_HID + (size_t)MT * 2048 * 2 + (size_t)(item - 1056) * COEF_ITEM : WS_END + (size_t)(item - 1848) * COEF_ITEM);
    return (u32x4*)(P.ws + off);
}
__device__ __forceinline__ void scan_prefetch(ScanPre& R, const Params& P, const bf16_t* pb, int tix, int h, int tid, bool final_mode) {
    int row0, pos0, L, b; tile_info(tix, row0, pos0, L, b);
    if (!final_mode) {
#pragma unroll
        for (int i = 0; i < 3; ++i) { const int idx = tid + 512 * i, r = idx >> 3, pc = idx & 7, pos = pos0 - 2 + r; R.x[i] = (u32x4){0u, 0u, 0u, 0u};
            if (idx < 131 * 8 && pos >= 0 && pos < L) R.x[i] = *(const u32x4*)(pb + (size_t)(row0 - 2 + r) * 2048 + h * 64 + pc * 8); }
    } else {
#pragma unroll
        for (int i = 0; i < 2; ++i) { const int idx = tid + 512 * i, r = idx >> 3, pc = idx & 7; R.g[i] = *(const u32x4*)(pb + (size_t)(row0 + r) * 2048 + 512 + h * 64 + pc * 8); }
        const u32x4* cb = coef_base(P, tix * 8 + h) + tid;
#pragma unroll
        for (int i = 0; i < 8; ++i) R.cf[i] = cb[i * 512];
    }
}
__device__ __forceinline__ void scan_group(const Params& P, int l, int wgI, bool final_mode, bool with_ctx, LAS unsigned char* lds) {
    const int tid = opaque_tid(), w = __builtin_amdgcn_readfirstlane(tid >> 6), lane = tid & 63, fr = lane & 15, fq = lane >> 4;
    const int h = wgI & 7, grp = wgI >> 3, gb = grp >> 3, j0 = (grp & 7) * 8;
    const int ctix = 256 + (wgI >> 3);
    const bool has_ctx = with_ctx && wgI < 64;
    const bf16_t* pb = (const bf16_t*)(P.ws + OFF_HID);
    float* summ = (float*)(P.ws + OFF_SUM);
    LAS f32x2* wcomp = (LAS f32x2*)(lds + SC_WCOMP_OFF); LAS float* car = (LAS float*)(lds + SC_CAR_OFF); LAS float* cw = (LAS float*)(lds + SC_CW_OFF);
    __syncthreads();
    if (!final_mode) { const bf16_t* wg = (const bf16_t*)(P.ws + OFF_WG);
      for (int idx = tid; idx < 2048; idx += 512) { const int mat = idx >> 9, e = (idx >> 3) & 63, pc = idx & 7;
          *(LAS u32x4*)(lds + SC_WG_OFF + (mat * 64 + e) * 144 + pc * 16) = *(const u32x4*)(wg + ((size_t)((l * 2 + (mat >> 1)) * 2 + (mat & 1)) * 8 + h) * 4096 + e * 64 + pc * 8); }
      if (tid < 320) { const int k = tid >> 6, ch = tid & 63; cw[tid] = k < 4 ? P.in[I_CONVW][(l * 4 + k) * 512 + h * 64 + ch] : P.in[I_CONVB][l * 512 + h * 64 + ch]; } }
    float brv[2][4], biv[2][4], sp8[2][4];
#pragma unroll
    for (int dir = 0; dir < 2; ++dir)
#pragma unroll
        for (int eb = 0; eb < 4; ++eb) { const int pidx = (l * 2 + dir) * 512 + h * 64 + eb * 16 + fr;
            brv[dir][eb] = -1.4426950408889634f * P.in[I_BR][pidx]; biv[dir][eb] = -1.4426950408889634f * P.in[I_BI][pidx]; sp8[dir][eb] = 8.0f * 1.4426950408889634f * log1pf(__expf(-P.in[I_LAM][pidx])); }
    if (final_mode) {
        LAS float* T = (LAS float*)(lds + SC_XL_OFF);
        { float tv[33];
#pragma unroll
          for (int i = 0; i < 33; ++i) { const int idx = tid + 512 * i; const int ch = idx & 63, ab = (idx >> 6) & 1, dir = (idx >> 7) & 1, k = idx >> 8;
              const int t = k < 2 ? 256 + 2 * gb + (dir == 0 ? k : 1 - k) : gb * 64 + (dir == 0 ? (k - 2) : (63 - (k - 2)));
              tv[i] = summ[((size_t)(t * 2 + dir) * 2 + ab) * 512 + h * 64 + ch]; }
#pragma unroll
          for (int i = 0; i < 33; ++i) { const int idx = tid + 512 * i; const int ch = idx & 63, ab = (idx >> 6) & 1, dir = (idx >> 7) & 1, k = idx >> 8;
              T[((dir * 66 + k) * 2 + ab) * 64 + ch] = tv[i]; } }
        __syncthreads();
        if (tid < 128) { const int dir = tid >> 6, ch = tid & 63; float s = 0.f;
#pragma unroll 6
            for (int k = 0; k < 66; ++k) {
                if (k >= 2) { const int i = (dir == 0 ? (k - 2) : (63 - (k - 2))) - j0; if (i >= 0 && i < 8) car[(dir * 9 + i) * 64 + ch] = s; }
                s = T[((dir * 66 + k) * 2 + 0) * 64 + ch] * s + T[((dir * 66 + k) * 2 + 1) * 64 + ch]; }
            float cs = 0.f;
            if (has_ctx) { const int cj = (ctix - 256) & 1; if (dir == 0 && cj == 1) cs = summ[((size_t)((ctix - 1) * 2 + 0) * 2 + 1) * 512 + h * 64 + ch]; if (dir == 1 && cj == 0) cs = summ[((size_t)((ctix + 1) * 2 + 1) * 2 + 1) * 512 + h * 64 + ch]; }
            car[(dir * 9 + 8) * 64 + ch] = cs; }
        __syncthreads();
    }
    const int nitems = 8 + (has_ctx ? 1 : 0);
    ScanPre R; scan_prefetch(R, P, pb, grp * 8, h, tid, final_mode);
#pragma unroll 1
    for (int it = 0; it < nitems; ++it) {
        const int tix = it < 8 ? grp * 8 + it : ctix;
        int row0, pos0, L, b; tile_info(tix, row0, pos0, L, b);
        if (!final_mode) {
#pragma unroll
        for (int i = 0; i < 3; ++i) { const int idx = tid + 512 * i; if (idx < 131 * 8) *(LAS u32x4*)(lds + SC_XL_OFF + (idx >> 3) * 128 + (idx & 7) * 16) = R.x[i]; }
        } else {
#pragma unroll
            for (int i = 0; i < 2; ++i) { const int idx = tid + 512 * i; *(LAS u32x4*)(lds + SC_GL_OFF + (idx >> 3) * 128 + (idx & 7) * 16) = R.g[i]; } }
        __syncthreads();
        if (it + 1 < nitems && !final_mode) scan_prefetch(R, P, pb, it + 1 < 8 ? grp * 8 + it + 1 : ctix, h, tid, final_mode);
        if (!final_mode) { const int q = tid >> 2, c4 = tid & 3; float a[16];
#pragma unroll
          for (int i = 0; i < 4; ++i) { const f32x4 bv = *(const LAS f32x4*)(cw + 256 + c4 * 16 + 4 * i); a[4 * i] = bv.x; a[4 * i + 1] = bv.y; a[4 * i + 2] = bv.z; a[4 * i + 3] = bv.w; }
#pragma unroll
          for (int k = 0; k < 4; ++k) {
              const u32x4 x0 = *(const LAS u32x4*)(lds + SC_XL_OFF + (q + k) * 128 + c4 * 32), x1 = *(const LAS u32x4*)(lds + SC_XL_OFF + (q + k) * 128 + c4 * 32 + 16);
              const unsigned xs[8] = {x0.x, x0.y, x0.z, x0.w, x1.x, x1.y, x1.z, x1.w};
#pragma unroll
              for (int i = 0; i < 4; ++i) { const f32x4 wv = *(const LAS f32x4*)(cw + k * 64 + c4 * 16 + 4 * i);
                  a[4 * i] += wv.x * bflo(xs[2 * i]); a[4 * i + 1] += wv.y * bfhi(xs[2 * i]); a[4 * i + 2] += wv.z * bflo(xs[2 * i + 1]); a[4 * i + 3] += wv.w * bfhi(xs[2 * i + 1]); } }
          LAS float* xo = (LAS float*)(lds + SC_XC_OFF + q * 272 + c4 * 64);
#pragma unroll
          for (int i = 0; i < 4; ++i) *(LAS f32x4*)(xo + 4 * i) = (f32x4){a[4 * i], a[4 * i + 1], a[4 * i + 2], a[4 * i + 3]}; }
        __syncthreads();
        bf16x8 af[2] = {};
        if (!final_mode) {
#pragma unroll
        for (int ks = 0; ks < 2; ++ks) { const LAS float* xr = (const LAS float*)(lds + SC_XC_OFF + (16 * w + fr) * 272) + ks * 32 + fq * 8;
            const f32x4 v0 = *(const LAS f32x4*)xr, v1 = *(const LAS f32x4*)(xr + 4);
            u32x4 t; t.x = pk2(v0.x, v0.y); t.y = pk2(v0.z, v0.w); t.z = pk2(v1.x, v1.y); t.w = pk2(v1.z, v1.w); af[ks] = __builtin_bit_cast(bf16x8, t); }
        }
        float ca[2][4][4], cbv[2][4][4], Ae[2][4], Be[2][4];
#pragma unroll
        for (int dir = 0; dir < 2; ++dir) {
#pragma unroll
            for (int eb = 0; eb < 4; ++eb) {
              if (!final_mode) {
                f32x4 pr = (f32x4){0.f, 0.f, 0.f, 0.f}, pi = pr;
#pragma unroll
                for (int ks = 0; ks < 2; ++ks) {
                    const bf16x8 br = *(const LAS bf16x8*)(lds + SC_WG_OFF + ((dir * 2 + 0) * 64 + eb * 16 + fr) * 144 + ks * 64 + fq * 16);
                    const bf16x8 bi = *(const LAS bf16x8*)(lds + SC_WG_OFF + ((dir * 2 + 1) * 64 + eb * 16 + fr) * 144 + ks * 64 + fq * 16);
                    pr = __builtin_amdgcn_mfma_f32_16x16x32_bf16(af[ks], br, pr, 0, 0, 0);
                    pi = __builtin_amdgcn_mfma_f32_16x16x32_bf16(af[ks], bi, pi, 0, 0, 0);
                }
                float la[4], ig[4], xv[4];
#pragma unroll
                for (int j = 0; j < 4; ++j) {
                    const float r = __builtin_amdgcn_rcpf(1.0f + __builtin_amdgcn_exp2f(pr[j] + brv[dir][eb])); ig[j] = __builtin_amdgcn_rcpf(1.0f + __builtin_amdgcn_exp2f(pi[j] + biv[dir][eb]));
                    xv[j] = *(const LAS float*)(lds + SC_XC_OFF + (16 * w + 4 * fq + j) * 272 + (eb * 16 + fr) * 4);
                    la[j] = -r * sp8[dir][eb]; }
                u32x4 pk; pk.x = pk2(la[0], la[1]); pk.y = pk2(la[2], la[3]);
                la[0] = bflo(pk.x); la[1] = bfhi(pk.x); la[2] = bflo(pk.y); la[3] = bfhi(pk.y);
                float bq[4];
#pragma unroll
                for (int j = 0; j < 4; ++j) { const float av = __builtin_amdgcn_exp2f(la[j]); ca[dir][eb][j] = av;
                    bq[j] = __builtin_amdgcn_sqrtf(__builtin_fmaf(-av, av, 1.0f)) * ig[j] * xv[j]; }
                pk.z = pk2(bq[0], bq[1]); pk.w = pk2(bq[2], bq[3]);
                cbv[dir][eb][0] = bflo(pk.z); cbv[dir][eb][1] = bfhi(pk.z); cbv[dir][eb][2] = bflo(pk.w); cbv[dir][eb][3] = bfhi(pk.w);
                coef_base(P, tix * 8 + h)[(dir * 4 + eb) * 512 + tid] = pk;
              } else {
                const u32x4 pk = R.cf[dir * 4 + eb];
                ca[dir][eb][0] = __builtin_amdgcn_exp2f(bflo(pk.x)); ca[dir][eb][1] = __builtin_amdgcn_exp2f(bfhi(pk.x)); ca[dir][eb][2] = __builtin_amdgcn_exp2f(bflo(pk.y)); ca[dir][eb][3] = __builtin_amdgcn_exp2f(bfhi(pk.y));
                cbv[dir][eb][0] = bflo(pk.z); cbv[dir][eb][1] = bfhi(pk.z); cbv[dir][eb][2] = bflo(pk.w); cbv[dir][eb][3] = bfhi(pk.w);
              }
                float A = 1.f, B = 0.f;
                if (dir == 0) {
#pragma unroll
                    for (int j = 0; j < 4; ++j) { B = ca[dir][eb][j] * B + cbv[dir][eb][j]; A *= ca[dir][eb][j]; }
                    float Ap = __shfl_up(A, 16), Bp = __shfl_up(B, 16); if (fq >= 1) { B = A * Bp + B; A = A * Ap; }
                    Ap = __shfl_up(A, 32); Bp = __shfl_up(B, 32); if (fq >= 2) { B = A * Bp + B; A = A * Ap; }
                    float ae = __shfl_up(A, 16), be = __shfl_up(B, 16); if (fq == 0) { ae = 1.f; be = 0.f; }
                    Ae[dir][eb] = ae; Be[dir][eb] = be;
                    if (fq == 3) wcomp[(0 * 8 + w) * 64 + eb * 16 + fr] = (f32x2){A, B};
                } else {
#pragma unroll
                    for (int j = 3; j >= 0; --j) { B = ca[dir][eb][j] * B + cbv[dir][eb][j]; A *= ca[dir][eb][j]; }
                    float Ap = __shfl_down(A, 16), Bp = __shfl_down(B, 16); if (fq <= 2) { B = A * Bp + B; A = A * Ap; }
                    Ap = __shfl_down(A, 32); Bp = __shfl_down(B, 32); if (fq <= 1) { B = A * Bp + B; A = A * Ap; }
                    float ae = __shfl_down(A, 16), be = __shfl_down(B, 16); if (fq == 3) { ae = 1.f; be = 0.f; }
                    Ae[dir][eb] = ae; Be[dir][eb] = be;
                    if (fq == 0) wcomp[(1 * 8 + w) * 64 + eb * 16 + fr] = (f32x2){A, B};
                }
            }
        }
        if (final_mode && it + 1 < nitems) scan_prefetch(R, P, pb, it + 1 < 8 ? grp * 8 + it + 1 : ctix, h, tid, final_mode);
        __syncthreads();
        if (!final_mode) {
            if (w == 0) {
                float A = 1.f, B = 0.f;
#pragma unroll
                for (int v = 0; v < 8; ++v) { const f32x2 cv = wcomp[(0 * 8 + v) * 64 + lane]; B = cv.x * B + cv.y; A = cv.x * A; }
                float* sp = summ + ((size_t)(tix * 2 + 0) * 2) * 512 + h * 64 + lane; sp[0] = A; sp[512] = B;
                A = 1.f; B = 0.f;
#pragma unroll
                for (int v = 7; v >= 0; --v) { const f32x2 cv = wcomp[(1 * 8 + v) * 64 + lane]; B = cv.x * B + cv.y; A = cv.x * A; }
                sp = summ + ((size_t)(tix * 2 + 1) * 2) * 512 + h * 64 + lane; sp[0] = A; sp[512] = B;
            }
        } else {
#pragma unroll
            for (int eb = 0; eb < 4; ++eb) {
                const int c = eb * 16 + fr;
                float s = car[(0 * 9 + it) * 64 + c];
#pragma unroll
                for (int v = 0; v < 7; ++v) { const f32x2 cv = wcomp[(0 * 8 + v) * 64 + c]; if (v < w) s = cv.x * s + cv.y; }
                s = Ae[0][eb] * s + Be[0][eb];
                float hf[4];
#pragma unroll
                for (int j = 0; j < 4; ++j) { s = ca[0][eb][j] * s + cbv[0][eb][j]; hf[j] = s; }
                s = car[(1 * 9 + it) * 64 + c];
#pragma unroll
                for (int v = 7; v > 0; --v) { const f32x2 cv = wcomp[(1 * 8 + v) * 64 + c]; if (v > w) s = cv.x * s + cv.y; }
                s = Ae[1][eb] * s + Be[1][eb];
#pragma unroll
                for (int j = 3; j >= 0; --j) { s = ca[1][eb][j] * s + cbv[1][eb][j]; hf[j] += s; }
#pragma unroll
                for (int j = 0; j < 4; ++j) {
                    const int q = 16 * w + 4 * fq + j;
                    const float g = bflo((unsigned)*(const LAS bf16_t*)(lds + SC_GL_OFF + q * 128 + c * 2));
                    const float ge = g * sigmoidf_(1.5957691216f * (g + 0.044715f * g * g * g));
                    *(LAS bf16_t*)(lds + SC_XC_OFF + q * 128 + c * 2) = (bf16_t)(pk2(hf[j] * ge, 0.f) & 0xffffu);
                }
            }
            __syncthreads();
            bf16_t* yb = (bf16_t*)(P.ws + OFF_Y);
#pragma unroll
            for (int i = 0; i < 2; ++i) { const int idx = tid + 512 * i, r = idx >> 3, pc = idx & 7;
                *(u32x4*)(yb + (size_t)(row0 + r) * D + h * 64 + pc * 8) = *(const LAS u32x4*)(lds + SC_XC_OFF + r * 128 + pc * 16); }
        }
    }
}
constexpr int ST_OFF = 0, VT_OFF = 1024;
__device__ __forceinline__ void sgu_item(const Params& P, int l, int tix, int g, LAS unsigned char* lds) {
    const int tid = opaque_tid(), w = __builtin_amdgcn_readfirstlane(tid >> 6), lane = tid & 63, fr = lane & 15, fq = lane >> 4;
    int row0, pos0, L, b; tile_info(tix, row0, pos0, L, b);
    const bf16_t* pb = (const bf16_t*)(P.ws + OFF_HID); bf16_t* yb = (bf16_t*)(P.ws + OFF_Y);
    LAS f32x2* stat = (LAS f32x2*)(lds + ST_OFF);
    __syncthreads();
    if (tid < 128) { const float* vp = (const float*)(P.ws + OFF_VST) + (size_t)(row0 + tid) * 16; float sm = 0.f, sq = 0.f;
#pragma unroll
        for (int i = 0; i < 4; ++i) { const f32x4 t = *(const f32x4*)(vp + 4 * i); sm += t.x + t.z; sq += t.y + t.w; }
        const float mean = sm * (1.0f / 512.0f), var = fmaxf(sq * (1.0f / 512.0f) - mean * mean, 0.f);
        stat[tid] = (f32x2){mean, rsqrtf(var + EPS)}; }
    __syncthreads();
    { const int qp = lane; const f32x2 s0 = stat[2 * qp], s1 = stat[2 * qp + 1];
#pragma unroll
      for (int it = 0; it < 2; ++it) { const int c0 = (w + 8 * it) * 8;
          const u32x4 r0 = *(const u32x4*)(pb + (size_t)(row0 + 2 * qp) * 2048 + 1536 + g * 128 + c0), r1 = *(const u32x4*)(pb + (size_t)(row0 + 2 * qp + 1) * 2048 + 1536 + g * 128 + c0);
          const float* gp = P.in[I_SGN] + l * 512 + g * 128 + c0; const f32x4 g0 = *(const f32x4*)gp, g1 = *(const f32x4*)(gp + 4);
          const float gn[8] = {g0.x, g0.y, g0.z, g0.w, g1.x, g1.y, g1.z, g1.w};
          const unsigned a[4] = {r0.x, r0.y, r0.z, r0.w}, bb[4] = {r1.x, r1.y, r1.z, r1.w};
#pragma unroll
          for (int i = 0; i < 4; ++i) {
              const float e0 = (bflo(a[i]) - s0.x) * s0.y * gn[2 * i], e1 = (bflo(bb[i]) - s1.x) * s1.y * gn[2 * i];
              const float o0 = (bfhi(a[i]) - s0.x) * s0.y * gn[2 * i + 1], o1 = (bfhi(bb[i]) - s1.x) * s1.y * gn[2 * i + 1];
              *(LAS unsigned*)(lds + VT_OFF + (c0 + 2 * i) * 272 + qp * 4) = pk2(e0, e1);
              *(LAS unsigned*)(lds + VT_OFF + (c0 + 2 * i + 1) * 272 + qp * 4) = pk2(o0, o1); } } }
    __syncthreads();
    const bf16_t* sgw = (const bf16_t*)(P.ws + OFF_SGW) + ((size_t)(l * 4 + g) * 128 + 16 * w + fr) * 128;
    bf16x8 bfr[4];
#pragma unroll
    for (int ks = 0; ks < 4; ++ks) bfr[ks] = *(const bf16x8*)(sgw + ks * 32 + fq * 8);
    const float bs = P.in[I_SGB][(l * 4 + g) * 128 + 16 * w + fr];
    const size_t prow = (size_t)(row0 + 16 * w + fr);
#pragma unroll
    for (int cb = 0; cb < 8; ++cb) {
        f32x4 acc = (f32x4){0.f, 0.f, 0.f, 0.f};
#pragma unroll
        for (int ks = 0; ks < 4; ++ks) { const bf16x8 a = *(const LAS bf16x8*)(lds + VT_OFF + (cb * 16 + fr) * 272 + (ks * 32 + fq * 8) * 2);
            acc = __builtin_amdgcn_mfma_f32_16x16x32_bf16(a, bfr[ks], acc, 0, 0, 0); }
        const int cc = g * 128 + cb * 16 + fq * 4;
        const u32x2 uu = *(const u32x2*)(pb + prow * 2048 + 1024 + cc);
        u32x2 o; o.x = pk2(bflo(uu.x) * (acc[0] + bs), bfhi(uu.x) * (acc[1] + bs)); o.y = pk2(bflo(uu.y) * (acc[2] + bs), bfhi(uu.y) * (acc[3] + bs));
        *(u32x2*)(yb + prow * D + 512 + cc) = o;
    }
}


#define XB_TMO      128
#define XB_XCNT(j)  (256  + 64 * (j))
#define XB_XSUB(j)  (1280 + 64 * (j))
#define XB_XGEN(j)  (2304 + 64 * (j))
#define XB_TOP      3328
#define XB_TOPGEN   3392
#define XCD_BAR_WORDS 3456
#define XB_SPIN_CAP (1u << 18)
__device__ __forceinline__ unsigned xb_ld(unsigned* p)              { return __hip_atomic_load(p, __ATOMIC_RELAXED, __HIP_MEMORY_SCOPE_AGENT); }
__device__ __forceinline__ unsigned xb_add(unsigned* p, unsigned v) { return __hip_atomic_fetch_add(p, v, __ATOMIC_RELAXED, __HIP_MEMORY_SCOPE_AGENT); }
__device__ __forceinline__ unsigned xb_xcc_id() { return (unsigned)__builtin_amdgcn_s_getreg((3 << 11) | 20) & 0xFu; }
#define XB_SPIN(cond, bar) do { unsigned _sp = 0; while (cond) { __builtin_amdgcn_s_sleep(1); \
    if ((++_sp & 255u) == 0u) { if (xb_ld(&(bar)[XB_TMO])) break; if (_sp > XB_SPIN_CAP) { atomicAdd(&(bar)[XB_TMO], 1u); break; } } } } while (0)
struct XcdBarrier { unsigned* bar; unsigned x; volatile LAS unsigned* st; };
__device__ __forceinline__ XcdBarrier xcd_barrier_post(unsigned* bar, volatile LAS unsigned* st) {
    XcdBarrier b; b.bar = bar; b.x = xb_xcc_id(); b.st = st;
    if (threadIdx.x == 0) (void)xb_add(&bar[XB_XCNT(b.x)], 1u);
    return b;
}
__device__ __forceinline__ void xcd_barrier_complete(unsigned* bar, unsigned x, unsigned& nloc, unsigned& nx) {
    const unsigned G = gridDim.x * gridDim.y * gridDim.z;
    unsigned sum, cnt, mine, sp = 0u;
    for (;;) {
        sum = 0u; cnt = 0u; mine = 0u;
#pragma unroll
        for (unsigned j = 0; j < 16; ++j) { const unsigned c = xb_ld(&bar[XB_XCNT(j)]); sum += c; cnt += (c > 0u) ? 1u : 0u; mine = (j == x) ? c : mine; }
        if (sum == G) break;
        __builtin_amdgcn_s_sleep(1);
        if ((++sp & 255u) == 0u) { if (xb_ld(&bar[XB_TMO])) break; if (sp > XB_SPIN_CAP) { atomicAdd(&bar[XB_TMO], 1u); break; } }
    }
    nloc = mine > 0u ? mine : 1u; nx = cnt > 0u ? cnt : 1u;
}
__device__ __forceinline__ void xcd_barrier(const XcdBarrier& b) {
    asm volatile("s_waitcnt vmcnt(0)" ::: "memory");
    __syncthreads();
    if (threadIdx.x == 0) {
        unsigned* bar = b.bar;
        __builtin_amdgcn_s_waitcnt(0);
        unsigned nloc = b.st[0], nx = b.st[1];
        if (nloc == 0u) { xcd_barrier_complete(bar, b.x, nloc, nx); b.st[0] = nloc; b.st[1] = nx; }
        const unsigned old = xb_add(&bar[XB_XSUB(b.x)], 1u);
        const unsigned gen = old / nloc;
        if (old + 1u == (gen + 1u) * nloc) {
            __builtin_amdgcn_fence(__ATOMIC_RELEASE, "agent");
            asm volatile("s_waitcnt vmcnt(0)" ::: "memory");
            const unsigned og = xb_add(&bar[XB_TOP], 1u);
            const unsigned tg = og / nx;
            if (og + 1u == (tg + 1u) * nx) xb_add(&bar[XB_TOPGEN], 1u);
            else XB_SPIN(xb_ld(&bar[XB_TOPGEN]) == tg, bar);
            __builtin_amdgcn_fence(__ATOMIC_ACQUIRE, "agent");
            xb_add(&bar[XB_XGEN(b.x)], 1u);
            asm volatile("s_waitcnt vmcnt(0)" ::: "memory");
        } else {
            XB_SPIN(xb_ld(&bar[XB_XGEN(b.x)]) == gen, bar);
            __builtin_amdgcn_fence(__ATOMIC_ACQUIRE, "agent");
            asm volatile("s_waitcnt vmcnt(0)" ::: "memory");
        }
    }
    __syncthreads();
}

__global__ void __launch_bounds__(512) fwd_mega(Params P) {
    extern __shared__ __attribute__((aligned(16))) unsigned char lds_raw[];
    LAS unsigned char* lds = (LAS unsigned char*)lds_raw;
    cg::grid_group grid = cg::this_grid();
    const int G = gridDim.x, c = blockIdx.x, tid = threadIdx.x;
    if (P.ws == nullptr) grid.sync();
    volatile LAS unsigned* xst = (volatile LAS unsigned*)(lds + 131072);
    if (tid == 0) { xst[0] = 0u; xst[1] = 0u; xst[2] = 0u; xst[3] = 0u; }
    __syncthreads();
    const XcdBarrier xb = xcd_barrier_post((unsigned*)(P.ws + OFF_BAR), xst);
    for (int it = c; it < (G == 256 ? 144 : 288); it += G) adaln_item(P, it, lds);
    { const int tw = opaque_tid(), wv = tw >> 6, ln = tw & 63; LAS float* scr = (LAS float*)(lds + 32768 + wv * 8448);
      for (int it = c * 8 + wv; it < 19968; it += G * 8) transpose_item(P, it, scr, ln); }
    { bf16_t* wg = (bf16_t*)(P.ws + OFF_WG);
      for (int i = c * 512 + tid; i < 262144; i += G * 512) { const int d = i & 63, e = (i >> 6) & 63, h = (i >> 12) & 7, gate = (i >> 15) & 1, dir = (i >> 16) & 1, l = i >> 17;
          const float* src = gate ? P.in[I_WI] : P.in[I_WR]; wg[i] = (bf16_t)(pk2(src[((size_t)((l * 2 + dir) * 8 + h) * 64 + d) * 64 + e] * -1.4426950408889634f, 0.f) & 0xffffu); }
      bf16_t* sg = (bf16_t*)(P.ws + OFF_SGW);
      for (int i = c * 512 + tid; i < 131072; i += G * 512) sg[i] = (bf16_t)(pk2(P.in[I_SGW][i], 0.f) & 0xffffu); }
    xcd_barrier(xb);
    for (int it = c; it < (G == 256 ? 208 : 416); it += G) shiftw_item(P, it, lds);
    { const int tw = opaque_tid(), wv = tw >> 6, ln = tw & 63;
      for (int row = c * 8 + wv; row < MT; row += 2 * G * 8) prep_item2(P, row, row + G * 8, row + G * 8 < MT, ln); }
    xcd_barrier(xb);
    bf16_t* AP = (bf16_t*)(P.ws + OFF_AP); bf16_t* YB = (bf16_t*)(P.ws + OFF_Y); bf16_t* HID = (bf16_t*)(P.ws + OFF_HID);
    float* RSQ = (float*)(P.ws + OFF_RSQ); float* VST = (float*)(P.ws + OFF_VST);
    const float* MODV = (const float*)(P.ws + OFF_MODV); const float* SW = (const float*)(P.ws + OFF_SW);
#pragma unroll 1
    for (int ph = 0; ph < 16; ++ph) {
        const int l = ph >> 3, st = ph & 7; const bool lastl = l == 1;
        const unsigned char* WL = P.ws + OFF_W + (size_t)l * LW_TOTAL;
        if (st == 0 || st == 6) {
            EpiSwiglu E; E.rtab = (const LAS float*)(lds + RSTD_OFF); E.vtab = (const LAS float*)(lds + VEC_OFF); E.hid = HID;
            const float* sWp = SW + (size_t)l * 5 * 13312 + (st == 0 ? 0 : 7680);
            pg8::Gemm g{AP, (const bf16_t*)(WL + (st == 0 ? LW_WIN1 : LW_WIN2)), MT, 5632, 1024};
            pg8::Order2 S; S.init(22, (st == 6 && lastl) ? 0 : 22, G, c);
            fill_tabs<1>(lds, S, RSQ, sWp, nullptr);
            pg8::gemm_phase<EpiSwiglu, pg8::Order2>(lds, g, S, E);
            if (G == 256 && ph == 0 && c >= 88 && c - 88 < 144) adaln_item(P, 144 + c - 88, lds);
        } else if (st == 1 || st == 5 || st == 7) {
            EpiResid E; E.hb = (bf16_t*)(P.ws + OFF_HB);
            const int cg_ = st == 1 ? 2 : (st == 5 ? 5 : 8);
            E.gate = MODV + (size_t)(l * 5) * 9216 + cg_ * 1024;
            E.gsn = st == 1 ? MODV + (size_t)(l * 5) * 9216 + 4 * 1024 : (st == 5 ? MODV + (size_t)(l * 5) * 9216 + 7 * 1024 : (lastl ? (const float*)nullptr : MODV + (size_t)(5) * 9216 + 1 * 1024));
            E.ap = AP; E.rsq = RSQ;
            pg8::Gemm g{st == 5 ? YB : HID, (const bf16_t*)(WL + (st == 1 ? LW_WOUT1 : (st == 5 ? LW_WOUTM : LW_WOUT2))), MT, 1024, st == 5 ? 1024 : 2816};
            const int cpn = (st != 1 && lastl) ? 0 : 4; const int ks = (st != 5 && cpn) ? 11 : 1;
            E.part = (float*)(P.ws + OFF_Y);
            pg8::Order2 S; S.init(4, cpn, G, c, ks);
            E.vtab = (const LAS float*)(lds + VEC_OFF);
            fill_tabs<2>(lds, S, nullptr, E.gate, E.gsn);
            pg8::gemm_phase<EpiResid, pg8::Order2>(lds, g, S, E);
            if (ks > 1) {
                xcd_barrier(xb);
                const int tw = opaque_tid(), wv = tw >> 6, ln = tw & 63;
                for (int r = c * 8 + wv; r < NCTX; r += G * 8) ctx_fix_row(P, r, ln, ks, E.part, E.gate, E.gsn);
            }
        } else if (st == 2) {
            EpiInproj E; E.rtab = (const LAS float*)(lds + RSTD_OFF); E.vtab = (const LAS float*)(lds + VEC_OFF); E.p = HID; E.vst = VST;
            const float* sWp = SW + (size_t)l * 5 * 13312 + 5632;
            pg8::Gemm g{AP, (const bf16_t*)(WL + LW_WINM), MT, 2048, 1024};
            pg8::Order2 S; S.init(8, lastl ? 2 : 8, G, c);
            fill_tabs<3>(lds, S, RSQ, sWp, nullptr);
            pg8::gemm_phase<EpiInproj, pg8::Order2>(lds, g, S, E);
            if (G == 256 && ph == 2 && c >= 32 && c - 32 < 208) shiftw_item(P, 208 + c - 32, lds);
        } else if (st == 3) {
            for (int wgI = c; wgI < 256; wgI += G) scan_group(P, l, wgI, false, true, lds);
            const int nsgu = lastl ? 1024 : 1056;
            for (int it = c; it < nsgu; it += G) sgu_item(P, l, it >> 2, it & 3, lds);
        } else {
            for (int wgI = c; wgI < 256; wgI += G) scan_group(P, l, wgI, true, !lastl, lds);
        }
        xcd_barrier(xb);
    }
    for (int it = c; it < NLAT / 16; it += G) final_item(P, it);
}

extern "C" void kernel_launch(void* const* d_in, const int* in_sizes, int n_in, void* d_out, int out_size, void* d_ws, size_t ws_size, hipStream_t stream) {
    static int grid = 0;
    if (!grid) {
        if (n_in != 26 || ws_size < WS_END + COEF_TAIL_ITEMS * COEF_ITEM) { fprintf(stderr, "kernel_launch: unexpected n_in %d / ws_size %zu (need %zu)\n", n_in, ws_size, (size_t)WS_END); grid = -1; return; }
        int dev = 0, cus = 0, per_cu = 0;
        (void)hipGetDevice(&dev);
        (void)hipDeviceGetAttribute(&cus, hipDeviceAttributeMultiprocessorCount, dev);
        (void)hipFuncSetAttribute((const void*)fwd_mega, hipFuncAttributeMaxDynamicSharedMemorySize, LDS_BYTES);
        (void)hipOccupancyMaxActiveBlocksPerMultiprocessor(&per_cu, (const void*)fwd_mega, 512, LDS_BYTES);
        if (per_cu < 1) { fprintf(stderr, "kernel_launch: occupancy query says %d blocks per CU\n", per_cu); per_cu = 1; }
        grid = cus;
    }
    if (grid < 0) return;
    if (hipMemsetAsync((char*)d_ws + OFF_BAR, 0, BAR_BYTES, stream) != hipSuccess) { fprintf(stderr, "kernel_launch: memset of the barrier words failed\n"); return; }
    Params p{};
    for (int i = 0; i < 26; ++i) p.in[i] = (const float*)d_in[i];
    p.out = (float*)d_out; p.ws = (unsigned char*)d_ws;
    void* args[] = {&p};
    hipError_t e = hipLaunchCooperativeKernel((const void*)fwd_mega, dim3(grid), dim3(512), args, LDS_BYTES, stream);
    if (e != hipSuccess) fprintf(stderr, "cooperative launch failed: %s (grid %d)\n", hipGetErrorString(e), grid);
}
```

```cpp
#include <hip/hip_runtime.h>
#include <hip/hip_cooperative_groups.h>
#include <cstdio>
#include <cstdint>
namespace cg = cooperative_groups;

#define LAS __attribute__((address_space(3)))
typedef unsigned short bf16_t;
typedef short bf16x8 __attribute__((ext_vector_type(8)));
typedef float f32x4 __attribute__((ext_vector_type(4)));
typedef float f32x2 __attribute__((ext_vector_type(2)));
typedef unsigned u32x4 __attribute__((ext_vector_type(4)));
typedef unsigned u32x2 __attribute__((ext_vector_type(2)));

__device__ __forceinline__ int opaque_tid() { int t = threadIdx.x; asm volatile("" : "+v"(t)); return t; }

namespace pg8 {
constexpr int BM = 256, BK = 64, HALF = 128, HTB = HALF * BK * 2, STAGE_BYTES = 8 * HTB, NXCD = 8, WGM = 4;
__host__ __device__ __forceinline__ int lds_byte(int r, int c) { const int st = (r >> 4) * 2 + (c >> 5), rr = r & 15, cc = c & 31, ob = rr * 64 + cc * 2; return st * 1024 + (ob ^ (((ob >> 9) & 1) << 5)); }
__host__ __device__ __forceinline__ void stage_rc(int b, int& R, int& C) { const int st = b / 1024, sb = b % 1024, swz = sb ^ (((sb >> 9) & 1) << 5); R = (st >> 1) * 16 + swz / 64; C = (st & 1) * 32 + (swz % 64) / 2; }
__host__ __device__ __forceinline__ int perm32(int rho) { const int n = rho >> 4, i = rho & 15; return 8 * (i >> 2) + 4 * n + (i & 3); }
struct Unit { int pm, pn, kc, ui; };
struct Gemm { const bf16_t* A; const bf16_t* Bt; int M, N, K; };

struct Order2 {
    int nN, nlat, cpn, total, G, c, ks;
    __device__ __forceinline__ void init(int nN_, int cpn_, int G_, int c_, int ks_ = 1) { nN = nN_; nlat = 128 * nN_; cpn = cpn_; ks = ks_; total = nlat + 4 * cpn_ * ks_; G = G_; c = c_; }
    __device__ __forceinline__ bool next(int i, Unit& u) const {
        const long L = (long)i * G + c; if (L >= total) return false;
        int pm, pn, kc = -1;
        if (L >= nlat) { int r = (int)L - nlat; if (ks > 1) { kc = r % ks; r /= ks; } pm = 128 + r / cpn; pn = r % cpn; }
        else { int wgid = (int)L; { const int q = nlat / NXCD, xcd = wgid % NXCD, off = wgid / NXCD; wgid = xcd * q + off; }
            const int nig = WGM * nN, gid = wgid / nig, fm = gid * WGM; pm = fm + ((wgid % nig) % WGM); pn = (wgid % nig) / WGM; }
        u.pm = pm; u.pn = pn; u.kc = kc; u.ui = i; return true;
    }
    __device__ __forceinline__ void a_ready(const Unit&) const {}
    __device__ __forceinline__ void done(const Unit&) const {}
};

template <class Epi, class Sched>
__device__ __forceinline__ void gemm_phase(LAS unsigned char* lds, const Gemm g, const Sched& S, const Epi& E) {
    const int tid = opaque_tid(), wid = __builtin_amdgcn_readfirstlane(tid >> 6), lane = tid & 63, wr = wid >> 2, wc = wid & 3, fr = lane & 15, fq = lane >> 4;
    const int K = g.K, ntf = K / BK, nts = S.ks > 1 ? ntf / S.ks : ntf;
    unsigned voffA[2], voffB[2];
#pragma unroll
    for (int i = 0; i < 2; ++i) { int R, C; stage_rc(tid * 16 + i * 8192, R, C); const int Rb = Epi::PERM ? ((R & ~31) + perm32(R & 31)) : R;
        voffA[i] = (unsigned)(R * K + C) * 2u; voffB[i] = (unsigned)(Rb * K + C) * 2u; }
    const size_t kstep = (size_t)(BK * 2);
    const size_t hstep = (size_t)HALF * K * 2;
    const size_t tstep = 2 * hstep;
    const unsigned ldsw = (unsigned)wid * 1024u;
    const int aoff = lds_byte(wr * 64 + fr, fq * 8), boff = lds_byte(wc * 32 + fr, fq * 8);
#define PG8_SA(b, h) (((b) * 2 + (h)) * HTB)
#define PG8_SB(b, h) ((4 + (b) * 2 + (h)) * HTB)
#define PG8_STAGE(bufoff, gbase, voff) do { _Pragma("unroll") for (int _i = 0; _i < 2; ++_i) \
        __builtin_amdgcn_global_load_lds((const unsigned*)((const char*)(gbase) + (voff)[_i]), (LAS unsigned*)(lds + (bufoff) + ldsw + _i * 8192), 16, 0, 0); } while (0)
#define PG8_LDA(dst, b, h) do { _Pragma("unroll") for (int m = 0; m < 4; ++m) _Pragma("unroll") for (int k = 0; k < 2; ++k) dst[m][k] = *(const LAS bf16x8*)(lds + PG8_SA(b, h) + aoff + m * 2048 + k * 1024); } while (0)
#define PG8_LDB(dst, b, h) do { _Pragma("unroll") for (int n = 0; n < 2; ++n) _Pragma("unroll") for (int k = 0; k < 2; ++k) dst[n][k] = *(const LAS bf16x8*)(lds + PG8_SB(b, h) + boff + n * 2048 + k * 1024); } while (0)
#define PG8_MMA(ai, bj, At, Bt) do { __builtin_amdgcn_s_setprio(1); _Pragma("unroll") for (int m = 0; m < 4; ++m) _Pragma("unroll") for (int n = 0; n < 2; ++n) _Pragma("unroll") for (int k = 0; k < 2; ++k) \
        acc[ai][bj][m][n] = __builtin_amdgcn_mfma_f32_16x16x32_bf16(Bt[n][k], At[m][k], acc[ai][bj][m][n], 0, 0, 0); __builtin_amdgcn_s_setprio(0); } while (0)
#define PG8_WAIT_V(n) asm volatile("s_waitcnt vmcnt(" #n ")" ::: "memory")
#define PG8_WAIT_L(n) asm volatile("s_waitcnt lgkmcnt(" #n ")" ::: "memory")
#define PG8_BAR __builtin_amdgcn_s_barrier()
#define PG8_SCHED __builtin_amdgcn_sched_barrier(0)
    Unit cur, nxt; int ui = 0;
    if (!S.next(0, cur)) return;
    f32x4 acc[2][2][4][2];
#pragma unroll
    for (int a = 0; a < 2; ++a)
#pragma unroll
        for (int b = 0; b < 2; ++b)
#pragma unroll
            for (int m = 0; m < 4; ++m)
#pragma unroll
                for (int n = 0; n < 2; ++n) acc[a][b][m][n] = (f32x4){0.f, 0.f, 0.f, 0.f};
    bf16x8 At[4][2], B0[2][2], B1[2][2];
    const char* cA = (const char*)g.A + (size_t)cur.pm * tstep + (cur.kc > 0 ? (size_t)cur.kc * nts * kstep : 0); const char* cB = (const char*)g.Bt + (size_t)cur.pn * tstep + (cur.kc > 0 ? (size_t)cur.kc * nts * kstep : 0);
    S.a_ready(cur);
    PG8_STAGE(PG8_SB(0, 0), cB, voffB); PG8_STAGE(PG8_SB(0, 1), cB + hstep, voffB); PG8_STAGE(PG8_SA(0, 0), cA, voffA); PG8_STAGE(PG8_SA(0, 1), cA + hstep, voffA);
    if (wr == 1) PG8_BAR;
    PG8_WAIT_V(2); PG8_BAR;
    PG8_STAGE(PG8_SB(1, 0), cB + kstep, voffB); PG8_STAGE(PG8_SA(1, 0), cA + kstep, voffA); PG8_STAGE(PG8_SB(1, 1), cB + hstep + kstep, voffB);
    PG8_WAIT_V(6); PG8_BAR;
    for (;;) {
        const bool has_next = S.next(ui + 1, nxt);
        const size_t nko = (has_next && nxt.kc > 0) ? (size_t)nxt.kc * nts * kstep : 0;
        const char* nA = has_next ? (const char*)g.A + (size_t)nxt.pm * tstep + nko : cA; const char* nB = has_next ? (const char*)g.Bt + (size_t)nxt.pn * tstep + nko : cB;
        const int nt = cur.kc >= 0 ? nts : ntf;
        for (int t = 0; t < nt; t += 2) {
            const bool last = (t == nt - 2);
            const char* a1 = cA + (size_t)(t + 1) * kstep;
            const char* a2 = last ? nA : cA + (size_t)(t + 2) * kstep; const char* b2 = last ? nB : cB + (size_t)(t + 2) * kstep;
            const char* a3 = a2 + kstep; const char* b3 = b2 + kstep;
            PG8_LDB(B0, 0, 0); PG8_LDB(B1, 0, 1); PG8_SCHED; PG8_LDA(At, 0, 0); PG8_STAGE(PG8_SA(1, 1), a1 + hstep, voffA);
            PG8_WAIT_V(8); PG8_WAIT_L(0); PG8_BAR; PG8_MMA(0, 0, At, B0); PG8_MMA(0, 1, At, B1); PG8_BAR; PG8_SCHED;
            PG8_LDA(At, 0, 1); PG8_STAGE(PG8_SB(0, 0), b2, voffB); PG8_STAGE(PG8_SB(0, 1), b2 + hstep, voffB); PG8_STAGE(PG8_SA(0, 0), a2, voffA);
            PG8_WAIT_V(8); PG8_WAIT_L(0); PG8_BAR; PG8_MMA(1, 0, At, B0); PG8_MMA(1, 1, At, B1); PG8_BAR; PG8_SCHED;
            PG8_LDB(B0, 1, 0); PG8_LDB(B1, 1, 1); PG8_SCHED; PG8_LDA(At, 1, 0); PG8_STAGE(PG8_SA(0, 1), a2 + hstep, voffA);
            PG8_WAIT_V(8); PG8_WAIT_L(0); PG8_BAR; PG8_MMA(0, 0, At, B0); PG8_MMA(0, 1, At, B1); PG8_BAR; PG8_SCHED;
            PG8_LDA(At, 1, 1); PG8_STAGE(PG8_SB(1, 0), b3, voffB); PG8_STAGE(PG8_SB(1, 1), b3 + hstep, voffB); PG8_STAGE(PG8_SA(1, 0), a3, voffA);
            PG8_WAIT_V(8); PG8_WAIT_L(0); PG8_BAR; PG8_MMA(1, 0, At, B0); PG8_MMA(1, 1, At, B1); PG8_BAR; PG8_SCHED;
        }
        if (wr == 0) PG8_BAR;
        E(acc, cur, wr, wc, fr, fq);
        if (!has_next) break;
#pragma unroll
        for (int a = 0; a < 2; ++a)
#pragma unroll
            for (int b = 0; b < 2; ++b)
#pragma unroll
                for (int m = 0; m < 4; ++m)
#pragma unroll
                    for (int n = 0; n < 2; ++n) acc[a][b][m][n] = (f32x4){0.f, 0.f, 0.f, 0.f};
        cur = nxt; cA = nA; cB = nB; ++ui;
        if (wr == 1) PG8_BAR;
    }
    PG8_WAIT_V(0);
    PG8_BAR;
#undef PG8_SA
#undef PG8_SB
#undef PG8_STAGE
#undef PG8_LDA
#undef PG8_LDB
#undef PG8_MMA
#undef PG8_WAIT_V
#undef PG8_WAIT_L
#undef PG8_BAR
#undef PG8_SCHED
}
}

constexpr int D = 1024, NB = 4, SEQ = 8192, CTXL = 256, DFF = 2816, NLAT = NB * SEQ, NCTX = NB * CTXL, MT = NLAT + NCTX;
constexpr float EPS = 1e-6f;
constexpr size_t OFF_HB = 0;
constexpr size_t OFF_AP = OFF_HB + (size_t)MT * D * 2;
constexpr size_t OFF_Y = OFF_AP + (size_t)MT * D * 2;
constexpr size_t OFF_HID = OFF_Y + (size_t)MT * D * 2;
constexpr size_t OFF_W = OFF_HID + (size_t)MT * DFF * 2;
constexpr size_t LW_WIN1 = 0, LW_WOUT1 = 11534336, LW_WINM = 17301504, LW_WOUTM = 21495808, LW_WIN2 = 23592960, LW_WOUT2 = 35127296, LW_TOTAL = 40894464;
constexpr size_t OFF_WG = OFF_W + 2 * LW_TOTAL;
constexpr size_t OFF_SGW = OFF_WG + 524288;
constexpr size_t OFF_MODV = OFF_SGW + 262144;
constexpr size_t OFF_SW = OFF_MODV + 368640;
constexpr size_t OFF_RSQ = OFF_SW + 532480;
constexpr size_t OFF_VST = OFF_RSQ + (size_t)MT * 16 * 4;
constexpr size_t OFF_SUM = OFF_VST + (size_t)MT * 16 * 4;
constexpr size_t OFF_BAR = OFF_SUM + (size_t)264 * 2048 * 4;
constexpr size_t BAR_BYTES = 16384;
constexpr size_t WS_END = OFF_BAR + BAR_BYTES;
constexpr int RSTD_OFF = 131072 + 16;
constexpr int VEC_OFF = RSTD_OFF + 12 * 256 * 4;
constexpr int LDS_BYTES = VEC_OFF + 12288;

struct Params { const float* in[26]; float* out; unsigned char* ws; };
enum { I_X = 0, I_C, I_CTX, I_CCTX, I_WADA, I_BADA, I_G1, I_W1IN, I_W1OUT, I_GMIX, I_WINM, I_CONVW, I_CONVB, I_WR, I_BR, I_WI, I_BI, I_LAM, I_SGN, I_SGW, I_SGB, I_WOUTM, I_G2, I_W2IN, I_W2OUT, I_GF };

__device__ __forceinline__ unsigned pk2(float lo, float hi) { unsigned r; asm("v_cvt_pk_bf16_f32 %0, %1, %2" : "=v"(r) : "v"(lo), "v"(hi)); return r; }
__device__ __forceinline__ float bflo(unsigned w) { return __uint_as_float(w << 16); }
__device__ __forceinline__ float bfhi(unsigned w) { return __uint_as_float(w & 0xffff0000u); }
__device__ __forceinline__ float sigmoidf_(float v) { return __builtin_amdgcn_rcpf(1.0f + __expf(-v)); }

__device__ __forceinline__ void rows_rstd(const LAS float* tab, int ui, int rl0, float (&rstd)[2][4]) {
#pragma unroll
    for (int ai = 0; ai < 2; ++ai)
#pragma unroll
        for (int m = 0; m < 4; ++m) rstd[ai][m] = tab[ui * 256 + rl0 + ai * 128 + m * 16];
}
template <int MODE, class Sched> __device__ __forceinline__ void fill_tabs(LAS unsigned char* lds, const Sched& S, const float* rsq, const float* v0, const float* v1) {
    const int tid = opaque_tid(); LAS float* tab = (LAS float*)(lds + RSTD_OFF); LAS float* vec = (LAS float*)(lds + VEC_OFF);
    for (int i = 0; i < 12; ++i) { pg8::Unit u; if (!S.next(i, u)) break;
        const int s = u.pm < 128 ? (u.pm >> 5) : 4;
        if (MODE != 2) {
            if (tid < 256) { const float* p = rsq + ((size_t)u.pm * 256 + tid) * 16; float t = 0.f;
#pragma unroll
                for (int j = 0; j < 4; ++j) { const f32x4 v = *(const f32x4*)(p + 4 * j); t += (v.x + v.y) + (v.z + v.w); }
                tab[i * 256 + tid] = rsqrtf(t * (1.0f / 1024.0f) + EPS); }
            else { const int t = tid - 256;
                vec[i * 256 + t] = MODE == 1 ? v0[s * 13312 + (t < 128 ? u.pn * 128 + t : 2816 + u.pn * 128 + (t - 128))] : v0[s * 13312 + u.pn * 256 + t]; }
        } else if (u.kc < 0 && i < 6) {
            vec[i * 512 + tid] = tid < 256 ? v0[s * 9216 + u.pn * 256 + tid] : (v1 ? v1[s * 9216 + u.pn * 256 + tid - 256] : 0.f);
        }
    }
    __syncthreads();
}
struct EpiSwiglu {
    static constexpr bool PERM = true;
    const LAS float* rtab; const LAS float* vtab; bf16_t* hid;
    __device__ __forceinline__ void operator()(const f32x4 (&acc)[2][2][4][2], const pg8::Unit& u, int wr, int wc, int fr_, int fq_) const {
        int fr = fr_, fq = fq_; asm volatile("" : "+v"(fr), "+v"(fq));
        const int s = u.pm < 128 ? (u.pm >> 5) : 4;
        const int row0 = u.pm * 256 + wr * 64 + fr, jc = u.pn * 128 + wc * 32 + fq * 8;
        const LAS float* swp = vtab + u.ui * 256 + wc * 32 + fq * 8;
        const f32x4 g0 = *(const LAS f32x4*)swp, g1 = *(const LAS f32x4*)(swp + 4), u0 = *(const LAS f32x4*)(swp + 128), u1 = *(const LAS f32x4*)(swp + 132);
        float rs[2][4]; rows_rstd(rtab, u.ui, wr * 64 + fr, rs);
#pragma unroll
        for (int ai = 0; ai < 2; ++ai)
#pragma unroll
            for (int m = 0; m < 4; ++m) {
                const int row = row0 + ai * 128 + m * 16; const float rstd = rs[ai][m];
                f32x4 g[2], up[2], e[2];
                g[0] = acc[ai][0][m][0] * rstd + g0; g[1] = acc[ai][0][m][1] * rstd + g1; up[0] = acc[ai][1][m][0] * rstd + u0; up[1] = acc[ai][1][m][1] * rstd + u1;
#pragma unroll
                for (int h = 0; h < 2; ++h) { const f32x4 t = g[h] * -1.4426950408889634f;
                    e[h] = (f32x4){__builtin_amdgcn_exp2f(t.x), __builtin_amdgcn_exp2f(t.y), __builtin_amdgcn_exp2f(t.z), __builtin_amdgcn_exp2f(t.w)}; }
#pragma unroll
                for (int h = 0; h < 2; ++h) { const f32x4 d = e[h] + 1.0f;
                    e[h] = (f32x4){__builtin_amdgcn_rcpf(d.x), __builtin_amdgcn_rcpf(d.y), __builtin_amdgcn_rcpf(d.z), __builtin_amdgcn_rcpf(d.w)}; }
#pragma unroll
                for (int h = 0; h < 2; ++h) g[h] = (g[h] * up[h]) * e[h];
                u32x4 w; w.x = pk2(g[0].x, g[0].y); w.y = pk2(g[0].z, g[0].w); w.z = pk2(g[1].x, g[1].y); w.w = pk2(g[1].z, g[1].w);
                *(u32x4*)(hid + (size_t)row * DFF + jc) = w;
            }
    }
};
struct EpiResid {
    static constexpr bool PERM = true;
    bf16_t* hb; const float* gate; const float* gsn; const LAS float* vtab; bf16_t* ap; float* rsq; float* part;
    __device__ __forceinline__ void operator()(const f32x4 (&acc)[2][2][4][2], const pg8::Unit& u, int wr, int wc, int fr_, int fq_) const {
        int fr = fr_, fq = fq_; asm volatile("" : "+v"(fr), "+v"(fq));
        const int cb0 = u.pn * 256 + wc * 32 + fq * 8;
        if (u.kc >= 0) {
            float* pp = part + ((size_t)u.kc * NCTX + (size_t)(u.pm - 128) * 256 + wr * 64 + fr) * D + cb0;
#pragma unroll
            for (int ai = 0; ai < 2; ++ai)
#pragma unroll
                for (int m = 0; m < 4; ++m)
#pragma unroll
                    for (int bj = 0; bj < 2; ++bj) { float* q = pp + (size_t)(ai * 128 + m * 16) * D + bj * 128; *(f32x4*)q = acc[ai][bj][m][0]; *(f32x4*)(q + 4) = acc[ai][bj][m][1]; }
            return;
        }
        const int s = u.pm < 128 ? (u.pm >> 5) : 4;
        f32x4 gt[2][2], gn[2][2];
#pragma unroll
        for (int bj = 0; bj < 2; ++bj) { const LAS float* gp = vtab + u.ui * 512 + bj * 128 + wc * 32 + fq * 8; gt[bj][0] = *(const LAS f32x4*)gp; gt[bj][1] = *(const LAS f32x4*)(gp + 4);
            gn[bj][0] = *(const LAS f32x4*)(gp + 256); gn[bj][1] = *(const LAS f32x4*)(gp + 260); }
        bf16_t* hbase = hb + ((size_t)u.pm * 256 + wr * 64 + fr) * D + cb0;
        u32x4 hv[2][2];
#pragma unroll
        for (int bj = 0; bj < 2; ++bj) hv[0][bj] = *(const u32x4*)(hbase + bj * 128);
#pragma unroll
        for (int it = 0; it < 8; ++it) {
            const int ai = it >> 2, m = it & 3;
            const size_t roff = (size_t)(ai * 128 + m * 16) * D; const size_t grow = (size_t)u.pm * 256 + ai * 128 + wr * 64 + m * 16 + fr;
            if (it < 7) { const size_t rn = (size_t)(((it + 1) >> 2) * 128 + ((it + 1) & 3) * 16) * D;
#pragma unroll
                for (int bj = 0; bj < 2; ++bj) hv[(it + 1) & 1][bj] = *(const u32x4*)(hbase + rn + bj * 128); }
            float sq = 0.f;
#pragma unroll
            for (int bj = 0; bj < 2; ++bj) {
                const u32x4 r = hv[it & 1][bj];
                const f32x4 o0 = (f32x4){bflo(r.x), bfhi(r.x), bflo(r.y), bfhi(r.y)}, o1 = (f32x4){bflo(r.z), bfhi(r.z), bflo(r.w), bfhi(r.w)};
                const f32x4 n0 = o0 + gt[bj][0] * acc[ai][bj][m][0], n1 = o1 + gt[bj][1] * acc[ai][bj][m][1];
                u32x4 hw; hw.x = pk2(n0.x, n0.y); hw.y = pk2(n0.z, n0.w); hw.z = pk2(n1.x, n1.y); hw.w = pk2(n1.z, n1.w);
                *(u32x4*)(hbase + roff + bj * 128) = hw;
                sq += (n0.x * n0.x + n0.y * n0.y) + (n0.z * n0.z + n0.w * n0.w) + (n1.x * n1.x + n1.y * n1.y) + (n1.z * n1.z + n1.w * n1.w);
                if (gsn) { const f32x4 a0 = n0 * gn[bj][0], a1 = n1 * gn[bj][1]; u32x4 w; w.x = pk2(a0.x, a0.y); w.y = pk2(a0.z, a0.w); w.z = pk2(a1.x, a1.y); w.w = pk2(a1.z, a1.w);
                    *(u32x4*)(ap + grow * D + cb0 + bj * 128) = w; }
            }
            sq += __shfl_xor(sq, 16); sq += __shfl_xor(sq, 32);
            if (fq == 0) rsq[grow * 16 + u.pn * 4 + wc] = sq;
        }
    }
};
struct EpiInproj {
    static constexpr bool PERM = true;
    const LAS float* rtab; const LAS float* vtab; bf16_t* p; float* vst;
    __device__ __forceinline__ void operator()(const f32x4 (&acc)[2][2][4][2], const pg8::Unit& u, int wr, int wc, int fr_, int fq_) const {
        int fr = fr_, fq = fq_; asm volatile("" : "+v"(fr), "+v"(fq));
        const int s = u.pm < 128 ? (u.pm >> 5) : 4;
        const int row0 = u.pm * 256 + wr * 64 + fr, cb0 = u.pn * 256 + wc * 32 + fq * 8;
        f32x4 sw[2][2];
#pragma unroll
        for (int bj = 0; bj < 2; ++bj) { const LAS float* sp = vtab + u.ui * 256 + bj * 128 + wc * 32 + fq * 8; sw[bj][0] = *(const LAS f32x4*)sp; sw[bj][1] = *(const LAS f32x4*)(sp + 4); }
        const bool isv = u.pn >= 6;
        float rs[2][4]; rows_rstd(rtab, u.ui, wr * 64 + fr, rs);
#pragma unroll
        for (int ai = 0; ai < 2; ++ai)
#pragma unroll
            for (int m = 0; m < 4; ++m) {
                const int row = row0 + ai * 128 + m * 16; const float rstd = rs[ai][m];
                float sm = 0.f, sq = 0.f;
#pragma unroll
                for (int bj = 0; bj < 2; ++bj) {
                    const f32x4 v0 = acc[ai][bj][m][0] * rstd + sw[bj][0], v1 = acc[ai][bj][m][1] * rstd + sw[bj][1];
                    u32x4 w; w.x = pk2(v0.x, v0.y); w.y = pk2(v0.z, v0.w); w.z = pk2(v1.x, v1.y); w.w = pk2(v1.z, v1.w);
                    *(u32x4*)(p + (size_t)row * 2048 + cb0 + bj * 128) = w;
                    sm += (v0.x + v0.y) + (v0.z + v0.w) + (v1.x + v1.y) + (v1.z + v1.w);
                    sq += (v0.x * v0.x + v0.y * v0.y) + (v0.z * v0.z + v0.w * v0.w) + (v1.x * v1.x + v1.y * v1.y) + (v1.z * v1.z + v1.w * v1.w);
                }
                if (isv) { sm += __shfl_xor(sm, 16); sm += __shfl_xor(sm, 32); sq += __shfl_xor(sq, 16); sq += __shfl_xor(sq, 32);
                    if (fq == 0) { float* vp = vst + (size_t)row * 16 + ((u.pn - 6) * 4 + wc) * 2; vp[0] = sm; vp[1] = sq; } }
            }
    }
};

__device__ __forceinline__ void gemv5_partial(const float* __restrict__ W, int ldw, int col, int k0, const LAS float* vin, float (&acc)[5]) {
#pragma unroll
    for (int s = 0; s < 5; ++s) acc[s] = 0.f;
#pragma unroll 32
    for (int k = k0; k < k0 + 128; ++k) { const float w = W[(size_t)k * ldw + col];
#pragma unroll
        for (int s = 0; s < 5; ++s) acc[s] += vin[s * 1024 + k] * w; }
}
__device__ __forceinline__ void adaln_item(const Params& P, int it, LAS unsigned char* lds) {
    const int tid = opaque_tid(), w = tid >> 6, lane = tid & 63;
    LAS float* vin = (LAS float*)lds; LAS float* red = (LAS float*)(lds + 20480);
    const int l = it / 144, c0 = (it % 144) * 64;
    for (int idx = tid; idx < 5120; idx += 512) { const int s = idx >> 10, k = idx & 1023; const float cv = s < 4 ? P.in[I_C][s * 1024 + k] : P.in[I_CCTX][k]; vin[idx] = cv / (1.0f + __expf(-cv)); }
    __syncthreads();
    float acc[5]; gemv5_partial(P.in[I_WADA] + (size_t)l * 1024 * 9216, 9216, c0 + lane, w * 128, vin, acc);
#pragma unroll
    for (int s = 0; s < 5; ++s) red[(w * 5 + s) * 64 + lane] = acc[s];
    __syncthreads();
    if (tid < 320) { const int s = tid >> 6; float m = 0.f;
#pragma unroll
        for (int v = 0; v < 8; ++v) m += red[(v * 5 + s) * 64 + lane];
        const int n = c0 + lane, chunk = n >> 10, k = n & 1023; m += P.in[I_BADA][l * 9216 + n];
        float val = m;
        if (chunk == 1) val = P.in[I_G1][l * 1024 + k] * (1.0f + m); else if (chunk == 4) val = P.in[I_GMIX][l * 1024 + k] * (1.0f + m); else if (chunk == 7) val = P.in[I_G2][l * 1024 + k] * (1.0f + m);
        else if (chunk == 2 || chunk == 8) val = 0.5f * m;
        ((float*)(P.ws + OFF_MODV))[((l * 5 + s) * 9 + chunk) * 1024 + k] = val; }
    __syncthreads();
}
__device__ __forceinline__ void shiftw_item(const Params& P, int it, LAS unsigned char* lds) {
    const int tid = opaque_tid(), w = tid >> 6, lane = tid & 63;
    LAS float* vin = (LAS float*)lds; LAS float* red = (LAS float*)(lds + 20480);
    const int l = it / 208; int r = it % 208; const float* W; int ldw, c0, off, chunk;
    if (r < 88) { W = P.in[I_W1IN] + (size_t)l * 1024 * 5632; ldw = 5632; c0 = r * 64; off = 0; chunk = 0; }
    else if (r < 120) { W = P.in[I_WINM] + (size_t)l * 1024 * 2048; ldw = 2048; c0 = (r - 88) * 64; off = 5632; chunk = 3; }
    else { W = P.in[I_W2IN] + (size_t)l * 1024 * 5632; ldw = 5632; c0 = (r - 120) * 64; off = 7680; chunk = 6; }
    const float* modv = (const float*)(P.ws + OFF_MODV);
    for (int idx = tid; idx < 5120; idx += 512) { const int s = idx >> 10, k = idx & 1023; vin[idx] = modv[((l * 5 + s) * 9 + chunk) * 1024 + k]; }
    __syncthreads();
    float acc[5]; gemv5_partial(W, ldw, c0 + lane, w * 128, vin, acc);
#pragma unroll
    for (int s = 0; s < 5; ++s) red[(w * 5 + s) * 64 + lane] = acc[s];
    __syncthreads();
    if (tid < 320) { const int s = tid >> 6; float m = 0.f;
#pragma unroll
        for (int v = 0; v < 8; ++v) m += red[(v * 5 + s) * 64 + lane];
        ((float*)(P.ws + OFF_SW))[(l * 5 + s) * 13312 + off + c0 + lane] = m; }
    __syncthreads();
}
__device__ __forceinline__ void transpose_item(const Params& P, int it, LAS float* scr, int lane) {
    const int l = it / 9984; int r = it % 9984; const float* W; int K, N; size_t dst; bool perm = false;
    if (r < 2816) { W = P.in[I_W1IN] + (size_t)l * 1024 * 5632; K = 1024; N = 5632; dst = LW_WIN1; perm = true; }
    else if ((r -= 2816) < 1408) { W = P.in[I_W1OUT] + (size_t)l * 2816 * 1024; K = 2816; N = 1024; dst = LW_WOUT1; }
    else if ((r -= 1408) < 1024) { W = P.in[I_WINM] + (size_t)l * 1024 * 2048; K = 1024; N = 2048; dst = LW_WINM; }
    else if ((r -= 1024) < 512) { W = P.in[I_WOUTM] + (size_t)l * 1024 * 1024; K = 1024; N = 1024; dst = LW_WOUTM; }
    else if ((r -= 512) < 2816) { W = P.in[I_W2IN] + (size_t)l * 1024 * 5632; K = 1024; N = 5632; dst = LW_WIN2; perm = true; }
    else { r -= 2816; W = P.in[I_W2OUT] + (size_t)l * 2816 * 1024; K = 2816; N = 1024; dst = LW_WOUT2; }
    const int ntn = N / 32, k0 = (r / ntn) * 64, n0 = (r % ntn) * 32;
    const int r0 = perm ? (((n0 % 2816) / 128) * 256 + (n0 / 2816) * 128 + (n0 % 128)) : n0;
    bf16_t* Bt = (bf16_t*)(P.ws + OFF_W + (size_t)l * LW_TOTAL + dst);
    float v[32];
#pragma unroll
    for (int i = 0; i < 32; ++i) { const int kk = 2 * i + (lane >> 5); v[i] = W[(size_t)(k0 + kk) * N + n0 + (lane & 31)]; }
#pragma unroll
    for (int i = 0; i < 32; ++i) { const int kk = 2 * i + (lane >> 5); scr[kk * 33 + (lane & 31)] = v[i]; }
    asm volatile("s_waitcnt lgkmcnt(0)" ::: "memory");
    const int c = lane & 7;
#pragma unroll
    for (int j = 0; j < 4; ++j) { const int n = (lane >> 3) + 8 * j; const LAS float* t = scr + (8 * c) * 33 + n;
        u32x4 o; o.x = pk2(t[0], t[33]); o.y = pk2(t[66], t[99]); o.z = pk2(t[132], t[165]); o.w = pk2(t[198], t[231]);
        *(u32x4*)(Bt + (size_t)(r0 + n) * K + k0 + 8 * c) = o; }
    asm volatile("s_waitcnt lgkmcnt(0)" ::: "memory");
}
__device__ __forceinline__ void prep_item2(const Params& P, int rowA, int rowB, bool hasB, int lane) {
    const int rows[2] = {rowA, hasB ? rowB : rowA};
    f32x4 v[2][4], g[2][4];
#pragma unroll
    for (int q = 0; q < 2; ++q) { const int row = rows[q]; const int s = row < NLAT ? (row >> 13) : 4;
        const float* src = row < NLAT ? P.in[I_X] + (size_t)row * D : P.in[I_CTX] + (size_t)(row - NLAT) * D;
        const float* gs = (const float*)(P.ws + OFF_MODV) + ((0 * 5 + s) * 9 + 1) * 1024;
#pragma unroll
        for (int j = 0; j < 4; ++j) { const int c = (lane + 64 * j) * 4; v[q][j] = *(const f32x4*)(src + c); g[q][j] = *(const f32x4*)(gs + c); } }
#pragma unroll
    for (int q = 0; q < 2; ++q) { if (q == 1 && !hasB) break; const int row = rows[q];
        bf16_t* ap = (bf16_t*)(P.ws + OFF_AP) + (size_t)row * D; bf16_t* hbp = (bf16_t*)(P.ws + OFF_HB) + (size_t)row * D;
        float sq = 0.f;
#pragma unroll
        for (int j = 0; j < 4; ++j) { const int c = (lane + 64 * j) * 4; const f32x4 x = v[q][j], gg = g[q][j];
            sq += (x.x * x.x + x.y * x.y) + (x.z * x.z + x.w * x.w);
            u32x2 o; o.x = pk2(x.x * gg.x, x.y * gg.y); o.y = pk2(x.z * gg.z, x.w * gg.w); *(u32x2*)(ap + c) = o;
            u32x2 hh; hh.x = pk2(x.x, x.y); hh.y = pk2(x.z, x.w); *(u32x2*)(hbp + c) = hh; }
#pragma unroll
        for (int o = 1; o < 64; o <<= 1) sq += __shfl_xor(sq, o);
        if (lane < 16) ((float*)(P.ws + OFF_RSQ))[(size_t)row * 16 + lane] = lane == 0 ? sq : 0.f; }
}
__device__ __forceinline__ void final_item(const Params& P, int it) {
    const int tid = opaque_tid(), w = tid >> 6, lane = tid & 63;
    const float* g = P.in[I_GF];
    u32x2 r[2][4]; f32x4 gg[4]; float t[2];
#pragma unroll
    for (int j = 0; j < 4; ++j) gg[j] = *(const f32x4*)(g + (lane + 64 * j) * 4);
#pragma unroll
    for (int q = 0; q < 2; ++q) { const int row = it * 16 + 2 * w + q;
        t[q] = ((const float*)(P.ws + OFF_RSQ))[(size_t)row * 16 + (lane & 15)];
        const bf16_t* hp = (const bf16_t*)(P.ws + OFF_HB) + (size_t)row * D;
#pragma unroll
        for (int j = 0; j < 4; ++j) r[q][j] = *(const u32x2*)(hp + (lane + 64 * j) * 4); }
#pragma unroll
    for (int q = 0; q < 2; ++q) { const int row = it * 16 + 2 * w + q; float tt = t[q];
        tt += __shfl_xor(tt, 1); tt += __shfl_xor(tt, 2); tt += __shfl_xor(tt, 4); tt += __shfl_xor(tt, 8);
        const float rstd = rsqrtf(tt * (1.0f / 1024.0f) + EPS);
        float* op = P.out + (size_t)row * D;
#pragma unroll
        for (int j = 0; j < 4; ++j) { const int c = (lane + 64 * j) * 4; *(f32x4*)(op + c) = (f32x4){bflo(r[q][j].x), bfhi(r[q][j].x), bflo(r[q][j].y), bfhi(r[q][j].y)} * rstd * gg[j]; } }
}

__device__ __forceinline__ void ctx_fix_row(const Params& P, int r, int lane, int ks, const float* part, const float* gate, const float* gsn) {
    const int c0 = lane * 16; const size_t grow = (size_t)NLAT + r;
    f32x4 sum[4];
#pragma unroll
    for (int i = 0; i < 4; ++i) sum[i] = (f32x4){0.f, 0.f, 0.f, 0.f};
    for (int k = 0; k < ks; ++k) { const float* pp = part + ((size_t)k * NCTX + r) * D + c0;
#pragma unroll
        for (int i = 0; i < 4; ++i) sum[i] += *(const f32x4*)(pp + 4 * i); }
    bf16_t* hp = (bf16_t*)(P.ws + OFF_HB) + grow * D + c0; bf16_t* ap = (bf16_t*)(P.ws + OFF_AP) + grow * D + c0;
    const u32x4 h0 = *(const u32x4*)hp, h1 = *(const u32x4*)(hp + 8);
    const unsigned hw[8] = {h0.x, h0.y, h0.z, h0.w, h1.x, h1.y, h1.z, h1.w};
    float n[16]; float sq = 0.f;
#pragma unroll
    for (int i = 0; i < 4; ++i) { const f32x4 g = *(const f32x4*)(gate + 4 * 9216 + c0 + 4 * i);
        n[4 * i] = bflo(hw[2 * i]) + g.x * sum[i].x; n[4 * i + 1] = bfhi(hw[2 * i]) + g.y * sum[i].y; n[4 * i + 2] = bflo(hw[2 * i + 1]) + g.z * sum[i].z; n[4 * i + 3] = bfhi(hw[2 * i + 1]) + g.w * sum[i].w; }
#pragma unroll
    for (int i = 0; i < 16; ++i) sq += n[i] * n[i];
    u32x4 o0, o1; o0.x = pk2(n[0], n[1]); o0.y = pk2(n[2], n[3]); o0.z = pk2(n[4], n[5]); o0.w = pk2(n[6], n[7]); o1.x = pk2(n[8], n[9]); o1.y = pk2(n[10], n[11]); o1.z = pk2(n[12], n[13]); o1.w = pk2(n[14], n[15]);
    *(u32x4*)hp = o0; *(u32x4*)(hp + 8) = o1;
    if (gsn) {
#pragma unroll
        for (int i = 0; i < 4; ++i) { const f32x4 g = *(const f32x4*)(gsn + 4 * 9216 + c0 + 4 * i); n[4 * i] *= g.x; n[4 * i + 1] *= g.y; n[4 * i + 2] *= g.z; n[4 * i + 3] *= g.w; }
        o0.x = pk2(n[0], n[1]); o0.y = pk2(n[2], n[3]); o0.z = pk2(n[4], n[5]); o0.w = pk2(n[6], n[7]); o1.x = pk2(n[8], n[9]); o1.y = pk2(n[10], n[11]); o1.z = pk2(n[12], n[13]); o1.w = pk2(n[14], n[15]);
        *(u32x4*)ap = o0; *(u32x4*)(ap + 8) = o1; }
    sq += __shfl_xor(sq, 1); sq += __shfl_xor(sq, 2);
    if ((lane & 3) == 0) ((float*)(P.ws + OFF_RSQ))[grow * 16 + (lane >> 2)] = sq;
}

__device__ __forceinline__ void tile_info(int tix, int& row0, int& pos0, int& L, int& b) {
    if (tix < 256) { b = tix >> 6; pos0 = (tix & 63) * 128; row0 = b * SEQ + pos0; L = SEQ; }
    else { const int c = tix - 256; b = c >> 1; pos0 = (c & 1) * 128; row0 = NLAT + b * CTXL + pos0; L = CTXL; }
}
constexpr int SC_WG_OFF = 0, SC_CW_OFF = 36864, SC_CAR_OFF = 38144, SC_WCOMP_OFF = 42752, SC_XL_OFF = 50944, SC_GL_OFF = 67840, SC_XC_OFF = 84224;
struct ScanPre { u32x4 x[3]; u32x4 g[2]; u32x4 cf[8]; };
constexpr size_t COEF_ITEM = 65536, COEF_TAIL_ITEMS = 264;
__device__ __forceinline__ u32x4* coef_base(const Params& P, int item) {
    const size_t off = item < 1056 ? OFF_AP + (size_t)item * COEF_ITEM : (item < 1848 ? OFF_HID + (size_t)MT * 2048 * 2 + (size_t)(item - 1056) * COEF_ITEM : WS_END + (size_t)(item - 1848) * COEF_ITEM);
    return (u32x4*)(P.ws + off);
}
__device__ __forceinline__ void scan_prefetch(ScanPre& R, const Params& P, const bf16_t* pb, int tix, int h, int tid, bool final_mode) {
    int row0, pos0, L, b; tile_info(tix, row0, pos0, L, b);
    if (!final_mode) {
#pragma unroll
        for (int i = 0; i < 3; ++i) { const int idx = tid + 512 * i, r = idx >> 3, pc = idx & 7, pos = pos0 - 2 + r; R.x[i] = (u32x4){0u, 0u, 0u, 0u};
            if (idx < 131 * 8 && pos >= 0 && pos < L) R.x[i] = *(const u32x4*)(pb + (size_t)(row0 - 2 + r) * 2048 + h * 64 + pc * 8); }
    } else {
#pragma unroll
        for (int i = 0; i < 2; ++i) { const int idx = tid + 512 * i, r = idx >> 3, pc = idx & 7; R.g[i] = *(const u32x4*)(pb + (size_t)(row0 + r) * 2048 + 512 + h * 64 + pc * 8); }
        const u32x4* cb = coef_base(P, tix * 8 + h) + tid;
#pragma unroll
        for (int i = 0; i < 8; ++i) R.cf[i] = cb[i * 512];
    }
}
__device__ __forceinline__ void scan_group(const Params& P, int l, int wgI, bool final_mode, bool with_ctx, LAS unsigned char* lds) {
    const int tid = opaque_tid(), w = __builtin_amdgcn_readfirstlane(tid >> 6), lane = tid & 63, fr = lane & 15, fq = lane >> 4;
    const int h = wgI & 7, grp = wgI >> 3, gb = grp >> 3, j0 = (grp & 7) * 8;
    const int ctix = 256 + (wgI >> 3);
    const bool has_ctx = with_ctx && wgI < 64;
    const bf16_t* pb = (const bf16_t*)(P.ws + OFF_HID);
    float* summ = (float*)(P.ws + OFF_SUM);
    LAS f32x2* wcomp = (LAS f32x2*)(lds + SC_WCOMP_OFF); LAS float* car = (LAS float*)(lds + SC_CAR_OFF); LAS float* cw = (LAS float*)(lds + SC_CW_OFF);
    __syncthreads();
    if (!final_mode) { const bf16_t* wg = (const bf16_t*)(P.ws + OFF_WG);
      for (int idx = tid; idx < 2048; idx += 512) { const int mat = idx >> 9, e = (idx >> 3) & 63, pc = idx & 7;
          *(LAS u32x4*)(lds + SC_WG_OFF + (mat * 64 + e) * 144 + pc * 16) = *(const u32x4*)(wg + ((size_t)((l * 2 + (mat >> 1)) * 2 + (mat & 1)) * 8 + h) * 4096 + e * 64 + pc * 8); }
      if (tid < 320) { const int k = tid >> 6, ch = tid & 63; cw[tid] = k < 4 ? P.in[I_CONVW][(l * 4 + k) * 512 + h * 64 + ch] : P.in[I_CONVB][l * 512 + h * 64 + ch]; } }
    float brv[2][4], biv[2][4], sp8[2][4];
#pragma unroll
    for (int dir = 0; dir < 2; ++dir)
#pragma unroll
        for (int eb = 0; eb < 4; ++eb) { const int pidx = (l * 2 + dir) * 512 + h * 64 + eb * 16 + fr;
            brv[dir][eb] = -1.4426950408889634f * P.in[I_BR][pidx]; biv[dir][eb] = -1.4426950408889634f * P.in[I_BI][pidx]; sp8[dir][eb] = 8.0f * 1.4426950408889634f * log1pf(__expf(-P.in[I_LAM][pidx])); }
    if (final_mode) {
        LAS float* T = (LAS float*)(lds + SC_XL_OFF);
        { float tv[33];
#pragma unroll
          for (int i = 0; i < 33; ++i) { const int idx = tid + 512 * i; const int ch = idx & 63, ab = (idx >> 6) & 1, dir = (idx >> 7) & 1, k = idx >> 8;
              const int t = k < 2 ? 256 + 2 * gb + (dir == 0 ? k : 1 - k) : gb * 64 + (dir == 0 ? (k - 2) : (63 - (k - 2)));
              tv[i] = summ[((size_t)(t * 2 + dir) * 2 + ab) * 512 + h * 64 + ch]; }
#pragma unroll
          for (int i = 0; i < 33; ++i) { const int idx = tid + 512 * i; const int ch = idx & 63, ab = (idx >> 6) & 1, dir = (idx >> 7) & 1, k = idx >> 8;
              T[((dir * 66 + k) * 2 + ab) * 64 + ch] = tv[i]; } }
        __syncthreads();
        if (tid < 128) { const int dir = tid >> 6, ch = tid & 63; float s = 0.f;
#pragma unroll 6
            for (int k = 0; k < 66; ++k) {
                if (k >= 2) { const int i = (dir == 0 ? (k - 2) : (63 - (k - 2))) - j0; if (i >= 0 && i < 8) car[(dir * 9 + i) * 64 + ch] = s; }
                s = T[((dir * 66 + k) * 2 + 0) * 64 + ch] * s + T[((dir * 66 + k) * 2 + 1) * 64 + ch]; }
            float cs = 0.f;
            if (has_ctx) { const int cj = (ctix - 256) & 1; if (dir == 0 && cj == 1) cs = summ[((size_t)((ctix - 1) * 2 + 0) * 2 + 1) * 512 + h * 64 + ch]; if (dir == 1 && cj == 0) cs = summ[((size_t)((ctix + 1) * 2 + 1) * 2 + 1) * 512 + h * 64 + ch]; }
            car[(dir * 9 + 8) * 64 + ch] = cs; }
        __syncthreads();
    }
    const int nitems = 8 + (has_ctx ? 1 : 0);
    ScanPre R; scan_prefetch(R, P, pb, grp * 8, h, tid, final_mode);
#pragma unroll 1
    for (int it = 0; it < nitems; ++it) {
        const int tix = it < 8 ? grp * 8 + it : ctix;
        int row0, pos0, L, b; tile_info(tix, row0, pos0, L, b);
        if (!final_mode) {
#pragma unroll
        for (int i = 0; i < 3; ++i) { const int idx = tid + 512 * i; if (idx < 131 * 8) *(LAS u32x4*)(lds + SC_XL_OFF + (idx >> 3) * 128 + (idx & 7) * 16) = R.x[i]; }
        } else {
#pragma unroll
            for (int i = 0; i < 2; ++i) { const int idx = tid + 512 * i; *(LAS u32x4*)(lds + SC_GL_OFF + (idx >> 3) * 128 + (idx & 7) * 16) = R.g[i]; } }
        __syncthreads();
        if (it + 1 < nitems && !final_mode) scan_prefetch(R, P, pb, it + 1 < 8 ? grp * 8 + it + 1 : ctix, h, tid, final_mode);
        if (!final_mode) { const int q = tid >> 2, c4 = tid & 3; float a[16];
#pragma unroll
          for (int i = 0; i < 4; ++i) { const f32x4 bv = *(const LAS f32x4*)(cw + 256 + c4 * 16 + 4 * i); a[4 * i] = bv.x; a[4 * i + 1] = bv.y; a[4 * i + 2] = bv.z; a[4 * i + 3] = bv.w; }
#pragma unroll
          for (int k = 0; k < 4; ++k) {
              const u32x4 x0 = *(const LAS u32x4*)(lds + SC_XL_OFF + (q + k) * 128 + c4 * 32), x1 = *(const LAS u32x4*)(lds + SC_XL_OFF + (q + k) * 128 + c4 * 32 + 16);
              const unsigned xs[8] = {x0.x, x0.y, x0.z, x0.w, x1.x, x1.y, x1.z, x1.w};
#pragma unroll
              for (int i = 0; i < 4; ++i) { const f32x4 wv = *(const LAS f32x4*)(cw + k * 64 + c4 * 16 + 4 * i);
                  a[4 * i] += wv.x * bflo(xs[2 * i]); a[4 * i + 1] += wv.y * bfhi(xs[2 * i]); a[4 * i + 2] += wv.z * bflo(xs[2 * i + 1]); a[4 * i + 3] += wv.w * bfhi(xs[2 * i + 1]); } }
          LAS float* xo = (LAS float*)(lds + SC_XC_OFF + q * 272 + c4 * 64);
#pragma unroll
          for (int i = 0; i < 4; ++i) *(LAS f32x4*)(xo + 4 * i) = (f32x4){a[4 * i], a[4 * i + 1], a[4 * i + 2], a[4 * i + 3]}; }
        __syncthreads();
        bf16x8 af[2] = {};
        if (!final_mode) {
#pragma unroll
        for (int ks = 0; ks < 2; ++ks) { const LAS float* xr = (const LAS float*)(lds + SC_XC_OFF + (16 * w + fr) * 272) + ks * 32 + fq * 8;
            const f32x4 v0 = *(const LAS f32x4*)xr, v1 = *(const LAS f32x4*)(xr + 4);
            u32x4 t; t.x = pk2(v0.x, v0.y); t.y = pk2(v0.z, v0.w); t.z = pk2(v1.x, v1.y); t.w = pk2(v1.z, v1.w); af[ks] = __builtin_bit_cast(bf16x8, t); }
        }
        float ca[2][4][4], cbv[2][4][4], Ae[2][4], Be[2][4];
#pragma unroll
        for (int dir = 0; dir < 2; ++dir) {
#pragma unroll
            for (int eb = 0; eb < 4; ++eb) {
              if (!final_mode) {
                f32x4 pr = (f32x4){0.f, 0.f, 0.f, 0.f}, pi = pr;
#pragma unroll
                for (int ks = 0; ks < 2; ++ks) {
                    const bf16x8 br = *(const LAS bf16x8*)(lds + SC_WG_OFF + ((dir * 2 + 0) * 64 + eb * 16 + fr) * 144 + ks * 64 + fq * 16);
                    const bf16x8 bi = *(const LAS bf16x8*)(lds + SC_WG_OFF + ((dir * 2 + 1) * 64 + eb * 16 + fr) * 144 + ks * 64 + fq * 16);
                    pr = __builtin_amdgcn_mfma_f32_16x16x32_bf16(af[ks], br, pr, 0, 0, 0);
                    pi = __builtin_amdgcn_mfma_f32_16x16x32_bf16(af[ks], bi, pi, 0, 0, 0);
                }
                float la[4], ig[4], xv[4];
#pragma unroll
                for (int j = 0; j < 4; ++j) {
                    const float r = __builtin_amdgcn_rcpf(1.0f + __builtin_amdgcn_exp2f(pr[j] + brv[dir][eb])); ig[j] = __builtin_amdgcn_rcpf(1.0f + __builtin_amdgcn_exp2f(pi[j] + biv[dir][eb]));
                    xv[j] = *(const LAS float*)(lds + SC_XC_OFF + (16 * w + 4 * fq + j) * 272 + (eb * 16 + fr) * 4);
                    la[j] = -r * sp8[dir][eb]; }
                u32x4 pk; pk.x = pk2(la[0], la[1]); pk.y = pk2(la[2], la[3]);
                la[0] = bflo(pk.x); la[1] = bfhi(pk.x); la[2] = bflo(pk.y); la[3] = bfhi(pk.y);
                float bq[4];
#pragma unroll
                for (int j = 0; j < 4; ++j) { const float av = __builtin_amdgcn_exp2f(la[j]); ca[dir][eb][j] = av;
                    bq[j] = __builtin_amdgcn_sqrtf(__builtin_fmaf(-av, av, 1.0f)) * ig[j] * xv[j]; }
                pk.z = pk2(bq[0], bq[1]); pk.w = pk2(bq[2], bq[3]);
                cbv[dir][eb][0] = bflo(pk.z); cbv[dir][eb][1] = bfhi(pk.z); cbv[dir][eb][2] = bflo(pk.w); cbv[dir][eb][3] = bfhi(pk.w);
                coef_base(P, tix * 8 + h)[(dir * 4 + eb) * 512 + tid] = pk;
              } else {
                const u32x4 pk = R.cf[dir * 4 + eb];
                ca[dir][eb][0] = __builtin_amdgcn_exp2f(bflo(pk.x)); ca[dir][eb][1] = __builtin_amdgcn_exp2f(bfhi(pk.x)); ca[dir][eb][2] = __builtin_amdgcn_exp2f(bflo(pk.y)); ca[dir][eb][3] = __builtin_amdgcn_exp2f(bfhi(pk.y));
                cbv[dir][eb][0] = bflo(pk.z); cbv[dir][eb][1] = bfhi(pk.z); cbv[dir][eb][2] = bflo(pk.w); cbv[dir][eb][3] = bfhi(pk.w);
              }
                float A = 1.f, B = 0.f;
                if (dir == 0) {
#pragma unroll
                    for (int j = 0; j < 4; ++j) { B = ca[dir][eb][j] * B + cbv[dir][eb][j]; A *= ca[dir][eb][j]; }
                    float Ap = __shfl_up(A, 16), Bp = __shfl_up(B, 16); if (fq >= 1) { B = A * Bp + B; A = A * Ap; }
                    Ap = __shfl_up(A, 32); Bp = __shfl_up(B, 32); if (fq >= 2) { B = A * Bp + B; A = A * Ap; }
                    float ae = __shfl_up(A, 16), be = __shfl_up(B, 16); if (fq == 0) { ae = 1.f; be = 0.f; }
                    Ae[dir][eb] = ae; Be[dir][eb] = be;
                    if (fq == 3) wcomp[(0 * 8 + w) * 64 + eb * 16 + fr] = (f32x2){A, B};
                } else {
#pragma unroll
                    for (int j = 3; j >= 0; --j) { B = ca[dir][eb][j] * B + cbv[dir][eb][j]; A *= ca[dir][eb][j]; }
                    float Ap = __shfl_down(A, 16), Bp = __shfl_down(B, 16); if (fq <= 2) { B = A * Bp + B; A = A * Ap; }
                    Ap = __shfl_down(A, 32); Bp = __shfl_down(B, 32); if (fq <= 1) { B = A * Bp + B; A = A * Ap; }
                    float ae = __shfl_down(A, 16), be = __shfl_down(B, 16); if (fq == 3) { ae = 1.f; be = 0.f; }
                    Ae[dir][eb] = ae; Be[dir][eb] = be;
                    if (fq == 0) wcomp[(1 * 8 + w) * 64 + eb * 16 + fr] = (f32x2){A, B};
                }
            }
        }
        if (final_mode && it + 1 < nitems) scan_prefetch(R, P, pb, it + 1 < 8 ? grp * 8 + it + 1 : ctix, h, tid, final_mode);
        __syncthreads();
        if (!final_mode) {
            if (w == 0) {
                float A = 1.f, B = 0.f;
#pragma unroll
                for (int v = 0; v < 8; ++v) { const f32x2 cv = wcomp[(0 * 8 + v) * 64 + lane]; B = cv.x * B + cv.y; A = cv.x * A; }
                float* sp = summ + ((size_t)(tix * 2 + 0) * 2) * 512 + h * 64 + lane; sp[0] = A; sp[512] = B;
                A = 1.f; B = 0.f;
#pragma unroll
                for (int v = 7; v >= 0; --v) { const f32x2 cv = wcomp[(1 * 8 + v) * 64 + lane]; B = cv.x * B + cv.y; A = cv.x * A; }
                sp = summ + ((size_t)(tix * 2 + 1) * 2) * 512 + h * 64 + lane; sp[0] = A; sp[512] = B;
            }
        } else {
#pragma unroll
            for (int eb = 0; eb < 4; ++eb) {
                const int c = eb * 16 + fr;
                float s = car[(0 * 9 + it) * 64 + c];
#pragma unroll
                for (int v = 0; v < 7; ++v) { const f32x2 cv = wcomp[(0 * 8 + v) * 64 + c]; if (v < w) s = cv.x * s + cv.y; }
                s = Ae[0][eb] * s + Be[0][eb];
                float hf[4];
#pragma unroll
                for (int j = 0; j < 4; ++j) { s = ca[0][eb][j] * s + cbv[0][eb][j]; hf[j] = s; }
                s = car[(1 * 9 + it) * 64 + c];
#pragma unroll
                for (int v = 7; v > 0; --v) { const f32x2 cv = wcomp[(1 * 8 + v) * 64 + c]; if (v > w) s = cv.x * s + cv.y; }
                s = Ae[1][eb] * s + Be[1][eb];
#pragma unroll
                for (int j = 3; j >= 0; --j) { s = ca[1][eb][j] * s + cbv[1][eb][j]; hf[j] += s; }
#pragma unroll
                for (int j = 0; j < 4; ++j) {
                    const int q = 16 * w + 4 * fq + j;
                    const float g = bflo((unsigned)*(const LAS bf16_t*)(lds + SC_GL_OFF + q * 128 + c * 2));
                    const float ge = g * sigmoidf_(1.5957691216f * (g + 0.044715f * g * g * g));
                    *(LAS bf16_t*)(lds + SC_XC_OFF + q * 128 + c * 2) = (bf16_t)(pk2(hf[j] * ge, 0.f) & 0xffffu);
                }
            }
            __syncthreads();
            bf16_t* yb = (bf16_t*)(P.ws + OFF_Y);
#pragma unroll
            for (int i = 0; i < 2; ++i) { const int idx = tid + 512 * i, r = idx >> 3, pc = idx & 7;
                *(u32x4*)(yb + (size_t)(row0 + r) * D + h * 64 + pc * 8) = *(const LAS u32x4*)(lds + SC_XC_OFF + r * 128 + pc * 16); }
        }
    }
}
constexpr int ST_OFF = 0, VT_OFF = 1024;
struct SguPre { f32x4 st[2][4]; u32x4 rv[2][2]; u32x2 uu[8]; };
__device__ __forceinline__ void sgu_prefetch(SguPre& R, const Params& P, int tix, int g, int w, int lane) {
    const int fr = lane & 15, fq = lane >> 4, qp = lane;
    int row0, pos0, L, b; tile_info(tix, row0, pos0, L, b);
    const bf16_t* pb = (const bf16_t*)(P.ws + OFF_HID);
#pragma unroll
    for (int q = 0; q < 2; ++q) { const float* vp = (const float*)(P.ws + OFF_VST) + (size_t)(row0 + 2 * qp + q) * 16;
#pragma unroll
        for (int i = 0; i < 4; ++i) R.st[q][i] = *(const f32x4*)(vp + 4 * i); }
#pragma unroll
    for (int it = 0; it < 2; ++it) { const int c0 = (w + 8 * it) * 8;
        R.rv[it][0] = *(const u32x4*)(pb + (size_t)(row0 + 2 * qp) * 2048 + 1536 + g * 128 + c0); R.rv[it][1] = *(const u32x4*)(pb + (size_t)(row0 + 2 * qp + 1) * 2048 + 1536 + g * 128 + c0); }
    const size_t prow = (size_t)(row0 + 16 * w + fr);
#pragma unroll
    for (int cb = 0; cb < 8; ++cb) R.uu[cb] = *(const u32x2*)(pb + prow * 2048 + 1024 + g * 128 + cb * 16 + fq * 4);
}
__device__ __forceinline__ void sgu_group(const Params& P, int l, int it0, int step, int nit, LAS unsigned char* lds) {
    const int tid = opaque_tid(), w = __builtin_amdgcn_readfirstlane(tid >> 6), lane = tid & 63, fr = lane & 15, fq = lane >> 4;
    if (it0 >= nit) return;
    bf16_t* yb = (bf16_t*)(P.ws + OFF_Y);
    SguPre R; sgu_prefetch(R, P, it0 >> 2, it0 & 3, w, lane);
#pragma unroll 1
    for (int it = it0; it < nit; it += step) {
        const int tix = it >> 2, g = it & 3, qp = lane;
        int row0, pos0, L, b; tile_info(tix, row0, pos0, L, b);
        const bf16_t* sgw = (const bf16_t*)(P.ws + OFF_SGW) + ((size_t)(l * 4 + g) * 128 + 16 * w + fr) * 128;
        bf16x8 bfr[4];
#pragma unroll
        for (int ks = 0; ks < 4; ++ks) bfr[ks] = *(const bf16x8*)(sgw + ks * 32 + fq * 8);
        const float bs = P.in[I_SGB][(l * 4 + g) * 128 + 16 * w + fr];
        f32x4 gv[2][2];
#pragma unroll
        for (int k = 0; k < 2; ++k) { const float* gp = P.in[I_SGN] + l * 512 + g * 128 + (w + 8 * k) * 8; gv[k][0] = *(const f32x4*)gp; gv[k][1] = *(const f32x4*)(gp + 4); }
        __syncthreads();
        f32x2 sv[2];
#pragma unroll
        for (int q = 0; q < 2; ++q) { float sm = 0.f, sq = 0.f;
#pragma unroll
            for (int i = 0; i < 4; ++i) { sm += R.st[q][i].x + R.st[q][i].z; sq += R.st[q][i].y + R.st[q][i].w; }
            const float mean = sm * (1.0f / 512.0f), var = fmaxf(sq * (1.0f / 512.0f) - mean * mean, 0.f);
            sv[q] = (f32x2){mean, rsqrtf(var + EPS)}; }
        { const f32x2 s0 = sv[0], s1 = sv[1];
#pragma unroll
          for (int k = 0; k < 2; ++k) { const int c0 = (w + 8 * k) * 8;
              const u32x4 r0 = R.rv[k][0], r1 = R.rv[k][1]; const f32x4 g0 = gv[k][0], g1 = gv[k][1];
              const float gn[8] = {g0.x, g0.y, g0.z, g0.w, g1.x, g1.y, g1.z, g1.w};
              const unsigned a[4] = {r0.x, r0.y, r0.z, r0.w}, bb[4] = {r1.x, r1.y, r1.z, r1.w};
#pragma unroll
              for (int i = 0; i < 4; ++i) {
                  const float e0 = (bflo(a[i]) - s0.x) * s0.y * gn[2 * i], e1 = (bflo(bb[i]) - s1.x) * s1.y * gn[2 * i];
                  const float o0 = (bfhi(a[i]) - s0.x) * s0.y * gn[2 * i + 1], o1 = (bfhi(bb[i]) - s1.x) * s1.y * gn[2 * i + 1];
                  *(LAS unsigned*)(lds + VT_OFF + (c0 + 2 * i) * 272 + qp * 4) = pk2(e0, e1);
                  *(LAS unsigned*)(lds + VT_OFF + (c0 + 2 * i + 1) * 272 + qp * 4) = pk2(o0, o1); } } }
        u32x2 uu8[8];
#pragma unroll
        for (int cb = 0; cb < 8; ++cb) uu8[cb] = R.uu[cb];
        if (it + step < nit) sgu_prefetch(R, P, (it + step) >> 2, (it + step) & 3, w, lane);
        __syncthreads();
        const size_t prow = (size_t)(row0 + 16 * w + fr);
#pragma unroll
        for (int cb = 0; cb < 8; ++cb) {
            f32x4 acc = (f32x4){0.f, 0.f, 0.f, 0.f};
#pragma unroll
            for (int ks = 0; ks < 4; ++ks) { const bf16x8 a = *(const LAS bf16x8*)(lds + VT_OFF + (cb * 16 + fr) * 272 + (ks * 32 + fq * 8) * 2);
                acc = __builtin_amdgcn_mfma_f32_16x16x32_bf16(a, bfr[ks], acc, 0, 0, 0); }
            const int cc = g * 128 + cb * 16 + fq * 4;
            const u32x2 uu = uu8[cb];
            u32x2 o; o.x = pk2(bflo(uu.x) * (acc[0] + bs), bfhi(uu.x) * (acc[1] + bs)); o.y = pk2(bflo(uu.y) * (acc[2] + bs), bfhi(uu.y) * (acc[3] + bs));
            *(u32x2*)(yb + prow * D + 512 + cc) = o;
        }
    }
}

#define XB_TMO      128
#define XB_XCNT(j)  (256  + 64 * (j))
#define XB_XSUB(j)  (1280 + 64 * (j))
#define XB_XGEN(j)  (2304 + 64 * (j))
#define XB_TOP      3328
#define XB_TOPGEN   3392
#define XCD_BAR_WORDS 3456
#define XB_SPIN_CAP (1u << 18)
__device__ __forceinline__ unsigned xb_ld(unsigned* p)              { return __hip_atomic_load(p, __ATOMIC_RELAXED, __HIP_MEMORY_SCOPE_AGENT); }
__device__ __forceinline__ unsigned xb_add(unsigned* p, unsigned v) { return __hip_atomic_fetch_add(p, v, __ATOMIC_RELAXED, __HIP_MEMORY_SCOPE_AGENT); }
__device__ __forceinline__ unsigned xb_xcc_id() { return (unsigned)__builtin_amdgcn_s_getreg((3 << 11) | 20) & 0xFu; }
#define XB_SPIN(cond, bar) do { unsigned _sp = 0; while (cond) { __builtin_amdgcn_s_sleep(1); \
    if ((++_sp & 255u) == 0u) { if (xb_ld(&(bar)[XB_TMO])) break; if (_sp > XB_SPIN_CAP) { atomicAdd(&(bar)[XB_TMO], 1u); break; } } } } while (0)
struct XcdBarrier { unsigned* bar; unsigned x; volatile LAS unsigned* st; };
__device__ __forceinline__ XcdBarrier xcd_barrier_post(unsigned* bar, volatile LAS unsigned* st) {
    XcdBarrier b; b.bar = bar; b.x = xb_xcc_id(); b.st = st;
    if (threadIdx.x == 0) (void)xb_add(&bar[XB_XCNT(b.x)], 1u);
    return b;
}
__device__ __forceinline__ void xcd_barrier_complete(unsigned* bar, unsigned x, unsigned& nloc, unsigned& nx) {
    const unsigned G = gridDim.x * gridDim.y * gridDim.z;
    unsigned sum, cnt, mine, sp = 0u;
    for (;;) {
        sum = 0u; cnt = 0u; mine = 0u;
#pragma unroll
        for (unsigned j = 0; j < 16; ++j) { const unsigned c = xb_ld(&bar[XB_XCNT(j)]); sum += c; cnt += (c > 0u) ? 1u : 0u; mine = (j == x) ? c : mine; }
        if (sum == G) break;
        __builtin_amdgcn_s_sleep(1);
        if ((++sp & 255u) == 0u) { if (xb_ld(&bar[XB_TMO])) break; if (sp > XB_SPIN_CAP) { atomicAdd(&bar[XB_TMO], 1u); break; } }
    }
    nloc = mine > 0u ? mine : 1u; nx = cnt > 0u ? cnt : 1u;
}
__device__ __forceinline__ void xcd_barrier(const XcdBarrier& b) {
    asm volatile("s_waitcnt vmcnt(0)" ::: "memory");
    __syncthreads();
    if (threadIdx.x == 0) {
        unsigned* bar = b.bar;
        __builtin_amdgcn_s_waitcnt(0);
        unsigned nloc = b.st[0], nx = b.st[1];
        if (nloc == 0u) { xcd_barrier_complete(bar, b.x, nloc, nx); b.st[0] = nloc; b.st[1] = nx; }
        const unsigned old = xb_add(&bar[XB_XSUB(b.x)], 1u);
        const unsigned gen = old / nloc;
        if (old + 1u == (gen + 1u) * nloc) {
            __builtin_amdgcn_fence(__ATOMIC_RELEASE, "agent");
            asm volatile("s_waitcnt vmcnt(0)" ::: "memory");
            const unsigned og = xb_add(&bar[XB_TOP], 1u);
            const unsigned tg = og / nx;
            if (og + 1u == (tg + 1u) * nx) xb_add(&bar[XB_TOPGEN], 1u);
            else XB_SPIN(xb_ld(&bar[XB_TOPGEN]) == tg, bar);
            __builtin_amdgcn_fence(__ATOMIC_ACQUIRE, "agent");
            xb_add(&bar[XB_XGEN(b.x)], 1u);
            asm volatile("s_waitcnt vmcnt(0)" ::: "memory");
        } else {
            XB_SPIN(xb_ld(&bar[XB_XGEN(b.x)]) == gen, bar);
            __builtin_amdgcn_fence(__ATOMIC_ACQUIRE, "agent");
            asm volatile("s_waitcnt vmcnt(0)" ::: "memory");
        }
    }
    __syncthreads();
}

__global__ void __launch_bounds__(512) fwd_mega(Params P) {
    extern __shared__ __attribute__((aligned(16))) unsigned char lds_raw[];
    LAS unsigned char* lds = (LAS unsigned char*)lds_raw;
    cg::grid_group grid = cg::this_grid();
    const int G = gridDim.x, c = blockIdx.x, tid = threadIdx.x;
    if (P.ws == nullptr) grid.sync();
    volatile LAS unsigned* xst = (volatile LAS unsigned*)(lds + 131072);
    if (tid == 0) { xst[0] = 0u; xst[1] = 0u; xst[2] = 0u; xst[3] = 0u; }
    __syncthreads();
    const XcdBarrier xb = xcd_barrier_post((unsigned*)(P.ws + OFF_BAR), xst);
    for (int it = c; it < 288; it += G) adaln_item(P, it, lds);
    { const int tw = opaque_tid(), wv = tw >> 6, ln = tw & 63; LAS float* scr = (LAS float*)(lds + 32768 + wv * 8448);
      for (int it = c * 8 + wv; it < 19968; it += G * 8) transpose_item(P, it, scr, ln); }
    { bf16_t* wg = (bf16_t*)(P.ws + OFF_WG);
      for (int i = c * 512 + tid; i < 262144; i += G * 512) { const int d = i & 63, e = (i >> 6) & 63, h = (i >> 12) & 7, gate = (i >> 15) & 1, dir = (i >> 16) & 1, l = i >> 17;
          const float* src = gate ? P.in[I_WI] : P.in[I_WR]; wg[i] = (bf16_t)(pk2(src[((size_t)((l * 2 + dir) * 8 + h) * 64 + d) * 64 + e] * -1.4426950408889634f, 0.f) & 0xffffu); }
      bf16_t* sg = (bf16_t*)(P.ws + OFF_SGW);
      for (int i = c * 512 + tid; i < 131072; i += G * 512) sg[i] = (bf16_t)(pk2(P.in[I_SGW][i], 0.f) & 0xffffu); }
    xcd_barrier(xb);
    for (int it = c; it < 416; it += G) shiftw_item(P, it, lds);
    { const int tw = opaque_tid(), wv = tw >> 6, ln = tw & 63;
      for (int row = c * 8 + wv; row < MT; row += 2 * G * 8) prep_item2(P, row, row + G * 8, row + G * 8 < MT, ln); }
    xcd_barrier(xb);
    bf16_t* AP = (bf16_t*)(P.ws + OFF_AP); bf16_t* YB = (bf16_t*)(P.ws + OFF_Y); bf16_t* HID = (bf16_t*)(P.ws + OFF_HID);
    float* RSQ = (float*)(P.ws + OFF_RSQ); float* VST = (float*)(P.ws + OFF_VST);
    const float* MODV = (const float*)(P.ws + OFF_MODV); const float* SW = (const float*)(P.ws + OFF_SW);
#pragma unroll 1
    for (int ph = 0; ph < 16; ++ph) {
        const int l = ph >> 3, st = ph & 7; const bool lastl = l == 1;
        const unsigned char* WL = P.ws + OFF_W + (size_t)l * LW_TOTAL;
        if (st == 0 || st == 6) {
            EpiSwiglu E; E.rtab = (const LAS float*)(lds + RSTD_OFF); E.vtab = (const LAS float*)(lds + VEC_OFF); E.hid = HID;
            const float* sWp = SW + (size_t)l * 5 * 13312 + (st == 0 ? 0 : 7680);
            pg8::Gemm g{AP, (const bf16_t*)(WL + (st == 0 ? LW_WIN1 : LW_WIN2)), MT, 5632, 1024};
            pg8::Order2 S; S.init(22, (st == 6 && lastl) ? 0 : 22, G, c);
            fill_tabs<1>(lds, S, RSQ, sWp, nullptr);
            pg8::gemm_phase<EpiSwiglu, pg8::Order2>(lds, g, S, E);
        } else if (st == 1 || st == 5 || st == 7) {
            EpiResid E; E.hb = (bf16_t*)(P.ws + OFF_HB);
            const int cg_ = st == 1 ? 2 : (st == 5 ? 5 : 8);
            E.gate = MODV + (size_t)(l * 5) * 9216 + cg_ * 1024;
            E.gsn = st == 1 ? MODV + (size_t)(l * 5) * 9216 + 4 * 1024 : (st == 5 ? MODV + (size_t)(l * 5) * 9216 + 7 * 1024 : (lastl ? (const float*)nullptr : MODV + (size_t)(5) * 9216 + 1 * 1024));
            E.ap = AP; E.rsq = RSQ;
            pg8::Gemm g{st == 5 ? YB : HID, (const bf16_t*)(WL + (st == 1 ? LW_WOUT1 : (st == 5 ? LW_WOUTM : LW_WOUT2))), MT, 1024, st == 5 ? 1024 : 2816};
            const int cpn = (st != 1 && lastl) ? 0 : 4; const int ks = (st != 5 && cpn) ? 11 : 1;
            E.part = (float*)(P.ws + OFF_Y);
            pg8::Order2 S; S.init(4, cpn, G, c, ks);
            E.vtab = (const LAS float*)(lds + VEC_OFF);
            fill_tabs<2>(lds, S, nullptr, E.gate, E.gsn);
            pg8::gemm_phase<EpiResid, pg8::Order2>(lds, g, S, E);
            if (ks > 1) {
                xcd_barrier(xb);
                const int tw = opaque_tid(), wv = tw >> 6, ln = tw & 63;
                for (int r = c * 8 + wv; r < NCTX; r += G * 8) ctx_fix_row(P, r, ln, ks, E.part, E.gate, E.gsn);
            }
        } else if (st == 2) {
            EpiInproj E; E.rtab = (const LAS float*)(lds + RSTD_OFF); E.vtab = (const LAS float*)(lds + VEC_OFF); E.p = HID; E.vst = VST;
            const float* sWp = SW + (size_t)l * 5 * 13312 + 5632;
            pg8::Gemm g{AP, (const bf16_t*)(WL + LW_WINM), MT, 2048, 1024};
            pg8::Order2 S; S.init(8, lastl ? 2 : 8, G, c);
            fill_tabs<3>(lds, S, RSQ, sWp, nullptr);
            pg8::gemm_phase<EpiInproj, pg8::Order2>(lds, g, S, E);
        } else if (st == 3) {
            for (int wgI = c; wgI < 256; wgI += G) scan_group(P, l, wgI, false, true, lds);
            const int nsgu = lastl ? 1024 : 1056;
            sgu_group(P, l, c, G, nsgu, lds);
        } else {
            for (int wgI = c; wgI < 256; wgI += G) scan_group(P, l, wgI, true, !lastl, lds);
        }
        xcd_barrier(xb);
    }
    for (int it = c; it < NLAT / 16; it += G) final_item(P, it);
}

extern "C" void kernel_launch(void* const* d_in, const int* in_sizes, int n_in, void* d_out, int out_size, void* d_ws, size_t ws_size, hipStream_t stream) {
    static int grid = 0;
    if (!grid) {
        if (n_in != 26 || ws_size < WS_END + COEF_TAIL_ITEMS * COEF_ITEM) { fprintf(stderr, "kernel_launch: unexpected n_in %d / ws_size %zu (need %zu)\n", n_in, ws_size, (size_t)WS_END); grid = -1; return; }
        int dev = 0, cus = 0, per_cu = 0;
        (void)hipGetDevice(&dev);
        (void)hipDeviceGetAttribute(&cus, hipDeviceAttributeMultiprocessorCount, dev);
        (void)hipFuncSetAttribute((const void*)fwd_mega, hipFuncAttributeMaxDynamicSharedMemorySize, LDS_BYTES);
        (void)hipOccupancyMaxActiveBlocksPerMultiprocessor(&per_cu, (const void*)fwd_mega, 512, LDS_BYTES);
        if (per_cu < 1) { fprintf(stderr, "kernel_launch: occupancy query says %d blocks per CU\n", per_cu); per_cu = 1; }
        grid = cus;
    }
    if (grid < 0) return;
    if (hipMemsetAsync((char*)d_ws + OFF_BAR, 0, BAR_BYTES, stream) != hipSuccess) { fprintf(stderr, "kernel_launch: memset of the barrier words failed\n"); return; }
    Params p{};
    for (int i = 0; i < 26; ++i) p.in[i] = (const float*)d_in[i];
    p.out = (float*)d_out; p.ws = (unsigned char*)d_ws;
    void* args[] = {&p};
    hipError_t e = hipLaunchCooperativeKernel((const void*)fwd_mega, dim3(grid), dim3(512), args, LDS_BYTES, stream);
    if (e != hipSuccess) fprintf(stderr, "cooperative launch failed: %s (grid %d)\n", hipGetErrorString(e), grid);
}
```

```cpp
#include <hip/hip_runtime.h>
#include <hip/hip_cooperative_groups.h>
#include <cstdio>
#include <cstdint>
namespace cg = cooperative_groups;

#define LAS __attribute__((address_space(3)))
typedef unsigned short bf16_t;
typedef short bf16x8 __attribute__((ext_vector_type(8)));
typedef float f32x4 __attribute__((ext_vector_type(4)));
typedef float f32x2 __attribute__((ext_vector_type(2)));
typedef unsigned u32x4 __attribute__((ext_vector_type(4)));
typedef unsigned u32x2 __attribute__((ext_vector_type(2)));

__device__ __forceinline__ int opaque_tid() { int t = threadIdx.x; asm volatile("" : "+v"(t)); return t; }

namespace pg8 {
constexpr int BM = 256, BK = 64, HALF = 128, HTB = HALF * BK * 2, STAGE_BYTES = 8 * HTB, NXCD = 8, WGM = 4;
__host__ __device__ __forceinline__ int lds_byte(int r, int c) { const int st = (r >> 4) * 2 + (c >> 5), rr = r & 15, cc = c & 31, ob = rr * 64 + cc * 2; return st * 1024 + (ob ^ (((ob >> 9) & 1) << 5)); }
__host__ __device__ __forceinline__ void stage_rc(int b, int& R, int& C) { const int st = b / 1024, sb = b % 1024, swz = sb ^ (((sb >> 9) & 1) << 5); R = (st >> 1) * 16 + swz / 64; C = (st & 1) * 32 + (swz % 64) / 2; }
__host__ __device__ __forceinline__ int perm32(int rho) { const int n = rho >> 4, i = rho & 15; return 8 * (i >> 2) + 4 * n + (i & 3); }
struct Unit { int pm, pn, kc, ui; };
struct Gemm { const bf16_t* A; const bf16_t* Bt; int M, N, K; };

struct Order2 {
    int nN, nlat, cpn, total, G, c, ks;
    __device__ __forceinline__ void init(int nN_, int cpn_, int G_, int c_, int ks_ = 1) { nN = nN_; nlat = 128 * nN_; cpn = cpn_; ks = ks_; total = nlat + 4 * cpn_ * ks_; G = G_; c = c_; }
    __device__ __forceinline__ bool next(int i, Unit& u) const {
        const long L = (long)i * G + c; if (L >= total) return false;
        int pm, pn, kc = -1;
        if (L >= nlat) { int r = (int)L - nlat; if (ks > 1) { kc = r % ks; r /= ks; } pm = 128 + r / cpn; pn = r % cpn; }
        else { int wgid = (int)L; { const int q = nlat / NXCD, xcd = wgid % NXCD, off = wgid / NXCD; wgid = xcd * q + off; }
            const int nig = WGM * nN, gid = wgid / nig, fm = gid * WGM; pm = fm + ((wgid % nig) % WGM); pn = (wgid % nig) / WGM; }
        u.pm = pm; u.pn = pn; u.kc = kc; u.ui = i; return true;
    }
    __device__ __forceinline__ void a_ready(const Unit&) const {}
    __device__ __forceinline__ void done(const Unit&) const {}
};

template <class Epi, class Sched>
__device__ __forceinline__ void gemm_phase(LAS unsigned char* lds, const Gemm g, const Sched& S, const Epi& E) {
    const int tid = opaque_tid(), wid = __builtin_amdgcn_readfirstlane(tid >> 6), lane = tid & 63, wr = wid >> 2, wc = wid & 3, fr = lane & 15, fq = lane >> 4;
    const int K = g.K, ntf = K / BK, nts = S.ks > 1 ? ntf / S.ks : ntf;
    unsigned voffA[2], voffB[2];
#pragma unroll
    for (int i = 0; i < 2; ++i) { int R, C; stage_rc(tid * 16 + i * 8192, R, C); const int Rb = Epi::PERM ? ((R & ~31) + perm32(R & 31)) : R;
        voffA[i] = (unsigned)(R * K + C) * 2u; voffB[i] = (unsigned)(Rb * K + C) * 2u; }
    const size_t kstep = (size_t)(BK * 2);
    const size_t hstep = (size_t)HALF * K * 2;
    const size_t tstep = 2 * hstep;
    const unsigned ldsw = (unsigned)wid * 1024u;
    const int aoff = lds_byte(wr * 64 + fr, fq * 8), boff = lds_byte(wc * 32 + fr, fq * 8);
#define PG8_SA(b, h) (((b) * 2 + (h)) * HTB)
#define PG8_SB(b, h) ((4 + (b) * 2 + (h)) * HTB)
#define PG8_STAGE(bufoff, gbase, voff) do { _Pragma("unroll") for (int _i = 0; _i < 2; ++_i) \
        __builtin_amdgcn_global_load_lds((const unsigned*)((const char*)(gbase) + (voff)[_i]), (LAS unsigned*)(lds + (bufoff) + ldsw + _i * 8192), 16, 0, 0); } while (0)
#define PG8_LDA(dst, b, h) do { _Pragma("unroll") for (int m = 0; m < 4; ++m) _Pragma("unroll") for (int k = 0; k < 2; ++k) dst[m][k] = *(const LAS bf16x8*)(lds + PG8_SA(b, h) + aoff + m * 2048 + k * 1024); } while (0)
#define PG8_LDB(dst, b, h) do { _Pragma("unroll") for (int n = 0; n < 2; ++n) _Pragma("unroll") for (int k = 0; k < 2; ++k) dst[n][k] = *(const LAS bf16x8*)(lds + PG8_SB(b, h) + boff + n * 2048 + k * 1024); } while (0)
#define PG8_MMA(ai, bj, At, Bt) do { __builtin_amdgcn_s_setprio(1); _Pragma("unroll") for (int m = 0; m < 4; ++m) _Pragma("unroll") for (int n = 0; n < 2; ++n) _Pragma("unroll") for (int k = 0; k < 2; ++k) \
        acc[ai][bj][m][n] = __builtin_amdgcn_mfma_f32_16x16x32_bf16(Bt[n][k], At[m][k], acc[ai][bj][m][n], 0, 0, 0); __builtin_amdgcn_s_setprio(0); } while (0)
#define PG8_WAIT_V(n) asm volatile("s_waitcnt vmcnt(" #n ")" ::: "memory")
#define PG8_WAIT_L(n) asm volatile("s_waitcnt lgkmcnt(" #n ")" ::: "memory")
#define PG8_BAR __builtin_amdgcn_s_barrier()
#define PG8_SCHED __builtin_amdgcn_sched_barrier(0)
    Unit cur, nxt; int ui = 0;
    if (!S.next(0, cur)) return;
    f32x4 acc[2][2][4][2];
#pragma unroll
    for (int a = 0; a < 2; ++a)
#pragma unroll
        for (int b = 0; b < 2; ++b)
#pragma unroll
            for (int m = 0; m < 4; ++m)
#pragma unroll
                for (int n = 0; n < 2; ++n) acc[a][b][m][n] = (f32x4){0.f, 0.f, 0.f, 0.f};
    bf16x8 At[4][2], B0[2][2], B1[2][2];
    const char* cA = (const char*)g.A + (size_t)cur.pm * tstep + (cur.kc > 0 ? (size_t)cur.kc * nts * kstep : 0); const char* cB = (const char*)g.Bt + (size_t)cur.pn * tstep + (cur.kc > 0 ? (size_t)cur.kc * nts * kstep : 0);
    S.a_ready(cur);
    PG8_STAGE(PG8_SB(0, 0), cB, voffB); PG8_STAGE(PG8_SB(0, 1), cB + hstep, voffB); PG8_STAGE(PG8_SA(0, 0), cA, voffA); PG8_STAGE(PG8_SA(0, 1), cA + hstep, voffA);
    PG8_STAGE(PG8_SB(1, 0), cB + kstep, voffB); PG8_STAGE(PG8_SA(1, 0), cA + kstep, voffA); PG8_STAGE(PG8_SB(1, 1), cB + hstep + kstep, voffB);
    if (wr == 1) PG8_BAR;
    PG8_WAIT_V(8); PG8_BAR;
    PG8_WAIT_V(6); PG8_BAR;
    for (;;) {
        const bool has_next = S.next(ui + 1, nxt);
        const size_t nko = (has_next && nxt.kc > 0) ? (size_t)nxt.kc * nts * kstep : 0;
        const char* nA = has_next ? (const char*)g.A + (size_t)nxt.pm * tstep + nko : cA; const char* nB = has_next ? (const char*)g.Bt + (size_t)nxt.pn * tstep + nko : cB;
        const int nt = cur.kc >= 0 ? nts : ntf;
        for (int t = 0; t < nt; t += 2) {
            const bool last = (t == nt - 2);
            const char* a1 = cA + (size_t)(t + 1) * kstep;
            const char* a2 = last ? nA : cA + (size_t)(t + 2) * kstep; const char* b2 = last ? nB : cB + (size_t)(t + 2) * kstep;
            const char* a3 = a2 + kstep; const char* b3 = b2 + kstep;
            PG8_LDB(B0, 0, 0); PG8_LDB(B1, 0, 1); PG8_SCHED; PG8_LDA(At, 0, 0); PG8_STAGE(PG8_SA(1, 1), a1 + hstep, voffA);
            PG8_WAIT_V(8); PG8_WAIT_L(0); PG8_BAR; PG8_MMA(0, 0, At, B0); PG8_MMA(0, 1, At, B1); PG8_BAR; PG8_SCHED;
            PG8_LDA(At, 0, 1); PG8_STAGE(PG8_SB(0, 0), b2, voffB); PG8_STAGE(PG8_SB(0, 1), b2 + hstep, voffB); PG8_STAGE(PG8_SA(0, 0), a2, voffA);
            PG8_WAIT_V(8); PG8_WAIT_L(0); PG8_BAR; PG8_MMA(1, 0, At, B0); PG8_MMA(1, 1, At, B1); PG8_BAR; PG8_SCHED;
            PG8_LDB(B0, 1, 0); PG8_LDB(B1, 1, 1); PG8_SCHED; PG8_LDA(At, 1, 0); PG8_STAGE(PG8_SA(0, 1), a2 + hstep, voffA);
            PG8_WAIT_V(8); PG8_WAIT_L(0); PG8_BAR; PG8_MMA(0, 0, At, B0); PG8_MMA(0, 1, At, B1); PG8_BAR; PG8_SCHED;
            PG8_LDA(At, 1, 1); PG8_STAGE(PG8_SB(1, 0), b3, voffB); PG8_STAGE(PG8_SB(1, 1), b3 + hstep, voffB); PG8_STAGE(PG8_SA(1, 0), a3, voffA);
            PG8_WAIT_V(8); PG8_WAIT_L(0); PG8_BAR; PG8_MMA(1, 0, At, B0); PG8_MMA(1, 1, At, B1); PG8_BAR; PG8_SCHED;
        }
        if (wr == 0) PG8_BAR;
        E(acc, cur, wr, wc, fr, fq);
        if (!has_next) break;
#pragma unroll
        for (int a = 0; a < 2; ++a)
#pragma unroll
            for (int b = 0; b < 2; ++b)
#pragma unroll
                for (int m = 0; m < 4; ++m)
#pragma unroll
                    for (int n = 0; n < 2; ++n) acc[a][b][m][n] = (f32x4){0.f, 0.f, 0.f, 0.f};
        cur = nxt; cA = nA; cB = nB; ++ui;
        if (wr == 1) PG8_BAR;
    }
    PG8_WAIT_V(0);
    PG8_BAR;
#undef PG8_SA
#undef PG8_SB
#undef PG8_STAGE
#undef PG8_LDA
#undef PG8_LDB
#undef PG8_MMA
#undef PG8_WAIT_V
#undef PG8_WAIT_L
#undef PG8_BAR
#undef PG8_SCHED
}
}

constexpr int D = 1024, NB = 4, SEQ = 8192, CTXL = 256, DFF = 2816, NLAT = NB * SEQ, NCTX = NB * CTXL, MT = NLAT + NCTX;
constexpr float EPS = 1e-6f;
constexpr size_t OFF_HB = 0;
constexpr size_t OFF_AP = OFF_HB + (size_t)MT * D * 2;
constexpr size_t OFF_Y = OFF_AP + (size_t)MT * D * 2;
constexpr size_t OFF_HID = OFF_Y + (size_t)MT * D * 2;
constexpr size_t OFF_W = OFF_HID + (size_t)MT * DFF * 2;
constexpr size_t LW_WIN1 = 0, LW_WOUT1 = 11534336, LW_WINM = 17301504, LW_WOUTM = 21495808, LW_WIN2 = 23592960, LW_WOUT2 = 35127296, LW_TOTAL = 40894464;
constexpr size_t OFF_WG = OFF_W + 2 * LW_TOTAL;
constexpr size_t OFF_SGW = OFF_WG + 524288;
constexpr size_t OFF_MODV = OFF_SGW + 262144;
constexpr size_t OFF_SW = OFF_MODV + 368640;
constexpr size_t OFF_RSQ = OFF_SW + 532480;
constexpr size_t OFF_VST = OFF_RSQ + (size_t)MT * 16 * 4;
constexpr size_t OFF_SUM = OFF_VST + (size_t)MT * 16 * 4;
constexpr size_t OFF_BAR = OFF_SUM + (size_t)264 * 2048 * 4;
constexpr size_t BAR_BYTES = 16384;
constexpr size_t WS_END = OFF_BAR + BAR_BYTES;
constexpr int RSTD_OFF = 131072 + 16;
constexpr int VEC_OFF = RSTD_OFF + 12 * 256 * 4;
constexpr int LDS_BYTES = VEC_OFF + 12288;

struct Params { const float* in[26]; float* out; unsigned char* ws; };
enum { I_X = 0, I_C, I_CTX, I_CCTX, I_WADA, I_BADA, I_G1, I_W1IN, I_W1OUT, I_GMIX, I_WINM, I_CONVW, I_CONVB, I_WR, I_BR, I_WI, I_BI, I_LAM, I_SGN, I_SGW, I_SGB, I_WOUTM, I_G2, I_W2IN, I_W2OUT, I_GF };

__device__ __forceinline__ unsigned pk2(float lo, float hi) { unsigned r; asm("v_cvt_pk_bf16_f32 %0, %1, %2" : "=v"(r) : "v"(lo), "v"(hi)); return r; }
__device__ __forceinline__ float bflo(unsigned w) { return __uint_as_float(w << 16); }
__device__ __forceinline__ float bfhi(unsigned w) { return __uint_as_float(w & 0xffff0000u); }
__device__ __forceinline__ float sigmoidf_(float v) { return __builtin_amdgcn_rcpf(1.0f + __expf(-v)); }

__device__ __forceinline__ void rows_rstd(const LAS float* tab, int ui, int rl0, float (&rstd)[2][4]) {
#pragma unroll
    for (int ai = 0; ai < 2; ++ai)
#pragma unroll
        for (int m = 0; m < 4; ++m) rstd[ai][m] = tab[ui * 256 + rl0 + ai * 128 + m * 16];
}
template <int MODE, class Sched> __device__ __forceinline__ void fill_tabs(LAS unsigned char* lds, const Sched& S, const float* rsq, const float* v0, const float* v1) {
    const int tid = opaque_tid(); LAS float* tab = (LAS float*)(lds + RSTD_OFF); LAS float* vec = (LAS float*)(lds + VEC_OFF);
    if (MODE != 2) {
        f32x4 rv[6][4]; float vv[6]; bool ok[6];
#pragma unroll
        for (int k = 0; k < 6; ++k) { const int pair = tid + 512 * k, i = pair >> 8, row = pair & 255; pg8::Unit u; ok[k] = S.next(i, u);
            const int pm = ok[k] ? u.pm : 0, pn = ok[k] ? u.pn : 0, s = pm < 128 ? (pm >> 5) : 4;
            const float* p = rsq + ((size_t)pm * 256 + row) * 16;
#pragma unroll
            for (int j = 0; j < 4; ++j) rv[k][j] = *(const f32x4*)(p + 4 * j);
            vv[k] = MODE == 1 ? v0[s * 13312 + (row < 128 ? pn * 128 + row : 2816 + pn * 128 + (row - 128))] : v0[s * 13312 + pn * 256 + row]; }
#pragma unroll
        for (int k = 0; k < 6; ++k) { const int pair = tid + 512 * k; float t = 0.f;
#pragma unroll
            for (int j = 0; j < 4; ++j) t += (rv[k][j].x + rv[k][j].y) + (rv[k][j].z + rv[k][j].w);
            if (ok[k]) { tab[pair] = rsqrtf(t * (1.0f / 1024.0f) + EPS); vec[pair] = vv[k]; } }
    } else {
        float vv[6]; bool ok[6];
#pragma unroll
        for (int k = 0; k < 6; ++k) { pg8::Unit u; ok[k] = S.next(k, u) && u.kc < 0;
            const int pm = ok[k] ? u.pm : 0, pn = ok[k] ? u.pn : 0, s = pm < 128 ? (pm >> 5) : 4;
            vv[k] = tid < 256 ? v0[s * 9216 + pn * 256 + tid] : (v1 ? v1[s * 9216 + pn * 256 + tid - 256] : 0.f); }
#pragma unroll
        for (int k = 0; k < 6; ++k) if (ok[k]) vec[k * 512 + tid] = vv[k];
    }
    __syncthreads();
}
struct EpiSwiglu {
    static constexpr bool PERM = true;
    const LAS float* rtab; const LAS float* vtab; bf16_t* hid;
    __device__ __forceinline__ void operator()(const f32x4 (&acc)[2][2][4][2], const pg8::Unit& u, int wr, int wc, int fr_, int fq_) const {
        int fr = fr_, fq = fq_; asm volatile("" : "+v"(fr), "+v"(fq));
        const int s = u.pm < 128 ? (u.pm >> 5) : 4;
        const int row0 = u.pm * 256 + wr * 64 + fr, jc = u.pn * 128 + wc * 32 + fq * 8;
        const LAS float* swp = vtab + u.ui * 256 + wc * 32 + fq * 8;
        const f32x4 g0 = *(const LAS f32x4*)swp, g1 = *(const LAS f32x4*)(swp + 4), u0 = *(const LAS f32x4*)(swp + 128), u1 = *(const LAS f32x4*)(swp + 132);
        float rs[2][4]; rows_rstd(rtab, u.ui, wr * 64 + fr, rs);
#pragma unroll
        for (int ai = 0; ai < 2; ++ai)
#pragma unroll
            for (int m = 0; m < 4; ++m) {
                const int row = row0 + ai * 128 + m * 16; const float rstd = rs[ai][m];
                f32x4 g[2], up[2], e[2];
                g[0] = acc[ai][0][m][0] * rstd + g0; g[1] = acc[ai][0][m][1] * rstd + g1; up[0] = acc[ai][1][m][0] * rstd + u0; up[1] = acc[ai][1][m][1] * rstd + u1;
#pragma unroll
                for (int h = 0; h < 2; ++h) { const f32x4 t = g[h] * -1.4426950408889634f;
                    e[h] = (f32x4){__builtin_amdgcn_exp2f(t.x), __builtin_amdgcn_exp2f(t.y), __builtin_amdgcn_exp2f(t.z), __builtin_amdgcn_exp2f(t.w)}; }
#pragma unroll
                for (int h = 0; h < 2; ++h) { const f32x4 d = e[h] + 1.0f;
                    e[h] = (f32x4){__builtin_amdgcn_rcpf(d.x), __builtin_amdgcn_rcpf(d.y), __builtin_amdgcn_rcpf(d.z), __builtin_amdgcn_rcpf(d.w)}; }
#pragma unroll
                for (int h = 0; h < 2; ++h) g[h] = (g[h] * up[h]) * e[h];
                u32x4 w; w.x = pk2(g[0].x, g[0].y); w.y = pk2(g[0].z, g[0].w); w.z = pk2(g[1].x, g[1].y); w.w = pk2(g[1].z, g[1].w);
                *(u32x4*)(hid + (size_t)row * DFF + jc) = w;
            }
    }
};
struct EpiResid {
    static constexpr bool PERM = true;
    bf16_t* hb; const float* gate; const float* gsn; const LAS float* vtab; bf16_t* ap; float* rsq; float* part;
    __device__ __forceinline__ void operator()(const f32x4 (&acc)[2][2][4][2], const pg8::Unit& u, int wr, int wc, int fr_, int fq_) const {
        int fr = fr_, fq = fq_; asm volatile("" : "+v"(fr), "+v"(fq));
        const int cb0 = u.pn * 256 + wc * 32 + fq * 8;
        if (u.kc >= 0) {
            float* pp = part + ((size_t)u.kc * NCTX + (size_t)(u.pm - 128) * 256 + wr * 64 + fr) * D + cb0;
#pragma unroll
            for (int ai = 0; ai < 2; ++ai)
#pragma unroll
                for (int m = 0; m < 4; ++m)
#pragma unroll
                    for (int bj = 0; bj < 2; ++bj) { float* q = pp + (size_t)(ai * 128 + m * 16) * D + bj * 128; *(f32x4*)q = acc[ai][bj][m][0]; *(f32x4*)(q + 4) = acc[ai][bj][m][1]; }
            return;
        }
        const int s = u.pm < 128 ? (u.pm >> 5) : 4;
        f32x4 gt[2][2], gn[2][2];
#pragma unroll
        for (int bj = 0; bj < 2; ++bj) { const LAS float* gp = vtab + u.ui * 512 + bj * 128 + wc * 32 + fq * 8; gt[bj][0] = *(const LAS f32x4*)gp; gt[bj][1] = *(const LAS f32x4*)(gp + 4);
            gn[bj][0] = *(const LAS f32x4*)(gp + 256); gn[bj][1] = *(const LAS f32x4*)(gp + 260); }
        bf16_t* hbase = hb + ((size_t)u.pm * 256 + wr * 64 + fr) * D + cb0;
        u32x4 hv[2][2];
#pragma unroll
        for (int bj = 0; bj < 2; ++bj) hv[0][bj] = *(const u32x4*)(hbase + bj * 128);
#pragma unroll
        for (int it = 0; it < 8; ++it) {
            const int ai = it >> 2, m = it & 3;
            const size_t roff = (size_t)(ai * 128 + m * 16) * D; const size_t grow = (size_t)u.pm * 256 + ai * 128 + wr * 64 + m * 16 + fr;
            if (it < 7) { const size_t rn = (size_t)(((it + 1) >> 2) * 128 + ((it + 1) & 3) * 16) * D;
#pragma unroll
                for (int bj = 0; bj < 2; ++bj) hv[(it + 1) & 1][bj] = *(const u32x4*)(hbase + rn + bj * 128); }
            float sq = 0.f;
#pragma unroll
            for (int bj = 0; bj < 2; ++bj) {
                const u32x4 r = hv[it & 1][bj];
                const f32x4 o0 = (f32x4){bflo(r.x), bfhi(r.x), bflo(r.y), bfhi(r.y)}, o1 = (f32x4){bflo(r.z), bfhi(r.z), bflo(r.w), bfhi(r.w)};
                const f32x4 n0 = o0 + gt[bj][0] * acc[ai][bj][m][0], n1 = o1 + gt[bj][1] * acc[ai][bj][m][1];
                u32x4 hw; hw.x = pk2(n0.x, n0.y); hw.y = pk2(n0.z, n0.w); hw.z = pk2(n1.x, n1.y); hw.w = pk2(n1.z, n1.w);
                *(u32x4*)(hbase + roff + bj * 128) = hw;
                sq += (n0.x * n0.x + n0.y * n0.y) + (n0.z * n0.z + n0.w * n0.w) + (n1.x * n1.x + n1.y * n1.y) + (n1.z * n1.z + n1.w * n1.w);
                if (gsn) { const f32x4 a0 = n0 * gn[bj][0], a1 = n1 * gn[bj][1]; u32x4 w; w.x = pk2(a0.x, a0.y); w.y = pk2(a0.z, a0.w); w.z = pk2(a1.x, a1.y); w.w = pk2(a1.z, a1.w);
                    *(u32x4*)(ap + grow * D + cb0 + bj * 128) = w; }
            }
            sq += __shfl_xor(sq, 16); sq += __shfl_xor(sq, 32);
            if (fq == 0) rsq[grow * 16 + u.pn * 4 + wc] = sq;
        }
    }
};
struct EpiInproj {
    static constexpr bool PERM = true;
    const LAS float* rtab; const LAS float* vtab; bf16_t* p; float* vst;
    __device__ __forceinline__ void operator()(const f32x4 (&acc)[2][2][4][2], const pg8::Unit& u, int wr, int wc, int fr_, int fq_) const {
        int fr = fr_, fq = fq_; asm volatile("" : "+v"(fr), "+v"(fq));
        const int s = u.pm < 128 ? (u.pm >> 5) : 4;
        const int row0 = u.pm * 256 + wr * 64 + fr, cb0 = u.pn * 256 + wc * 32 + fq * 8;
        f32x4 sw[2][2];
#pragma unroll
        for (int bj = 0; bj < 2; ++bj) { const LAS float* sp = vtab + u.ui * 256 + bj * 128 + wc * 32 + fq * 8; sw[bj][0] = *(const LAS f32x4*)sp; sw[bj][1] = *(const LAS f32x4*)(sp + 4); }
        const bool isv = u.pn >= 6;
        float rs[2][4]; rows_rstd(rtab, u.ui, wr * 64 + fr, rs);
#pragma unroll
        for (int ai = 0; ai < 2; ++ai)
#pragma unroll
            for (int m = 0; m < 4; ++m) {
                const int row = row0 + ai * 128 + m * 16; const float rstd = rs[ai][m];
                float sm = 0.f, sq = 0.f;
#pragma unroll
                for (int bj = 0; bj < 2; ++bj) {
                    const f32x4 v0 = acc[ai][bj][m][0] * rstd + sw[bj][0], v1 = acc[ai][bj][m][1] * rstd + sw[bj][1];
                    u32x4 w; w.x = pk2(v0.x, v0.y); w.y = pk2(v0.z, v0.w); w.z = pk2(v1.x, v1.y); w.w = pk2(v1.z, v1.w);
                    *(u32x4*)(p + (size_t)row * 2048 + cb0 + bj * 128) = w;
                    sm += (v0.x + v0.y) + (v0.z + v0.w) + (v1.x + v1.y) + (v1.z + v1.w);
                    sq += (v0.x * v0.x + v0.y * v0.y) + (v0.z * v0.z + v0.w * v0.w) + (v1.x * v1.x + v1.y * v1.y) + (v1.z * v1.z + v1.w * v1.w);
                }
                if (isv) { sm += __shfl_xor(sm, 16); sm += __shfl_xor(sm, 32); sq += __shfl_xor(sq, 16); sq += __shfl_xor(sq, 32);
                    if (fq == 0) { float* vp = vst + (size_t)row * 16 + ((u.pn - 6) * 4 + wc) * 2; vp[0] = sm; vp[1] = sq; } }
            }
    }
};

__device__ __forceinline__ void gemv5_partial(const float* __restrict__ W, int ldw, int col, int k0, const LAS float* vin, float (&acc)[5]) {
#pragma unroll
    for (int s = 0; s < 5; ++s) acc[s] = 0.f;
#pragma unroll 32
    for (int k = k0; k < k0 + 128; ++k) { const float w = W[(size_t)k * ldw + col];
#pragma unroll
        for (int s = 0; s < 5; ++s) acc[s] += vin[s * 1024 + k] * w; }
}
__device__ __forceinline__ void adaln_item(const Params& P, int it, LAS unsigned char* lds) {
    const int tid = opaque_tid(), w = tid >> 6, lane = tid & 63;
    LAS float* vin = (LAS float*)lds; LAS float* red = (LAS float*)(lds + 20480);
    const int l = it / 144, c0 = (it % 144) * 64;
    for (int idx = tid; idx < 5120; idx += 512) { const int s = idx >> 10, k = idx & 1023; const float cv = s < 4 ? P.in[I_C][s * 1024 + k] : P.in[I_CCTX][k]; vin[idx] = cv / (1.0f + __expf(-cv)); }
    __syncthreads();
    float acc[5]; gemv5_partial(P.in[I_WADA] + (size_t)l * 1024 * 9216, 9216, c0 + lane, w * 128, vin, acc);
#pragma unroll
    for (int s = 0; s < 5; ++s) red[(w * 5 + s) * 64 + lane] = acc[s];
    __syncthreads();
    if (tid < 320) { const int s = tid >> 6; float m = 0.f;
#pragma unroll
        for (int v = 0; v < 8; ++v) m += red[(v * 5 + s) * 64 + lane];
        const int n = c0 + lane, chunk = n >> 10, k = n & 1023; m += P.in[I_BADA][l * 9216 + n];
        float val = m;
        if (chunk == 1) val = P.in[I_G1][l * 1024 + k] * (1.0f + m); else if (chunk == 4) val = P.in[I_GMIX][l * 1024 + k] * (1.0f + m); else if (chunk == 7) val = P.in[I_G2][l * 1024 + k] * (1.0f + m);
        else if (chunk == 2 || chunk == 8) val = 0.5f * m;
        ((float*)(P.ws + OFF_MODV))[((l * 5 + s) * 9 + chunk) * 1024 + k] = val; }
    __syncthreads();
}
__device__ __forceinline__ void shiftw_item(const Params& P, int it, LAS unsigned char* lds) {
    const int tid = opaque_tid(), w = tid >> 6, lane = tid & 63;
    LAS float* vin = (LAS float*)lds; LAS float* red = (LAS float*)(lds + 20480);
    const int l = it / 208; int r = it % 208; const float* W; int ldw, c0, off, chunk;
    if (r < 88) { W = P.in[I_W1IN] + (size_t)l * 1024 * 5632; ldw = 5632; c0 = r * 64; off = 0; chunk = 0; }
    else if (r < 120) { W = P.in[I_WINM] + (size_t)l * 1024 * 2048; ldw = 2048; c0 = (r - 88) * 64; off = 5632; chunk = 3; }
    else { W = P.in[I_W2IN] + (size_t)l * 1024 * 5632; ldw = 5632; c0 = (r - 120) * 64; off = 7680; chunk = 6; }
    const float* modv = (const float*)(P.ws + OFF_MODV);
    for (int idx = tid; idx < 5120; idx += 512) { const int s = idx >> 10, k = idx & 1023; vin[idx] = modv[((l * 5 + s) * 9 + chunk) * 1024 + k]; }
    __syncthreads();
    float acc[5]; gemv5_partial(W, ldw, c0 + lane, w * 128, vin, acc);
#pragma unroll
    for (int s = 0; s < 5; ++s) red[(w * 5 + s) * 64 + lane] = acc[s];
    __syncthreads();
    if (tid < 320) { const int s = tid >> 6; float m = 0.f;
#pragma unroll
        for (int v = 0; v < 8; ++v) m += red[(v * 5 + s) * 64 + lane];
        ((float*)(P.ws + OFF_SW))[(l * 5 + s) * 13312 + off + c0 + lane] = m; }
    __syncthreads();
}
__device__ __forceinline__ void transpose_item(const Params& P, int it, LAS float* scr, int lane) {
    const int l = it / 9984; int r = it % 9984; const float* W; int K, N; size_t dst; bool perm = false;
    if (r < 2816) { W = P.in[I_W1IN] + (size_t)l * 1024 * 5632; K = 1024; N = 5632; dst = LW_WIN1; perm = true; }
    else if ((r -= 2816) < 1408) { W = P.in[I_W1OUT] + (size_t)l * 2816 * 1024; K = 2816; N = 1024; dst = LW_WOUT1; }
    else if ((r -= 1408) < 1024) { W = P.in[I_WINM] + (size_t)l * 1024 * 2048; K = 1024; N = 2048; dst = LW_WINM; }
    else if ((r -= 1024) < 512) { W = P.in[I_WOUTM] + (size_t)l * 1024 * 1024; K = 1024; N = 1024; dst = LW_WOUTM; }
    else if ((r -= 512) < 2816) { W = P.in[I_W2IN] + (size_t)l * 1024 * 5632; K = 1024; N = 5632; dst = LW_WIN2; perm = true; }
    else { r -= 2816; W = P.in[I_W2OUT] + (size_t)l * 2816 * 1024; K = 2816; N = 1024; dst = LW_WOUT2; }
    const int ntn = N / 32, k0 = (r / ntn) * 64, n0 = (r % ntn) * 32;
    const int r0 = perm ? (((n0 % 2816) / 128) * 256 + (n0 / 2816) * 128 + (n0 % 128)) : n0;
    bf16_t* Bt = (bf16_t*)(P.ws + OFF_W + (size_t)l * LW_TOTAL + dst);
    float v[32];
#pragma unroll
    for (int i = 0; i < 32; ++i) { const int kk = 2 * i + (lane >> 5); v[i] = W[(size_t)(k0 + kk) * N + n0 + (lane & 31)]; }
#pragma unroll
    for (int i = 0; i < 32; ++i) { const int kk = 2 * i + (lane >> 5); scr[kk * 33 + (lane & 31)] = v[i]; }
    asm volatile("s_waitcnt lgkmcnt(0)" ::: "memory");
    const int c = lane & 7;
#pragma unroll
    for (int j = 0; j < 4; ++j) { const int n = (lane >> 3) + 8 * j; const LAS float* t = scr + (8 * c) * 33 + n;
        u32x4 o; o.x = pk2(t[0], t[33]); o.y = pk2(t[66], t[99]); o.z = pk2(t[132], t[165]); o.w = pk2(t[198], t[231]);
        *(u32x4*)(Bt + (size_t)(r0 + n) * K + k0 + 8 * c) = o; }
    asm volatile("s_waitcnt lgkmcnt(0)" ::: "memory");
}
__device__ __forceinline__ void prep_item2(const Params& P, int rowA, int rowB, bool hasB, int lane) {
    const int rows[2] = {rowA, hasB ? rowB : rowA};
    f32x4 v[2][4], g[2][4];
#pragma unroll
    for (int q = 0; q < 2; ++q) { const int row = rows[q]; const int s = row < NLAT ? (row >> 13) : 4;
        const float* src = row < NLAT ? P.in[I_X] + (size_t)row * D : P.in[I_CTX] + (size_t)(row - NLAT) * D;
        const float* gs = (const float*)(P.ws + OFF_MODV) + ((0 * 5 + s) * 9 + 1) * 1024;
#pragma unroll
        for (int j = 0; j < 4; ++j) { const int c = (lane + 64 * j) * 4; v[q][j] = *(const f32x4*)(src + c); g[q][j] = *(const f32x4*)(gs + c); } }
#pragma unroll
    for (int q = 0; q < 2; ++q) { if (q == 1 && !hasB) break; const int row = rows[q];
        bf16_t* ap = (bf16_t*)(P.ws + OFF_AP) + (size_t)row * D; bf16_t* hbp = (bf16_t*)(P.ws + OFF_HB) + (size_t)row * D;
        float sq = 0.f;
#pragma unroll
        for (int j = 0; j < 4; ++j) { const int c = (lane + 64 * j) * 4; const f32x4 x = v[q][j], gg = g[q][j];
            sq += (x.x * x.x + x.y * x.y) + (x.z * x.z + x.w * x.w);
            u32x2 o; o.x = pk2(x.x * gg.x, x.y * gg.y); o.y = pk2(x.z * gg.z, x.w * gg.w); *(u32x2*)(ap + c) = o;
            u32x2 hh; hh.x = pk2(x.x, x.y); hh.y = pk2(x.z, x.w); *(u32x2*)(hbp + c) = hh; }
#pragma unroll
        for (int o = 1; o < 64; o <<= 1) sq += __shfl_xor(sq, o);
        if (lane < 16) ((float*)(P.ws + OFF_RSQ))[(size_t)row * 16 + lane] = lane == 0 ? sq : 0.f; }
}
__device__ __forceinline__ void final_item(const Params& P, int it) {
    const int tid = opaque_tid(), w = tid >> 6, lane = tid & 63;
    const float* g = P.in[I_GF];
    u32x2 r[2][4]; f32x4 gg[4]; float t[2];
#pragma unroll
    for (int j = 0; j < 4; ++j) gg[j] = *(const f32x4*)(g + (lane + 64 * j) * 4);
#pragma unroll
    for (int q = 0; q < 2; ++q) { const int row = it * 16 + 2 * w + q;
        t[q] = ((const float*)(P.ws + OFF_RSQ))[(size_t)row * 16 + (lane & 15)];
        const bf16_t* hp = (const bf16_t*)(P.ws + OFF_HB) + (size_t)row * D;
#pragma unroll
        for (int j = 0; j < 4; ++j) r[q][j] = *(const u32x2*)(hp + (lane + 64 * j) * 4); }
#pragma unroll
    for (int q = 0; q < 2; ++q) { const int row = it * 16 + 2 * w + q; float tt = t[q];
        tt += __shfl_xor(tt, 1); tt += __shfl_xor(tt, 2); tt += __shfl_xor(tt, 4); tt += __shfl_xor(tt, 8);
        const float rstd = rsqrtf(tt * (1.0f / 1024.0f) + EPS);
        float* op = P.out + (size_t)row * D;
#pragma unroll
        for (int j = 0; j < 4; ++j) { const int c = (lane + 64 * j) * 4; *(f32x4*)(op + c) = (f32x4){bflo(r[q][j].x), bfhi(r[q][j].x), bflo(r[q][j].y), bfhi(r[q][j].y)} * rstd * gg[j]; } }
}

__device__ __forceinline__ void ctx_fix_row(const Params& P, int r, int lane, int ks, const float* part, const float* gate, const float* gsn) {
    const int c0 = lane * 16; const size_t grow = (size_t)NLAT + r;
    f32x4 sum[4];
#pragma unroll
    for (int i = 0; i < 4; ++i) sum[i] = (f32x4){0.f, 0.f, 0.f, 0.f};
    for (int k = 0; k < ks; ++k) { const float* pp = part + ((size_t)k * NCTX + r) * D + c0;
#pragma unroll
        for (int i = 0; i < 4; ++i) sum[i] += *(const f32x4*)(pp + 4 * i); }
    bf16_t* hp = (bf16_t*)(P.ws + OFF_HB) + grow * D + c0; bf16_t* ap = (bf16_t*)(P.ws + OFF_AP) + grow * D + c0;
    const u32x4 h0 = *(const u32x4*)hp, h1 = *(const u32x4*)(hp + 8);
    const unsigned hw[8] = {h0.x, h0.y, h0.z, h0.w, h1.x, h1.y, h1.z, h1.w};
    float n[16]; float sq = 0.f;
#pragma unroll
    for (int i = 0; i < 4; ++i) { const f32x4 g = *(const f32x4*)(gate + 4 * 9216 + c0 + 4 * i);
        n[4 * i] = bflo(hw[2 * i]) + g.x * sum[i].x; n[4 * i + 1] = bfhi(hw[2 * i]) + g.y * sum[i].y; n[4 * i + 2] = bflo(hw[2 * i + 1]) + g.z * sum[i].z; n[4 * i + 3] = bfhi(hw[2 * i + 1]) + g.w * sum[i].w; }
#pragma unroll
    for (int i = 0; i < 16; ++i) sq += n[i] * n[i];
    u32x4 o0, o1; o0.x = pk2(n[0], n[1]); o0.y = pk2(n[2], n[3]); o0.z = pk2(n[4], n[5]); o0.w = pk2(n[6], n[7]); o1.x = pk2(n[8], n[9]); o1.y = pk2(n[10], n[11]); o1.z = pk2(n[12], n[13]); o1.w = pk2(n[14], n[15]);
    *(u32x4*)hp = o0; *(u32x4*)(hp + 8) = o1;
    if (gsn) {
#pragma unroll
        for (int i = 0; i < 4; ++i) { const f32x4 g = *(const f32x4*)(gsn + 4 * 9216 + c0 + 4 * i); n[4 * i] *= g.x; n[4 * i + 1] *= g.y; n[4 * i + 2] *= g.z; n[4 * i + 3] *= g.w; }
        o0.x = pk2(n[0], n[1]); o0.y = pk2(n[2], n[3]); o0.z = pk2(n[4], n[5]); o0.w = pk2(n[6], n[7]); o1.x = pk2(n[8], n[9]); o1.y = pk2(n[10], n[11]); o1.z = pk2(n[12], n[13]); o1.w = pk2(n[14], n[15]);
        *(u32x4*)ap = o0; *(u32x4*)(ap + 8) = o1; }
    sq += __shfl_xor(sq, 1); sq += __shfl_xor(sq, 2);
    if ((lane & 3) == 0) ((float*)(P.ws + OFF_RSQ))[grow * 16 + (lane >> 2)] = sq;
}

__device__ __forceinline__ void tile_info(int tix, int& row0, int& pos0, int& L, int& b) {
    if (tix < 256) { b = tix >> 6; pos0 = (tix & 63) * 128; row0 = b * SEQ + pos0; L = SEQ; }
    else { const int c = tix - 256; b = c >> 1; pos0 = (c & 1) * 128; row0 = NLAT + b * CTXL + pos0; L = CTXL; }
}
constexpr int SC_WG_OFF = 0, SC_CW_OFF = 36864, SC_CAR_OFF = 38144, SC_WCOMP_OFF = 42752, SC_XL_OFF = 50944, SC_GL_OFF = 67840, SC_XC_OFF = 84224;
struct ScanPre { u32x4 x[3]; u32x4 g[2]; u32x4 cf[8]; };
constexpr size_t COEF_ITEM = 65536, COEF_TAIL_ITEMS = 264;
__device__ __forceinline__ u32x4* coef_base(const Params& P, int item) {
    const size_t off = item < 1056 ? OFF_AP + (size_t)item * COEF_ITEM : (item < 1848 ? OFF_HID + (size_t)MT * 2048 * 2 + (size_t)(item - 1056) * COEF_ITEM : WS_END + (size_t)(item - 1848) * COEF_ITEM);
    return (u32x4*)(P.ws + off);
}
__device__ __forceinline__ void scan_prefetch(ScanPre& R, const Params& P, const bf16_t* pb, int tix, int h, int tid, bool final_mode) {
    int row0, pos0, L, b; tile_info(tix, row0, pos0, L, b);
    if (!final_mode) {
#pragma unroll
        for (int i = 0; i < 3; ++i) { const int idx = tid + 512 * i, r = idx >> 3, pc = idx & 7, pos = pos0 - 2 + r; R.x[i] = (u32x4){0u, 0u, 0u, 0u};
            if (idx < 131 * 8 && pos >= 0 && pos < L) R.x[i] = *(const u32x4*)(pb + (size_t)(row0 - 2 + r) * 2048 + h * 64 + pc * 8); }
    } else {
#pragma unroll
        for (int i = 0; i < 2; ++i) { const int idx = tid + 512 * i, r = idx >> 3, pc = idx & 7; R.g[i] = *(const u32x4*)(pb + (size_t)(row0 + r) * 2048 + 512 + h * 64 + pc * 8); }
        const u32x4* cb = coef_base(P, tix * 8 + h) + tid;
#pragma unroll
        for (int i = 0; i < 8; ++i) R.cf[i] = cb[i * 512];
    }
}
__device__ __forceinline__ void scan_group(const Params& P, int l, int wgI, bool final_mode, bool with_ctx, LAS unsigned char* lds) {
    const int tid = opaque_tid(), w = __builtin_amdgcn_readfirstlane(tid >> 6), lane = tid & 63, fr = lane & 15, fq = lane >> 4;
    const int h = wgI & 7, grp = wgI >> 3, gb = grp >> 3, j0 = (grp & 7) * 8;
    const int ctix = 256 + (wgI >> 3);
    const bool has_ctx = with_ctx && wgI < 64;
    const bf16_t* pb = (const bf16_t*)(P.ws + OFF_HID);
    float* summ = (float*)(P.ws + OFF_SUM);
    LAS f32x2* wcomp = (LAS f32x2*)(lds + SC_WCOMP_OFF); LAS float* car = (LAS float*)(lds + SC_CAR_OFF); LAS float* cw = (LAS float*)(lds + SC_CW_OFF);
    __syncthreads();
    if (!final_mode) { const bf16_t* wg = (const bf16_t*)(P.ws + OFF_WG);
      for (int idx = tid; idx < 2048; idx += 512) { const int mat = idx >> 9, e = (idx >> 3) & 63, pc = idx & 7;
          *(LAS u32x4*)(lds + SC_WG_OFF + (mat * 64 + e) * 144 + pc * 16) = *(const u32x4*)(wg + ((size_t)((l * 2 + (mat >> 1)) * 2 + (mat & 1)) * 8 + h) * 4096 + e * 64 + pc * 8); }
      if (tid < 320) { const int k = tid >> 6, ch = tid & 63; cw[tid] = k < 4 ? P.in[I_CONVW][(l * 4 + k) * 512 + h * 64 + ch] : P.in[I_CONVB][l * 512 + h * 64 + ch]; } }
    float brv[2][4], biv[2][4], sp8[2][4];
#pragma unroll
    for (int dir = 0; dir < 2; ++dir)
#pragma unroll
        for (int eb = 0; eb < 4; ++eb) { const int pidx = (l * 2 + dir) * 512 + h * 64 + eb * 16 + fr;
            brv[dir][eb] = -1.4426950408889634f * P.in[I_BR][pidx]; biv[dir][eb] = -1.4426950408889634f * P.in[I_BI][pidx]; sp8[dir][eb] = 8.0f * 1.4426950408889634f * log1pf(__expf(-P.in[I_LAM][pidx])); }
    if (final_mode) {
        LAS float* T = (LAS float*)(lds + SC_XL_OFF);
        { float tv[33];
#pragma unroll
          for (int i = 0; i < 33; ++i) { const int idx = tid + 512 * i; const int ch = idx & 63, ab = (idx >> 6) & 1, dir = (idx >> 7) & 1, k = idx >> 8;
              const int t = k < 2 ? 256 + 2 * gb + (dir == 0 ? k : 1 - k) : gb * 64 + (dir == 0 ? (k - 2) : (63 - (k - 2)));
              tv[i] = summ[((size_t)(t * 2 + dir) * 2 + ab) * 512 + h * 64 + ch]; }
#pragma unroll
          for (int i = 0; i < 33; ++i) { const int idx = tid + 512 * i; const int ch = idx & 63, ab = (idx >> 6) & 1, dir = (idx >> 7) & 1, k = idx >> 8;
              T[((dir * 66 + k) * 2 + ab) * 64 + ch] = tv[i]; } }
        __syncthreads();
        if (tid < 128) { const int dir = tid >> 6, ch = tid & 63; float s = 0.f;
#pragma unroll 6
            for (int k = 0; k < 66; ++k) {
                if (k >= 2) { const int i = (dir == 0 ? (k - 2) : (63 - (k - 2))) - j0; if (i >= 0 && i < 8) car[(dir * 9 + i) * 64 + ch] = s; }
                s = T[((dir * 66 + k) * 2 + 0) * 64 + ch] * s + T[((dir * 66 + k) * 2 + 1) * 64 + ch]; }
            float cs = 0.f;
            if (has_ctx) { const int cj = (ctix - 256) & 1; if (dir == 0 && cj == 1) cs = summ[((size_t)((ctix - 1) * 2 + 0) * 2 + 1) * 512 + h * 64 + ch]; if (dir == 1 && cj == 0) cs = summ[((size_t)((ctix + 1) * 2 + 1) * 2 + 1) * 512 + h * 64 + ch]; }
            car[(dir * 9 + 8) * 64 + ch] = cs; }
        __syncthreads();
    }
    const int nitems = 8 + (has_ctx ? 1 : 0);
    ScanPre R; scan_prefetch(R, P, pb, grp * 8, h, tid, final_mode);
#pragma unroll 1
    for (int it = 0; it < nitems; ++it) {
        const int tix = it < 8 ? grp * 8 + it : ctix;
        int row0, pos0, L, b; tile_info(tix, row0, pos0, L, b);
        if (!final_mode) {
#pragma unroll
        for (int i = 0; i < 3; ++i) { const int idx = tid + 512 * i; if (idx < 131 * 8) *(LAS u32x4*)(lds + SC_XL_OFF + (idx >> 3) * 128 + (idx & 7) * 16) = R.x[i]; }
        } else {
#pragma unroll
            for (int i = 0; i < 2; ++i) { const int idx = tid + 512 * i; *(LAS u32x4*)(lds + SC_GL_OFF + (idx >> 3) * 128 + (idx & 7) * 16) = R.g[i]; } }
        __syncthreads();
        if (it + 1 < nitems && !final_mode) scan_prefetch(R, P, pb, it + 1 < 8 ? grp * 8 + it + 1 : ctix, h, tid, final_mode);
        if (!final_mode) { const int q = tid >> 2, c4 = tid & 3; float a[16];
#pragma unroll
          for (int i = 0; i < 4; ++i) { const f32x4 bv = *(const LAS f32x4*)(cw + 256 + c4 * 16 + 4 * i); a[4 * i] = bv.x; a[4 * i + 1] = bv.y; a[4 * i + 2] = bv.z; a[4 * i + 3] = bv.w; }
#pragma unroll
          for (int k = 0; k < 4; ++k) {
              const u32x4 x0 = *(const LAS u32x4*)(lds + SC_XL_OFF + (q + k) * 128 + c4 * 32), x1 = *(const LAS u32x4*)(lds + SC_XL_OFF + (q + k) * 128 + c4 * 32 + 16);
              const unsigned xs[8] = {x0.x, x0.y, x0.z, x0.w, x1.x, x1.y, x1.z, x1.w};
#pragma unroll
              for (int i = 0; i < 4; ++i) { const f32x4 wv = *(const LAS f32x4*)(cw + k * 64 + c4 * 16 + 4 * i);
                  a[4 * i] += wv.x * bflo(xs[2 * i]); a[4 * i + 1] += wv.y * bfhi(xs[2 * i]); a[4 * i + 2] += wv.z * bflo(xs[2 * i + 1]); a[4 * i + 3] += wv.w * bfhi(xs[2 * i + 1]); } }
          LAS float* xo = (LAS float*)(lds + SC_XC_OFF + q * 272 + c4 * 64);
#pragma unroll
          for (int i = 0; i < 4; ++i) *(LAS f32x4*)(xo + 4 * i) = (f32x4){a[4 * i], a[4 * i + 1], a[4 * i + 2], a[4 * i + 3]}; }
        __syncthreads();
        bf16x8 af[2] = {};
        if (!final_mode) {
#pragma unroll
        for (int ks = 0; ks < 2; ++ks) { const LAS float* xr = (const LAS float*)(lds + SC_XC_OFF + (16 * w + fr) * 272) + ks * 32 + fq * 8;
            const f32x4 v0 = *(const LAS f32x4*)xr, v1 = *(const LAS f32x4*)(xr + 4);
            u32x4 t; t.x = pk2(v0.x, v0.y); t.y = pk2(v0.z, v0.w); t.z = pk2(v1.x, v1.y); t.w = pk2(v1.z, v1.w); af[ks] = __builtin_bit_cast(bf16x8, t); }
        }
        float ca[2][4][4], cbv[2][4][4], Ae[2][4], Be[2][4];
#pragma unroll
        for (int dir = 0; dir < 2; ++dir) {
#pragma unroll
            for (int eb = 0; eb < 4; ++eb) {
              if (!final_mode) {
                f32x4 pr = (f32x4){0.f, 0.f, 0.f, 0.f}, pi = pr;
#pragma unroll
                for (int ks = 0; ks < 2; ++ks) {
                    const bf16x8 br = *(const LAS bf16x8*)(lds + SC_WG_OFF + ((dir * 2 + 0) * 64 + eb * 16 + fr) * 144 + ks * 64 + fq * 16);
                    const bf16x8 bi = *(const LAS bf16x8*)(lds + SC_WG_OFF + ((dir * 2 + 1) * 64 + eb * 16 + fr) * 144 + ks * 64 + fq * 16);
                    pr = __builtin_amdgcn_mfma_f32_16x16x32_bf16(af[ks], br, pr, 0, 0, 0);
                    pi = __builtin_amdgcn_mfma_f32_16x16x32_bf16(af[ks], bi, pi, 0, 0, 0);
                }
                float la[4], ig[4], xv[4];
#pragma unroll
                for (int j = 0; j < 4; ++j) {
                    const float r = __builtin_amdgcn_rcpf(1.0f + __builtin_amdgcn_exp2f(pr[j] + brv[dir][eb])); ig[j] = __builtin_amdgcn_rcpf(1.0f + __builtin_amdgcn_exp2f(pi[j] + biv[dir][eb]));
                    xv[j] = *(const LAS float*)(lds + SC_XC_OFF + (16 * w + 4 * fq + j) * 272 + (eb * 16 + fr) * 4);
                    la[j] = -r * sp8[dir][eb]; }
                u32x4 pk; pk.x = pk2(la[0], la[1]); pk.y = pk2(la[2], la[3]);
                la[0] = bflo(pk.x); la[1] = bfhi(pk.x); la[2] = bflo(pk.y); la[3] = bfhi(pk.y);
                float bq[4];
#pragma unroll
                for (int j = 0; j < 4; ++j) { const float av = __builtin_amdgcn_exp2f(la[j]); ca[dir][eb][j] = av;
                    bq[j] = __builtin_amdgcn_sqrtf(__builtin_fmaf(-av, av, 1.0f)) * ig[j] * xv[j]; }
                pk.z = pk2(bq[0], bq[1]); pk.w = pk2(bq[2], bq[3]);
                cbv[dir][eb][0] = bflo(pk.z); cbv[dir][eb][1] = bfhi(pk.z); cbv[dir][eb][2] = bflo(pk.w); cbv[dir][eb][3] = bfhi(pk.w);
                coef_base(P, tix * 8 + h)[(dir * 4 + eb) * 512 + tid] = pk;
              } else {
                const u32x4 pk = R.cf[dir * 4 + eb];
                ca[dir][eb][0] = __builtin_amdgcn_exp2f(bflo(pk.x)); ca[dir][eb][1] = __builtin_amdgcn_exp2f(bfhi(pk.x)); ca[dir][eb][2] = __builtin_amdgcn_exp2f(bflo(pk.y)); ca[dir][eb][3] = __builtin_amdgcn_exp2f(bfhi(pk.y));
                cbv[dir][eb][0] = bflo(pk.z); cbv[dir][eb][1] = bfhi(pk.z); cbv[dir][eb][2] = bflo(pk.w); cbv[dir][eb][3] = bfhi(pk.w);
              }
                float A = 1.f, B = 0.f;
                if (dir == 0) {
#pragma unroll
                    for (int j = 0; j < 4; ++j) { B = ca[dir][eb][j] * B + cbv[dir][eb][j]; A *= ca[dir][eb][j]; }
                    float Ap = __shfl_up(A, 16), Bp = __shfl_up(B, 16); if (fq >= 1) { B = A * Bp + B; A = A * Ap; }
                    Ap = __shfl_up(A, 32); Bp = __shfl_up(B, 32); if (fq >= 2) { B = A * Bp + B; A = A * Ap; }
                    float ae = __shfl_up(A, 16), be = __shfl_up(B, 16); if (fq == 0) { ae = 1.f; be = 0.f; }
                    Ae[dir][eb] = ae; Be[dir][eb] = be;
                    if (fq == 3) wcomp[(0 * 8 + w) * 64 + eb * 16 + fr] = (f32x2){A, B};
                } else {
#pragma unroll
                    for (int j = 3; j >= 0; --j) { B = ca[dir][eb][j] * B + cbv[dir][eb][j]; A *= ca[dir][eb][j]; }
                    float Ap = __shfl_down(A, 16), Bp = __shfl_down(B, 16); if (fq <= 2) { B = A * Bp + B; A = A * Ap; }
                    Ap = __shfl_down(A, 32); Bp = __shfl_down(B, 32); if (fq <= 1) { B = A * Bp + B; A = A * Ap; }
                    float ae = __shfl_down(A, 16), be = __shfl_down(B, 16); if (fq == 3) { ae = 1.f; be = 0.f; }
                    Ae[dir][eb] = ae; Be[dir][eb] = be;
                    if (fq == 0) wcomp[(1 * 8 + w) * 64 + eb * 16 + fr] = (f32x2){A, B};
                }
            }
        }
        if (final_mode && it + 1 < nitems) scan_prefetch(R, P, pb, it + 1 < 8 ? grp * 8 + it + 1 : ctix, h, tid, final_mode);
        __syncthreads();
        if (!final_mode) {
            if (w == 0) {
                float A = 1.f, B = 0.f;
#pragma unroll
                for (int v = 0; v < 8; ++v) { const f32x2 cv = wcomp[(0 * 8 + v) * 64 + lane]; B = cv.x * B + cv.y; A = cv.x * A; }
                float* sp = summ + ((size_t)(tix * 2 + 0) * 2) * 512 + h * 64 + lane; sp[0] = A; sp[512] = B;
                A = 1.f; B = 0.f;
#pragma unroll
                for (int v = 7; v >= 0; --v) { const f32x2 cv = wcomp[(1 * 8 + v) * 64 + lane]; B = cv.x * B + cv.y; A = cv.x * A; }
                sp = summ + ((size_t)(tix * 2 + 1) * 2) * 512 + h * 64 + lane; sp[0] = A; sp[512] = B;
            }
        } else {
#pragma unroll
            for (int eb = 0; eb < 4; ++eb) {
                const int c = eb * 16 + fr;
                float s = car[(0 * 9 + it) * 64 + c];
#pragma unroll
                for (int v = 0; v < 7; ++v) { const f32x2 cv = wcomp[(0 * 8 + v) * 64 + c]; if (v < w) s = cv.x * s + cv.y; }
                s = Ae[0][eb] * s + Be[0][eb];
                float hf[4];
#pragma unroll
                for (int j = 0; j < 4; ++j) { s = ca[0][eb][j] * s + cbv[0][eb][j]; hf[j] = s; }
                s = car[(1 * 9 + it) * 64 + c];
#pragma unroll
                for (int v = 7; v > 0; --v) { const f32x2 cv = wcomp[(1 * 8 + v) * 64 + c]; if (v > w) s = cv.x * s + cv.y; }
                s = Ae[1][eb] * s + Be[1][eb];
#pragma unroll
                for (int j = 3; j >= 0; --j) { s = ca[1][eb][j] * s + cbv[1][eb][j]; hf[j] += s; }
#pragma unroll
                for (int j = 0; j < 4; ++j) {
                    const int q = 16 * w + 4 * fq + j;
                    const float g = bflo((unsigned)*(const LAS bf16_t*)(lds + SC_GL_OFF + q * 128 + c * 2));
                    const float ge = g * sigmoidf_(1.5957691216f * (g + 0.044715f * g * g * g));
                    *(LAS bf16_t*)(lds + SC_XC_OFF + q * 128 + c * 2) = (bf16_t)(pk2(hf[j] * ge, 0.f) & 0xffffu);
                }
            }
            __syncthreads();
            bf16_t* yb = (bf16_t*)(P.ws + OFF_Y);
#pragma unroll
            for (int i = 0; i < 2; ++i) { const int idx = tid + 512 * i, r = idx >> 3, pc = idx & 7;
                *(u32x4*)(yb + (size_t)(row0 + r) * D + h * 64 + pc * 8) = *(const LAS u32x4*)(lds + SC_XC_OFF + r * 128 + pc * 16); }
        }
    }
}
constexpr int ST_OFF = 0, VT_OFF = 1024;
__device__ __forceinline__ void sgu_item(const Params& P, int l, int tix, int g, LAS unsigned char* lds) {
    const int tid = opaque_tid(), w = __builtin_amdgcn_readfirstlane(tid >> 6), lane = tid & 63, fr = lane & 15, fq = lane >> 4;
    int row0, pos0, L, b; tile_info(tix, row0, pos0, L, b);
    const bf16_t* pb = (const bf16_t*)(P.ws + OFF_HID); bf16_t* yb = (bf16_t*)(P.ws + OFF_Y);
    LAS f32x2* stat = (LAS f32x2*)(lds + ST_OFF);
    __syncthreads();
    if (tid < 128) { const float* vp = (const float*)(P.ws + OFF_VST) + (size_t)(row0 + tid) * 16; float sm = 0.f, sq = 0.f;
#pragma unroll
        for (int i = 0; i < 4; ++i) { const f32x4 t = *(const f32x4*)(vp + 4 * i); sm += t.x + t.z; sq += t.y + t.w; }
        const float mean = sm * (1.0f / 512.0f), var = fmaxf(sq * (1.0f / 512.0f) - mean * mean, 0.f);
        stat[tid] = (f32x2){mean, rsqrtf(var + EPS)}; }
    __syncthreads();
    { const int qp = lane; const f32x2 s0 = stat[2 * qp], s1 = stat[2 * qp + 1];
#pragma unroll
      for (int it = 0; it < 2; ++it) { const int c0 = (w + 8 * it) * 8;
          const u32x4 r0 = *(const u32x4*)(pb + (size_t)(row0 + 2 * qp) * 2048 + 1536 + g * 128 + c0), r1 = *(const u32x4*)(pb + (size_t)(row0 + 2 * qp + 1) * 2048 + 1536 + g * 128 + c0);
          const float* gp = P.in[I_SGN] + l * 512 + g * 128 + c0; const f32x4 g0 = *(const f32x4*)gp, g1 = *(const f32x4*)(gp + 4);
          const float gn[8] = {g0.x, g0.y, g0.z, g0.w, g1.x, g1.y, g1.z, g1.w};
          const unsigned a[4] = {r0.x, r0.y, r0.z, r0.w}, bb[4] = {r1.x, r1.y, r1.z, r1.w};
#pragma unroll
          for (int i = 0; i < 4; ++i) {
              const float e0 = (bflo(a[i]) - s0.x) * s0.y * gn[2 * i], e1 = (bflo(bb[i]) - s1.x) * s1.y * gn[2 * i];
              const float o0 = (bfhi(a[i]) - s0.x) * s0.y * gn[2 * i + 1], o1 = (bfhi(bb[i]) - s1.x) * s1.y * gn[2 * i + 1];
              *(LAS unsigned*)(lds + VT_OFF + (c0 + 2 * i) * 272 + qp * 4) = pk2(e0, e1);
              *(LAS unsigned*)(lds + VT_OFF + (c0 + 2 * i + 1) * 272 + qp * 4) = pk2(o0, o1); } } }
    __syncthreads();
    const bf16_t* sgw = (const bf16_t*)(P.ws + OFF_SGW) + ((size_t)(l * 4 + g) * 128 + 16 * w + fr) * 128;
    bf16x8 bfr[4];
#pragma unroll
    for (int ks = 0; ks < 4; ++ks) bfr[ks] = *(const bf16x8*)(sgw + ks * 32 + fq * 8);
    const float bs = P.in[I_SGB][(l * 4 + g) * 128 + 16 * w + fr];
    const size_t prow = (size_t)(row0 + 16 * w + fr);
#pragma unroll
    for (int cb = 0; cb < 8; ++cb) {
        f32x4 acc = (f32x4){0.f, 0.f, 0.f, 0.f};
#pragma unroll
        for (int ks = 0; ks < 4; ++ks) { const bf16x8 a = *(const LAS bf16x8*)(lds + VT_OFF + (cb * 16 + fr) * 272 + (ks * 32 + fq * 8) * 2);
            acc = __builtin_amdgcn_mfma_f32_16x16x32_bf16(a, bfr[ks], acc, 0, 0, 0); }
        const int cc = g * 128 + cb * 16 + fq * 4;
        const u32x2 uu = *(const u32x2*)(pb + prow * 2048 + 1024 + cc);
        u32x2 o; o.x = pk2(bflo(uu.x) * (acc[0] + bs), bfhi(uu.x) * (acc[1] + bs)); o.y = pk2(bflo(uu.y) * (acc[2] + bs), bfhi(uu.y) * (acc[3] + bs));
        *(u32x2*)(yb + prow * D + 512 + cc) = o;
    }
}


#define XB_TMO      128
#define XB_XCNT(j)  (256  + 64 * (j))
#define XB_XSUB(j)  (1280 + 64 * (j))
#define XB_XGEN(j)  (2304 + 64 * (j))
#define XB_TOP      3328
#define XB_TOPGEN   3392
#define XCD_BAR_WORDS 3456
#define XB_SPIN_CAP (1u << 18)
__device__ __forceinline__ unsigned xb_ld(unsigned* p)              { return __hip_atomic_load(p, __ATOMIC_RELAXED, __HIP_MEMORY_SCOPE_AGENT); }
__device__ __forceinline__ unsigned xb_add(unsigned* p, unsigned v) { return __hip_atomic_fetch_add(p, v, __ATOMIC_RELAXED, __HIP_MEMORY_SCOPE_AGENT); }
__device__ __forceinline__ unsigned xb_xcc_id() { return (unsigned)__builtin_amdgcn_s_getreg((3 << 11) | 20) & 0xFu; }
#define XB_SPIN(cond, bar) do { unsigned _sp = 0; while (cond) { __builtin_amdgcn_s_sleep(1); \
    if ((++_sp & 255u) == 0u) { if (xb_ld(&(bar)[XB_TMO])) break; if (_sp > XB_SPIN_CAP) { atomicAdd(&(bar)[XB_TMO], 1u); break; } } } } while (0)
struct XcdBarrier { unsigned* bar; unsigned x; volatile LAS unsigned* st; };
__device__ __forceinline__ XcdBarrier xcd_barrier_post(unsigned* bar, volatile LAS unsigned* st) {
    XcdBarrier b; b.bar = bar; b.x = xb_xcc_id(); b.st = st;
    if (threadIdx.x == 0) (void)xb_add(&bar[XB_XCNT(b.x)], 1u);
    return b;
}
__device__ __forceinline__ void xcd_barrier_complete(unsigned* bar, unsigned x, unsigned& nloc, unsigned& nx) {
    const unsigned G = gridDim.x * gridDim.y * gridDim.z;
    unsigned sum, cnt, mine, sp = 0u;
    for (;;) {
        sum = 0u; cnt = 0u; mine = 0u;
#pragma unroll
        for (unsigned j = 0; j < 16; ++j) { const unsigned c = xb_ld(&bar[XB_XCNT(j)]); sum += c; cnt += (c > 0u) ? 1u : 0u; mine = (j == x) ? c : mine; }
        if (sum == G) break;
        __builtin_amdgcn_s_sleep(1);
        if ((++sp & 255u) == 0u) { if (xb_ld(&bar[XB_TMO])) break; if (sp > XB_SPIN_CAP) { atomicAdd(&bar[XB_TMO], 1u); break; } }
    }
    nloc = mine > 0u ? mine : 1u; nx = cnt > 0u ? cnt : 1u;
}
__device__ __forceinline__ void xcd_barrier(const XcdBarrier& b) {
    asm volatile("s_waitcnt vmcnt(0)" ::: "memory");
    __syncthreads();
    if (threadIdx.x == 0) {
        unsigned* bar = b.bar;
        __builtin_amdgcn_s_waitcnt(0);
        unsigned nloc = b.st[0], nx = b.st[1];
        if (nloc == 0u) { xcd_barrier_complete(bar, b.x, nloc, nx); b.st[0] = nloc; b.st[1] = nx; }
        const unsigned old = xb_add(&bar[XB_XSUB(b.x)], 1u);
        const unsigned gen = old / nloc;
        if (old + 1u == (gen + 1u) * nloc) {
            __builtin_amdgcn_fence(__ATOMIC_RELEASE, "agent");
            asm volatile("s_waitcnt vmcnt(0)" ::: "memory");
            const unsigned og = xb_add(&bar[XB_TOP], 1u);
            const unsigned tg = og / nx;
            if (og + 1u == (tg + 1u) * nx) xb_add(&bar[XB_TOPGEN], 1u);
            else XB_SPIN(xb_ld(&bar[XB_TOPGEN]) == tg, bar);
            __builtin_amdgcn_fence(__ATOMIC_ACQUIRE, "agent");
            xb_add(&bar[XB_XGEN(b.x)], 1u);
            asm volatile("s_waitcnt vmcnt(0)" ::: "memory");
        } else {
            XB_SPIN(xb_ld(&bar[XB_XGEN(b.x)]) == gen, bar);
            __builtin_amdgcn_fence(__ATOMIC_ACQUIRE, "agent");
            asm volatile("s_waitcnt vmcnt(0)" ::: "memory");
        }
    }
    __syncthreads();
}

__global__ void __launch_bounds__(512) fwd_mega(Params P) {
    extern __shared__ __attribute__((aligned(16))) unsigned char lds_raw[];
    LAS unsigned char* lds = (LAS unsigned char*)lds_raw;
    cg::grid_group grid = cg::this_grid();
    const int G = gridDim.x, c = blockIdx.x, tid = threadIdx.x;
    if (P.ws == nullptr) grid.sync();
    volatile LAS unsigned* xst = (volatile LAS unsigned*)(lds + 131072);
    if (tid == 0) { xst[0] = 0u; xst[1] = 0u; xst[2] = 0u; xst[3] = 0u; }
    __syncthreads();
    const XcdBarrier xb = xcd_barrier_post((unsigned*)(P.ws + OFF_BAR), xst);
    for (int it = c; it < 288; it += G) adaln_item(P, it, lds);
    { const int tw = opaque_tid(), wv = tw >> 6, ln = tw & 63; LAS float* scr = (LAS float*)(lds + 32768 + wv * 8448);
      for (int it = c * 8 + wv; it < 19968; it += G * 8) transpose_item(P, it, scr, ln); }
    { bf16_t* wg = (bf16_t*)(P.ws + OFF_WG);
      for (int i = c * 512 + tid; i < 262144; i += G * 512) { const int d = i & 63, e = (i >> 6) & 63, h = (i >> 12) & 7, gate = (i >> 15) & 1, dir = (i >> 16) & 1, l = i >> 17;
          const float* src = gate ? P.in[I_WI] : P.in[I_WR]; wg[i] = (bf16_t)(pk2(src[((size_t)((l * 2 + dir) * 8 + h) * 64 + d) * 64 + e] * -1.4426950408889634f, 0.f) & 0xffffu); }
      bf16_t* sg = (bf16_t*)(P.ws + OFF_SGW);
      for (int i = c * 512 + tid; i < 131072; i += G * 512) sg[i] = (bf16_t)(pk2(P.in[I_SGW][i], 0.f) & 0xffffu); }
    xcd_barrier(xb);
    for (int it = c; it < 416; it += G) shiftw_item(P, it, lds);
    { const int tw = opaque_tid(), wv = tw >> 6, ln = tw & 63;
      for (int row = c * 8 + wv; row < MT; row += 2 * G * 8) prep_item2(P, row, row + G * 8, row + G * 8 < MT, ln); }
    xcd_barrier(xb);
    bf16_t* AP = (bf16_t*)(P.ws + OFF_AP); bf16_t* YB = (bf16_t*)(P.ws + OFF_Y); bf16_t* HID = (bf16_t*)(P.ws + OFF_HID);
    float* RSQ = (float*)(P.ws + OFF_RSQ); float* VST = (float*)(P.ws + OFF_VST);
    const float* MODV = (const float*)(P.ws + OFF_MODV); const float* SW = (const float*)(P.ws + OFF_SW);
#pragma unroll 1
    for (int ph = 0; ph < 16; ++ph) {
        const int l = ph >> 3, st = ph & 7; const bool lastl = l == 1;
        const unsigned char* WL = P.ws + OFF_W + (size_t)l * LW_TOTAL;
        if (st == 0 || st == 6) {
            EpiSwiglu E; E.rtab = (const LAS float*)(lds + RSTD_OFF); E.vtab = (const LAS float*)(lds + VEC_OFF); E.hid = HID;
            const float* sWp = SW + (size_t)l * 5 * 13312 + (st == 0 ? 0 : 7680);
            pg8::Gemm g{AP, (const bf16_t*)(WL + (st == 0 ? LW_WIN1 : LW_WIN2)), MT, 5632, 1024};
            pg8::Order2 S; S.init(22, (st == 6 && lastl) ? 0 : 22, G, c);
            fill_tabs<1>(lds, S, RSQ, sWp, nullptr);
            pg8::gemm_phase<EpiSwiglu, pg8::Order2>(lds, g, S, E);
        } else if (st == 1 || st == 5 || st == 7) {
            EpiResid E; E.hb = (bf16_t*)(P.ws + OFF_HB);
            const int cg_ = st == 1 ? 2 : (st == 5 ? 5 : 8);
            E.gate = MODV + (size_t)(l * 5) * 9216 + cg_ * 1024;
            E.gsn = st == 1 ? MODV + (size_t)(l * 5) * 9216 + 4 * 1024 : (st == 5 ? MODV + (size_t)(l * 5) * 9216 + 7 * 1024 : (lastl ? (const float*)nullptr : MODV + (size_t)(5) * 9216 + 1 * 1024));
            E.ap = AP; E.rsq = RSQ;
            pg8::Gemm g{st == 5 ? YB : HID, (const bf16_t*)(WL + (st == 1 ? LW_WOUT1 : (st == 5 ? LW_WOUTM : LW_WOUT2))), MT, 1024, st == 5 ? 1024 : 2816};
            const int cpn = (st != 1 && lastl) ? 0 : 4; const int ks = (st != 5 && cpn) ? 11 : 1;
            E.part = (float*)(P.ws + OFF_Y);
            pg8::Order2 S; S.init(4, cpn, G, c, ks);
            E.vtab = (const LAS float*)(lds + VEC_OFF);
            fill_tabs<2>(lds, S, nullptr, E.gate, E.gsn);
            pg8::gemm_phase<EpiResid, pg8::Order2>(lds, g, S, E);
            if (ks > 1) {
                xcd_barrier(xb);
                const int tw = opaque_tid(), wv = tw >> 6, ln = tw & 63;
                for (int r = c * 8 + wv; r < NCTX; r += G * 8) ctx_fix_row(P, r, ln, ks, E.part, E.gate, E.gsn);
            }
        } else if (st == 2) {
            EpiInproj E; E.rtab = (const LAS float*)(lds + RSTD_OFF); E.vtab = (const LAS float*)(lds + VEC_OFF); E.p = HID; E.vst = VST;
            const float* sWp = SW + (size_t)l * 5 * 13312 + 5632;
            pg8::Gemm g{AP, (const bf16_t*)(WL + LW_WINM), MT, 2048, 1024};
            pg8::Order2 S; S.init(8, lastl ? 2 : 8, G, c);
            fill_tabs<3>(lds, S, RSQ, sWp, nullptr);
            pg8::gemm_phase<EpiInproj, pg8::Order2>(lds, g, S, E);
        } else if (st == 3) {
            for (int wgI = c; wgI < 256; wgI += G) scan_group(P, l, wgI, false, true, lds);
            const int nsgu = lastl ? 1024 : 1056;
            for (int it = c; it < nsgu; it += G) sgu_item(P, l, it >> 2, it & 3, lds);
        } else {
            for (int wgI = c; wgI < 256; wgI += G) scan_group(P, l, wgI, true, !lastl, lds);
        }
        xcd_barrier(xb);
    }
    for (int it = c; it < NLAT / 16; it += G) final_item(P, it);
}

extern "C" void kernel_launch(void* const* d_in, const int* in_sizes, int n_in, void* d_out, int out_size, void* d_ws, size_t ws_size, hipStream_t stream) {
    static int grid = 0;
    if (!grid) {
        if (n_in != 26 || ws_size < WS_END + COEF_TAIL_ITEMS * COEF_ITEM) { fprintf(stderr, "kernel_launch: unexpected n_in %d / ws_size %zu (need %zu)\n", n_in, ws_size, (size_t)WS_END); grid = -1; return; }
        int dev = 0, cus = 0, per_cu = 0;
        (void)hipGetDevice(&dev);
        (void)hipDeviceGetAttribute(&cus, hipDeviceAttributeMultiprocessorCount, dev);
        (void)hipFuncSetAttribute((const void*)fwd_mega, hipFuncAttributeMaxDynamicSharedMemorySize, LDS_BYTES);
        (void)hipOccupancyMaxActiveBlocksPerMultiprocessor(&per_cu, (const void*)fwd_mega, 512, LDS_BYTES);
        if (per_cu < 1) { fprintf(stderr, "kernel_launch: occupancy query says %d blocks per CU\n", per_cu); per_cu = 1; }
        grid = cus;
    }
    if (grid < 0) return;
    if (hipMemsetAsync((char*)d_ws + OFF_BAR, 0, BAR_BYTES, stream) != hipSuccess) { fprintf(stderr, "kernel_launch: memset of the barrier words failed\n"); return; }
    Params p{};
    for (int i = 0; i < 26; ++i) p.in[i] = (const float*)d_in[i];
    p.out = (float*)d_out; p.ws = (unsigned char*)d_ws;
    void* args[] = {&p};
    hipError_t e = hipLaunchCooperativeKernel((const void*)fwd_mega, dim3(grid), dim3(512), args, LDS_BYTES, stream);
    if (e != hipSuccess) fprintf(stderr, "cooperative launch failed: %s (grid %d)\n", hipGetErrorString(e), grid);
}
```

```cpp
#include <hip/hip_runtime.h>
#include <hip/hip_cooperative_groups.h>
#include <cstdio>
#include <cstdint>
namespace cg = cooperative_groups;

#define LAS __attribute__((address_space(3)))
#ifndef GLDS_AUX
#define GLDS_AUX 1
#endif
typedef unsigned short bf16_t;
typedef short bf16x8 __attribute__((ext_vector_type(8)));
typedef float f32x4 __attribute__((ext_vector_type(4)));
typedef float f32x2 __attribute__((ext_vector_type(2)));
typedef unsigned u32x4 __attribute__((ext_vector_type(4)));
typedef unsigned u32x2 __attribute__((ext_vector_type(2)));

__device__ __forceinline__ int opaque_tid() { int t = threadIdx.x; asm volatile("" : "+v"(t)); return t; }

namespace pg8 {
constexpr int BM = 256, BK = 64, HALF = 128, HTB = HALF * BK * 2, STAGE_BYTES = 8 * HTB, NXCD = 8, WGM = 4;
__host__ __device__ __forceinline__ int lds_byte(int r, int c) { const int st = (r >> 4) * 2 + (c >> 5), rr = r & 15, cc = c & 31, ob = rr * 64 + cc * 2; return st * 1024 + (ob ^ (((ob >> 9) & 1) << 5)); }
__host__ __device__ __forceinline__ void stage_rc(int b, int& R, int& C) { const int st = b / 1024, sb = b % 1024, swz = sb ^ (((sb >> 9) & 1) << 5); R = (st >> 1) * 16 + swz / 64; C = (st & 1) * 32 + (swz % 64) / 2; }
__host__ __device__ __forceinline__ int perm32(int rho) { const int n = rho >> 4, i = rho & 15; return 8 * (i >> 2) + 4 * n + (i & 3); }
struct Unit { int pm, pn, kc, ui; };
struct Gemm { const bf16_t* A; const bf16_t* Bt; int M, N, K; };

struct Order2 {
    int nN, nlat, cpn, total, G, c, ks;
    __device__ __forceinline__ void init(int nN_, int cpn_, int G_, int c_, int ks_ = 1) { nN = nN_; nlat = 128 * nN_; cpn = cpn_; ks = ks_; total = nlat + 4 * cpn_ * ks_; G = G_; c = c_; }
    __device__ __forceinline__ bool next(int i, Unit& u) const {
        const long L = (long)i * G + c; if (L >= total) return false;
        int pm, pn, kc = -1;
        if (L >= nlat) { int r = (int)L - nlat; if (ks > 1) { kc = r % ks; r /= ks; } pm = 128 + r / cpn; pn = r % cpn; }
        else { int wgid = (int)L; { const int q = nlat / NXCD, xcd = wgid % NXCD, off = wgid / NXCD; wgid = xcd * q + off; }
            const int nig = WGM * nN, gid = wgid / nig, fm = gid * WGM; pm = fm + ((wgid % nig) % WGM); pn = (wgid % nig) / WGM; }
        u.pm = pm; u.pn = pn; u.kc = kc; u.ui = i; return true;
    }
    __device__ __forceinline__ void a_ready(const Unit&) const {}
    __device__ __forceinline__ void done(const Unit&) const {}
};

template <class Epi, class Sched>
__device__ __forceinline__ void gemm_phase(LAS unsigned char* lds, const Gemm g, const Sched& S, const Epi& E) {
    const int tid = opaque_tid(), wid = __builtin_amdgcn_readfirstlane(tid >> 6), lane = tid & 63, wr = wid >> 2, wc = wid & 3, fr = lane & 15, fq = lane >> 4;
    const int K = g.K, ntf = K / BK, nts = S.ks > 1 ? ntf / S.ks : ntf;
    unsigned voffA[2], voffB[2];
#pragma unroll
    for (int i = 0; i < 2; ++i) { int R, C; stage_rc(tid * 16 + i * 8192, R, C); const int Rb = Epi::PERM ? ((R & ~31) + perm32(R & 31)) : R;
        voffA[i] = (unsigned)(R * K + C) * 2u; voffB[i] = (unsigned)(Rb * K + C) * 2u; }
    const size_t kstep = (size_t)(BK * 2);
    const size_t hstep = (size_t)HALF * K * 2;
    const size_t tstep = 2 * hstep;
    const unsigned ldsw = (unsigned)wid * 1024u;
    const int aoff = lds_byte(wr * 64 + fr, fq * 8), boff = lds_byte(wc * 32 + fr, fq * 8);
#define PG8_SA(b, h) (((b) * 2 + (h)) * HTB)
#define PG8_SB(b, h) ((4 + (b) * 2 + (h)) * HTB)
#define PG8_STAGE(bufoff, gbase, voff) do { _Pragma("unroll") for (int _i = 0; _i < 2; ++_i) \
        __builtin_amdgcn_global_load_lds((const unsigned*)((const char*)(gbase) + (voff)[_i]), (LAS unsigned*)(lds + (bufoff) + ldsw + _i * 8192), 16, 0, GLDS_AUX); } while (0)
#define PG8_LDA(dst, b, h) do { _Pragma("unroll") for (int m = 0; m < 4; ++m) _Pragma("unroll") for (int k = 0; k < 2; ++k) dst[m][k] = *(const LAS bf16x8*)(lds + PG8_SA(b, h) + aoff + m * 2048 + k * 1024); } while (0)
#define PG8_LDB(dst, b, h) do { _Pragma("unroll") for (int n = 0; n < 2; ++n) _Pragma("unroll") for (int k = 0; k < 2; ++k) dst[n][k] = *(const LAS bf16x8*)(lds + PG8_SB(b, h) + boff + n * 2048 + k * 1024); } while (0)
#define PG8_MMA(ai, bj, At, Bt) do { __builtin_amdgcn_s_setprio(1); _Pragma("unroll") for (int m = 0; m < 4; ++m) _Pragma("unroll") for (int n = 0; n < 2; ++n) _Pragma("unroll") for (int k = 0; k < 2; ++k) \
        acc[ai][bj][m][n] = __builtin_amdgcn_mfma_f32_16x16x32_bf16(Bt[n][k], At[m][k], acc[ai][bj][m][n], 0, 0, 0); __builtin_amdgcn_s_setprio(0); } while (0)
#define PG8_WAIT_V(n) asm volatile("s_waitcnt vmcnt(" #n ")" ::: "memory")
#define PG8_WAIT_L(n) asm volatile("s_waitcnt lgkmcnt(" #n ")" ::: "memory")
#define PG8_BAR __builtin_amdgcn_s_barrier()
#define PG8_SCHED __builtin_amdgcn_sched_barrier(0)
    Unit cur, nxt; int ui = 0;
    if (!S.next(0, cur)) return;
    f32x4 acc[2][2][4][2];
#pragma unroll
    for (int a = 0; a < 2; ++a)
#pragma unroll
        for (int b = 0; b < 2; ++b)
#pragma unroll
            for (int m = 0; m < 4; ++m)
#pragma unroll
                for (int n = 0; n < 2; ++n) acc[a][b][m][n] = (f32x4){0.f, 0.f, 0.f, 0.f};
    bf16x8 At[4][2], B0[2][2], B1[2][2];
    const char* cA = (const char*)g.A + (size_t)cur.pm * tstep + (cur.kc > 0 ? (size_t)cur.kc * nts * kstep : 0); const char* cB = (const char*)g.Bt + (size_t)cur.pn * tstep + (cur.kc > 0 ? (size_t)cur.kc * nts * kstep : 0);
    S.a_ready(cur);
    PG8_STAGE(PG8_SB(0, 0), cB, voffB); PG8_STAGE(PG8_SB(0, 1), cB + hstep, voffB); PG8_STAGE(PG8_SA(0, 0), cA, voffA); PG8_STAGE(PG8_SA(0, 1), cA + hstep, voffA);
    if (wr == 1) PG8_BAR;
    PG8_WAIT_V(2); PG8_BAR;
    PG8_STAGE(PG8_SB(1, 0), cB + kstep, voffB); PG8_STAGE(PG8_SA(1, 0), cA + kstep, voffA); PG8_STAGE(PG8_SB(1, 1), cB + hstep + kstep, voffB);
    PG8_WAIT_V(6); PG8_BAR;
    for (;;) {
        const bool has_next = S.next(ui + 1, nxt);
        const size_t nko = (has_next && nxt.kc > 0) ? (size_t)nxt.kc * nts * kstep : 0;
        const char* nA = has_next ? (const char*)g.A + (size_t)nxt.pm * tstep + nko : cA; const char* nB = has_next ? (const char*)g.Bt + (size_t)nxt.pn * tstep + nko : cB;
        const int nt = cur.kc >= 0 ? nts : ntf;
        for (int t = 0; t < nt; t += 2) {
            const bool last = (t == nt - 2);
            const char* a1 = cA + (size_t)(t + 1) * kstep;
            const char* a2 = last ? nA : cA + (size_t)(t + 2) * kstep; const char* b2 = last ? nB : cB + (size_t)(t + 2) * kstep;
            const char* a3 = a2 + kstep; const char* b3 = b2 + kstep;
            PG8_LDB(B0, 0, 0); PG8_LDB(B1, 0, 1); PG8_SCHED; PG8_LDA(At, 0, 0); PG8_STAGE(PG8_SA(1, 1), a1 + hstep, voffA);
            PG8_WAIT_V(8); PG8_WAIT_L(0); PG8_BAR; PG8_MMA(0, 0, At, B0); PG8_MMA(0, 1, At, B1); PG8_BAR; PG8_SCHED;
            PG8_LDA(At, 0, 1); PG8_STAGE(PG8_SB(0, 0), b2, voffB); PG8_STAGE(PG8_SB(0, 1), b2 + hstep, voffB); PG8_STAGE(PG8_SA(0, 0), a2, voffA);
            PG8_WAIT_V(8); PG8_WAIT_L(0); PG8_BAR; PG8_MMA(1, 0, At, B0); PG8_MMA(1, 1, At, B1); PG8_BAR; PG8_SCHED;
            PG8_LDB(B0, 1, 0); PG8_LDB(B1, 1, 1); PG8_SCHED; PG8_LDA(At, 1, 0); PG8_STAGE(PG8_SA(0, 1), a2 + hstep, voffA);
            PG8_WAIT_V(8); PG8_WAIT_L(0); PG8_BAR; PG8_MMA(0, 0, At, B0); PG8_MMA(0, 1, At, B1); PG8_BAR; PG8_SCHED;
            PG8_LDA(At, 1, 1); PG8_STAGE(PG8_SB(1, 0), b3, voffB); PG8_STAGE(PG8_SB(1, 1), b3 + hstep, voffB); PG8_STAGE(PG8_SA(1, 0), a3, voffA);
            PG8_WAIT_V(8); PG8_WAIT_L(0); PG8_BAR; PG8_MMA(1, 0, At, B0); PG8_MMA(1, 1, At, B1); PG8_BAR; PG8_SCHED;
        }
        if (wr == 0) PG8_BAR;
        E(acc, cur, wr, wc, fr, fq);
        if (!has_next) break;
#pragma unroll
        for (int a = 0; a < 2; ++a)
#pragma unroll
            for (int b = 0; b < 2; ++b)
#pragma unroll
                for (int m = 0; m < 4; ++m)
#pragma unroll
                    for (int n = 0; n < 2; ++n) acc[a][b][m][n] = (f32x4){0.f, 0.f, 0.f, 0.f};
        cur = nxt; cA = nA; cB = nB; ++ui;
        if (wr == 1) PG8_BAR;
    }
    PG8_WAIT_V(0);
    PG8_BAR;
#undef PG8_SA
#undef PG8_SB
#undef PG8_STAGE
#undef PG8_LDA
#undef PG8_LDB
#undef PG8_MMA
#undef PG8_WAIT_V
#undef PG8_WAIT_L
#undef PG8_BAR
#undef PG8_SCHED
}
}

constexpr int D = 1024, NB = 4, SEQ = 8192, CTXL = 256, DFF = 2816, NLAT = NB * SEQ, NCTX = NB * CTXL, MT = NLAT + NCTX;
constexpr float EPS = 1e-6f;
constexpr size_t OFF_HB = 0;
constexpr size_t OFF_AP = OFF_HB + (size_t)MT * D * 2;
constexpr size_t OFF_Y = OFF_AP + (size_t)MT * D * 2;
constexpr size_t OFF_HID = OFF_Y + (size_t)MT * D * 2;
constexpr size_t OFF_W = OFF_HID + (size_t)MT * DFF * 2;
constexpr size_t LW_WIN1 = 0, LW_WOUT1 = 11534336, LW_WINM = 17301504, LW_WOUTM = 21495808, LW_WIN2 = 23592960, LW_WOUT2 = 35127296, LW_TOTAL = 40894464;
constexpr size_t OFF_WG = OFF_W + 2 * LW_TOTAL;
constexpr size_t OFF_SGW = OFF_WG + 524288;
constexpr size_t OFF_MODV = OFF_SGW + 262144;
constexpr size_t OFF_SW = OFF_MODV + 368640;
constexpr size_t OFF_RSQ = OFF_SW + 532480;
constexpr size_t OFF_VST = OFF_RSQ + (size_t)MT * 16 * 4;
constexpr size_t OFF_SUM = OFF_VST + (size_t)MT * 16 * 4;
constexpr size_t OFF_BAR = OFF_SUM + (size_t)264 * 2048 * 4;
constexpr size_t BAR_BYTES = 16384;
constexpr size_t WS_END = OFF_BAR + BAR_BYTES;
constexpr int RSTD_OFF = 131072 + 16;
constexpr int VEC_OFF = RSTD_OFF + 12 * 256 * 4;
constexpr int LDS_BYTES = VEC_OFF + 12288;

struct Params { const float* in[26]; float* out; unsigned char* ws; };
enum { I_X = 0, I_C, I_CTX, I_CCTX, I_WADA, I_BADA, I_G1, I_W1IN, I_W1OUT, I_GMIX, I_WINM, I_CONVW, I_CONVB, I_WR, I_BR, I_WI, I_BI, I_LAM, I_SGN, I_SGW, I_SGB, I_WOUTM, I_G2, I_W2IN, I_W2OUT, I_GF };

__device__ __forceinline__ unsigned pk2(float lo, float hi) { unsigned r; asm("v_cvt_pk_bf16_f32 %0, %1, %2" : "=v"(r) : "v"(lo), "v"(hi)); return r; }
__device__ __forceinline__ float bflo(unsigned w) { return __uint_as_float(w << 16); }
__device__ __forceinline__ float bfhi(unsigned w) { return __uint_as_float(w & 0xffff0000u); }
__device__ __forceinline__ float sigmoidf_(float v) { return __builtin_amdgcn_rcpf(1.0f + __expf(-v)); }

__device__ __forceinline__ void rows_rstd(const LAS float* tab, int ui, int rl0, float (&rstd)[2][4]) {
#pragma unroll
    for (int ai = 0; ai < 2; ++ai)
#pragma unroll
        for (int m = 0; m < 4; ++m) rstd[ai][m] = tab[ui * 256 + rl0 + ai * 128 + m * 16];
}
template <int MODE, class Sched> __device__ __forceinline__ void fill_tabs(LAS unsigned char* lds, const Sched& S, const float* rsq, const float* v0, const float* v1) {
    const int tid = opaque_tid(); LAS float* tab = (LAS float*)(lds + RSTD_OFF); LAS float* vec = (LAS float*)(lds + VEC_OFF);
    for (int i = 0; i < 12; ++i) { pg8::Unit u; if (!S.next(i, u)) break;
        const int s = u.pm < 128 ? (u.pm >> 5) : 4;
        if (MODE != 2) {
            if (tid < 256) { const float* p = rsq + ((size_t)u.pm * 256 + tid) * 16; float t = 0.f;
#pragma unroll
                for (int j = 0; j < 4; ++j) { const f32x4 v = *(const f32x4*)(p + 4 * j); t += (v.x + v.y) + (v.z + v.w); }
                tab[i * 256 + tid] = rsqrtf(t * (1.0f / 1024.0f) + EPS); }
            else { const int t = tid - 256;
                vec[i * 256 + t] = MODE == 1 ? v0[s * 13312 + (t < 128 ? u.pn * 128 + t : 2816 + u.pn * 128 + (t - 128))] : v0[s * 13312 + u.pn * 256 + t]; }
        } else if (u.kc < 0 && i < 6) {
            vec[i * 512 + tid] = tid < 256 ? v0[s * 9216 + u.pn * 256 + tid] : (v1 ? v1[s * 9216 + u.pn * 256 + tid - 256] : 0.f);
        }
    }
    __syncthreads();
}
struct EpiSwiglu {
    static constexpr bool PERM = true;
    const LAS float* rtab; const LAS float* vtab; bf16_t* hid;
    __device__ __forceinline__ void operator()(const f32x4 (&acc)[2][2][4][2], const pg8::Unit& u, int wr, int wc, int fr_, int fq_) const {
        int fr = fr_, fq = fq_; asm volatile("" : "+v"(fr), "+v"(fq));
        const int s = u.pm < 128 ? (u.pm >> 5) : 4;
        const int row0 = u.pm * 256 + wr * 64 + fr, jc = u.pn * 128 + wc * 32 + fq * 8;
        const LAS float* swp = vtab + u.ui * 256 + wc * 32 + fq * 8;
        const f32x4 g0 = *(const LAS f32x4*)swp, g1 = *(const LAS f32x4*)(swp + 4), u0 = *(const LAS f32x4*)(swp + 128), u1 = *(const LAS f32x4*)(swp + 132);
        float rs[2][4]; rows_rstd(rtab, u.ui, wr * 64 + fr, rs);
#pragma unroll
        for (int ai = 0; ai < 2; ++ai)
#pragma unroll
            for (int m = 0; m < 4; ++m) {
                const int row = row0 + ai * 128 + m * 16; const float rstd = rs[ai][m];
                f32x4 g[2], up[2], e[2];
                g[0] = acc[ai][0][m][0] * rstd + g0; g[1] = acc[ai][0][m][1] * rstd + g1; up[0] = acc[ai][1][m][0] * rstd + u0; up[1] = acc[ai][1][m][1] * rstd + u1;
#pragma unroll
                for (int h = 0; h < 2; ++h) { const f32x4 t = g[h] * -1.4426950408889634f;
                    e[h] = (f32x4){__builtin_amdgcn_exp2f(t.x), __builtin_amdgcn_exp2f(t.y), __builtin_amdgcn_exp2f(t.z), __builtin_amdgcn_exp2f(t.w)}; }
#pragma unroll
                for (int h = 0; h < 2; ++h) { const f32x4 d = e[h] + 1.0f;
                    e[h] = (f32x4){__builtin_amdgcn_rcpf(d.x), __builtin_amdgcn_rcpf(d.y), __builtin_amdgcn_rcpf(d.z), __builtin_amdgcn_rcpf(d.w)}; }
#pragma unroll
                for (int h = 0; h < 2; ++h) g[h] = (g[h] * up[h]) * e[h];
                u32x4 w; w.x = pk2(g[0].x, g[0].y); w.y = pk2(g[0].z, g[0].w); w.z = pk2(g[1].x, g[1].y); w.w = pk2(g[1].z, g[1].w);
                *(u32x4*)(hid + (size_t)row * DFF + jc) = w;
            }
    }
};
struct EpiResid {
    static constexpr bool PERM = true;
    bf16_t* hb; const float* gate; const float* gsn; const LAS float* vtab; bf16_t* ap; float* rsq; float* part;
    __device__ __forceinline__ void operator()(const f32x4 (&acc)[2][2][4][2], const pg8::Unit& u, int wr, int wc, int fr_, int fq_) const {
        int fr = fr_, fq = fq_; asm volatile("" : "+v"(fr), "+v"(fq));
        const int cb0 = u.pn * 256 + wc * 32 + fq * 8;
        if (u.kc >= 0) {
            float* pp = part + ((size_t)u.kc * NCTX + (size_t)(u.pm - 128) * 256 + wr * 64 + fr) * D + cb0;
#pragma unroll
            for (int ai = 0; ai < 2; ++ai)
#pragma unroll
                for (int m = 0; m < 4; ++m)
#pragma unroll
                    for (int bj = 0; bj < 2; ++bj) { float* q = pp + (size_t)(ai * 128 + m * 16) * D + bj * 128; *(f32x4*)q = acc[ai][bj][m][0]; *(f32x4*)(q + 4) = acc[ai][bj][m][1]; }
            return;
        }
        const int s = u.pm < 128 ? (u.pm >> 5) : 4;
        f32x4 gt[2][2], gn[2][2];
#pragma unroll
        for (int bj = 0; bj < 2; ++bj) { const LAS float* gp = vtab + u.ui * 512 + bj * 128 + wc * 32 + fq * 8; gt[bj][0] = *(const LAS f32x4*)gp; gt[bj][1] = *(const LAS f32x4*)(gp + 4);
            gn[bj][0] = *(const LAS f32x4*)(gp + 256); gn[bj][1] = *(const LAS f32x4*)(gp + 260); }
        bf16_t* hbase = hb + ((size_t)u.pm * 256 + wr * 64 + fr) * D + cb0;
        u32x4 hv[2][2];
#pragma unroll
        for (int bj = 0; bj < 2; ++bj) hv[0][bj] = *(const u32x4*)(hbase + bj * 128);
#pragma unroll
        for (int it = 0; it < 8; ++it) {
            const int ai = it >> 2, m = it & 3;
            const size_t roff = (size_t)(ai * 128 + m * 16) * D; const size_t grow = (size_t)u.pm * 256 + ai * 128 + wr * 64 + m * 16 + fr;
            if (it < 7) { const size_t rn = (size_t)(((it + 1) >> 2) * 128 + ((it + 1) & 3) * 16) * D;
#pragma unroll
                for (int bj = 0; bj < 2; ++bj) hv[(it + 1) & 1][bj] = *(const u32x4*)(hbase + rn + bj * 128); }
            float sq = 0.f;
#pragma unroll
            for (int bj = 0; bj < 2; ++bj) {
                const u32x4 r = hv[it & 1][bj];
                const f32x4 o0 = (f32x4){bflo(r.x), bfhi(r.x), bflo(r.y), bfhi(r.y)}, o1 = (f32x4){bflo(r.z), bfhi(r.z), bflo(r.w), bfhi(r.w)};
                const f32x4 n0 = o0 + gt[bj][0] * acc[ai][bj][m][0], n1 = o1 + gt[bj][1] * acc[ai][bj][m][1];
                u32x4 hw; hw.x = pk2(n0.x, n0.y); hw.y = pk2(n0.z, n0.w); hw.z = pk2(n1.x, n1.y); hw.w = pk2(n1.z, n1.w);
                *(u32x4*)(hbase + roff + bj * 128) = hw;
                sq += (n0.x * n0.x + n0.y * n0.y) + (n0.z * n0.z + n0.w * n0.w) + (n1.x * n1.x + n1.y * n1.y) + (n1.z * n1.z + n1.w * n1.w);
                if (gsn) { const f32x4 a0 = n0 * gn[bj][0], a1 = n1 * gn[bj][1]; u32x4 w; w.x = pk2(a0.x, a0.y); w.y = pk2(a0.z, a0.w); w.z = pk2(a1.x, a1.y); w.w = pk2(a1.z, a1.w);
                    *(u32x4*)(ap + grow * D + cb0 + bj * 128) = w; }
            }
            sq += __shfl_xor(sq, 16); sq += __shfl_xor(sq, 32);
            if (fq == 0) rsq[grow * 16 + u.pn * 4 + wc] = sq;
        }
    }
};
struct EpiInproj {
    static constexpr bool PERM = true;
    const LAS float* rtab; const LAS float* vtab; bf16_t* p; float* vst;
    __device__ __forceinline__ void operator()(const f32x4 (&acc)[2][2][4][2], const pg8::Unit& u, int wr, int wc, int fr_, int fq_) const {
        int fr = fr_, fq = fq_; asm volatile("" : "+v"(fr), "+v"(fq));
        const int s = u.pm < 128 ? (u.pm >> 5) : 4;
        const int row0 = u.pm * 256 + wr * 64 + fr, cb0 = u.pn * 256 + wc * 32 + fq * 8;
        f32x4 sw[2][2];
#pragma unroll
        for (int bj = 0; bj < 2; ++bj) { const LAS float* sp = vtab + u.ui * 256 + bj * 128 + wc * 32 + fq * 8; sw[bj][0] = *(const LAS f32x4*)sp; sw[bj][1] = *(const LAS f32x4*)(sp + 4); }
        const bool isv = u.pn >= 6;
        float rs[2][4]; rows_rstd(rtab, u.ui, wr * 64 + fr, rs);
#pragma unroll
        for (int ai = 0; ai < 2; ++ai)
#pragma unroll
            for (int m = 0; m < 4; ++m) {
                const int row = row0 + ai * 128 + m * 16; const float rstd = rs[ai][m];
                float sm = 0.f, sq = 0.f;
#pragma unroll
                for (int bj = 0; bj < 2; ++bj) {
                    const f32x4 v0 = acc[ai][bj][m][0] * rstd + sw[bj][0], v1 = acc[ai][bj][m][1] * rstd + sw[bj][1];
                    u32x4 w; w.x = pk2(v0.x, v0.y); w.y = pk2(v0.z, v0.w); w.z = pk2(v1.x, v1.y); w.w = pk2(v1.z, v1.w);
                    *(u32x4*)(p + (size_t)row * 2048 + cb0 + bj * 128) = w;
                    sm += (v0.x + v0.y) + (v0.z + v0.w) + (v1.x + v1.y) + (v1.z + v1.w);
                    sq += (v0.x * v0.x + v0.y * v0.y) + (v0.z * v0.z + v0.w * v0.w) + (v1.x * v1.x + v1.y * v1.y) + (v1.z * v1.z + v1.w * v1.w);
                }
                if (isv) { sm += __shfl_xor(sm, 16); sm += __shfl_xor(sm, 32); sq += __shfl_xor(sq, 16); sq += __shfl_xor(sq, 32);
                    if (fq == 0) { float* vp = vst + (size_t)row * 16 + ((u.pn - 6) * 4 + wc) * 2; vp[0] = sm; vp[1] = sq; } }
            }
    }
};

__device__ __forceinline__ void gemv5_partial(const float* __restrict__ W, int ldw, int col, int k0, const LAS float* vin, float (&acc)[5]) {
#pragma unroll
    for (int s = 0; s < 5; ++s) acc[s] = 0.f;
#pragma unroll 32
    for (int k = k0; k < k0 + 128; ++k) { const float w = W[(size_t)k * ldw + col];
#pragma unroll
        for (int s = 0; s < 5; ++s) acc[s] += vin[s * 1024 + k] * w; }
}
__device__ __forceinline__ void adaln_item(const Params& P, int it, LAS unsigned char* lds) {
    const int tid = opaque_tid(), w = tid >> 6, lane = tid & 63;
    LAS float* vin = (LAS float*)lds; LAS float* red = (LAS float*)(lds + 20480);
    const int l = it / 144, c0 = (it % 144) * 64;
    for (int idx = tid; idx < 5120; idx += 512) { const int s = idx >> 10, k = idx & 1023; const float cv = s < 4 ? P.in[I_C][s * 1024 + k] : P.in[I_CCTX][k]; vin[idx] = cv / (1.0f + __expf(-cv)); }
    __syncthreads();
    float acc[5]; gemv5_partial(P.in[I_WADA] + (size_t)l * 1024 * 9216, 9216, c0 + lane, w * 128, vin, acc);
#pragma unroll
    for (int s = 0; s < 5; ++s) red[(w * 5 + s) * 64 + lane] = acc[s];
    __syncthreads();
    if (tid < 320) { const int s = tid >> 6; float m = 0.f;
#pragma unroll
        for (int v = 0; v < 8; ++v) m += red[(v * 5 + s) * 64 + lane];
        const int n = c0 + lane, chunk = n >> 10, k = n & 1023; m += P.in[I_BADA][l * 9216 + n];
        float val = m;
        if (chunk == 1) val = P.in[I_G1][l * 1024 + k] * (1.0f + m); else if (chunk == 4) val = P.in[I_GMIX][l * 1024 + k] * (1.0f + m); else if (chunk == 7) val = P.in[I_G2][l * 1024 + k] * (1.0f + m);
        else if (chunk == 2 || chunk == 8) val = 0.5f * m;
        ((float*)(P.ws + OFF_MODV))[((l * 5 + s) * 9 + chunk) * 1024 + k] = val; }
    __syncthreads();
}
__device__ __forceinline__ void shiftw_item(const Params& P, int it, LAS unsigned char* lds) {
    const int tid = opaque_tid(), w = tid >> 6, lane = tid & 63;
    LAS float* vin = (LAS float*)lds; LAS float* red = (LAS float*)(lds + 20480);
    const int l = it / 208; int r = it % 208; const float* W; int ldw, c0, off, chunk;
    if (r < 88) { W = P.in[I_W1IN] + (size_t)l * 1024 * 5632; ldw = 5632; c0 = r * 64; off = 0; chunk = 0; }
    else if (r < 120) { W = P.in[I_WINM] + (size_t)l * 1024 * 2048; ldw = 2048; c0 = (r - 88) * 64; off = 5632; chunk = 3; }
    else { W = P.in[I_W2IN] + (size_t)l * 1024 * 5632; ldw = 5632; c0 = (r - 120) * 64; off = 7680; chunk = 6; }
    const float* modv = (const float*)(P.ws + OFF_MODV);
    for (int idx = tid; idx < 5120; idx += 512) { const int s = idx >> 10, k = idx & 1023; vin[idx] = modv[((l * 5 + s) * 9 + chunk) * 1024 + k]; }
    __syncthreads();
    float acc[5]; gemv5_partial(W, ldw, c0 + lane, w * 128, vin, acc);
#pragma unroll
    for (int s = 0; s < 5; ++s) red[(w * 5 + s) * 64 + lane] = acc[s];
    __syncthreads();
    if (tid < 320) { const int s = tid >> 6; float m = 0.f;
#pragma unroll
        for (int v = 0; v < 8; ++v) m += red[(v * 5 + s) * 64 + lane];
        ((float*)(P.ws + OFF_SW))[(l * 5 + s) * 13312 + off + c0 + lane] = m; }
    __syncthreads();
}
__device__ __forceinline__ void transpose_item(const Params& P, int it, LAS float* scr, int lane) {
    const int l = it / 9984; int r = it % 9984; const float* W; int K, N; size_t dst; bool perm = false;
    if (r < 2816) { W = P.in[I_W1IN] + (size_t)l * 1024 * 5632; K = 1024; N = 5632; dst = LW_WIN1; perm = true; }
    else if ((r -= 2816) < 1408) { W = P.in[I_W1OUT] + (size_t)l * 2816 * 1024; K = 2816; N = 1024; dst = LW_WOUT1; }
    else if ((r -= 1408) < 1024) { W = P.in[I_WINM] + (size_t)l * 1024 * 2048; K = 1024; N = 2048; dst = LW_WINM; }
    else if ((r -= 1024) < 512) { W = P.in[I_WOUTM] + (size_t)l * 1024 * 1024; K = 1024; N = 1024; dst = LW_WOUTM; }
    else if ((r -= 512) < 2816) { W = P.in[I_W2IN] + (size_t)l * 1024 * 5632; K = 1024; N = 5632; dst = LW_WIN2; perm = true; }
    else { r -= 2816; W = P.in[I_W2OUT] + (size_t)l * 2816 * 1024; K = 2816; N = 1024; dst = LW_WOUT2; }
    const int ntn = N / 32, k0 = (r / ntn) * 64, n0 = (r % ntn) * 32;
    const int r0 = perm ? (((n0 % 2816) / 128) * 256 + (n0 / 2816) * 128 + (n0 % 128)) : n0;
    bf16_t* Bt = (bf16_t*)(P.ws + OFF_W + (size_t)l * LW_TOTAL + dst);
    float v[32];
#pragma unroll
    for (int i = 0; i < 32; ++i) { const int kk = 2 * i + (lane >> 5); v[i] = W[(size_t)(k0 + kk) * N + n0 + (lane & 31)]; }
#pragma unroll
    for (int i = 0; i < 32; ++i) { const int kk = 2 * i + (lane >> 5); scr[kk * 33 + (lane & 31)] = v[i]; }
    asm volatile("s_waitcnt lgkmcnt(0)" ::: "memory");
    const int c = lane & 7;
#pragma unroll
    for (int j = 0; j < 4; ++j) { const int n = (lane >> 3) + 8 * j; const LAS float* t = scr + (8 * c) * 33 + n;
        u32x4 o; o.x = pk2(t[0], t[33]); o.y = pk2(t[66], t[99]); o.z = pk2(t[132], t[165]); o.w = pk2(t[198], t[231]);
        *(u32x4*)(Bt + (size_t)(r0 + n) * K + k0 + 8 * c) = o; }
    asm volatile("s_waitcnt lgkmcnt(0)" ::: "memory");
}
__device__ __forceinline__ void prep_item2(const Params& P, int rowA, int rowB, bool hasB, int lane) {
    const int rows[2] = {rowA, hasB ? rowB : rowA};
    f32x4 v[2][4], g[2][4];
#pragma unroll
    for (int q = 0; q < 2; ++q) { const int row = rows[q]; const int s = row < NLAT ? (row >> 13) : 4;
        const float* src = row < NLAT ? P.in[I_X] + (size_t)row * D : P.in[I_CTX] + (size_t)(row - NLAT) * D;
        const float* gs = (const float*)(P.ws + OFF_MODV) + ((0 * 5 + s) * 9 + 1) * 1024;
#pragma unroll
        for (int j = 0; j < 4; ++j) { const int c = (lane + 64 * j) * 4; v[q][j] = *(const f32x4*)(src + c); g[q][j] = *(const f32x4*)(gs + c); } }
#pragma unroll
    for (int q = 0; q < 2; ++q) { if (q == 1 && !hasB) break; const int row = rows[q];
        bf16_t* ap = (bf16_t*)(P.ws + OFF_AP) + (size_t)row * D; bf16_t* hbp = (bf16_t*)(P.ws + OFF_HB) + (size_t)row * D;
        float sq = 0.f;
#pragma unroll
        for (int j = 0; j < 4; ++j) { const int c = (lane + 64 * j) * 4; const f32x4 x = v[q][j], gg = g[q][j];
            sq += (x.x * x.x + x.y * x.y) + (x.z * x.z + x.w * x.w);
            u32x2 o; o.x = pk2(x.x * gg.x, x.y * gg.y); o.y = pk2(x.z * gg.z, x.w * gg.w); *(u32x2*)(ap + c) = o;
            u32x2 hh; hh.x = pk2(x.x, x.y); hh.y = pk2(x.z, x.w); *(u32x2*)(hbp + c) = hh; }
#pragma unroll
        for (int o = 1; o < 64; o <<= 1) sq += __shfl_xor(sq, o);
        if (lane < 16) ((float*)(P.ws + OFF_RSQ))[(size_t)row * 16 + lane] = lane == 0 ? sq : 0.f; }
}
__device__ __forceinline__ void final_item(const Params& P, int it) {
    const int tid = opaque_tid(), w = tid >> 6, lane = tid & 63;
    const float* g = P.in[I_GF];
    u32x2 r[2][4]; f32x4 gg[4]; float t[2];
#pragma unroll
    for (int j = 0; j < 4; ++j) gg[j] = *(const f32x4*)(g + (lane + 64 * j) * 4);
#pragma unroll
    for (int q = 0; q < 2; ++q) { const int row = it * 16 + 2 * w + q;
        t[q] = ((const float*)(P.ws + OFF_RSQ))[(size_t)row * 16 + (lane & 15)];
        const bf16_t* hp = (const bf16_t*)(P.ws + OFF_HB) + (size_t)row * D;
#pragma unroll
        for (int j = 0; j < 4; ++j) r[q][j] = *(const u32x2*)(hp + (lane + 64 * j) * 4); }
#pragma unroll
    for (int q = 0; q < 2; ++q) { const int row = it * 16 + 2 * w + q; float tt = t[q];
        tt += __shfl_xor(tt, 1); tt += __shfl_xor(tt, 2); tt += __shfl_xor(tt, 4); tt += __shfl_xor(tt, 8);
        const float rstd = rsqrtf(tt * (1.0f / 1024.0f) + EPS);
        float* op = P.out + (size_t)row * D;
#pragma unroll
        for (int j = 0; j < 4; ++j) { const int c = (lane + 64 * j) * 4; *(f32x4*)(op + c) = (f32x4){bflo(r[q][j].x), bfhi(r[q][j].x), bflo(r[q][j].y), bfhi(r[q][j].y)} * rstd * gg[j]; } }
}

__device__ __forceinline__ void ctx_fix_row(const Params& P, int r, int lane, int ks, const float* part, const float* gate, const float* gsn) {
    const int c0 = lane * 16; const size_t grow = (size_t)NLAT + r;
    f32x4 sum[4];
#pragma unroll
    for (int i = 0; i < 4; ++i) sum[i] = (f32x4){0.f, 0.f, 0.f, 0.f};
    for (int k = 0; k < ks; ++k) { const float* pp = part + ((size_t)k * NCTX + r) * D + c0;
#pragma unroll
        for (int i = 0; i < 4; ++i) sum[i] += *(const f32x4*)(pp + 4 * i); }
    bf16_t* hp = (bf16_t*)(P.ws + OFF_HB) + grow * D + c0; bf16_t* ap = (bf16_t*)(P.ws + OFF_AP) + grow * D + c0;
    const u32x4 h0 = *(const u32x4*)hp, h1 = *(const u32x4*)(hp + 8);
    const unsigned hw[8] = {h0.x, h0.y, h0.z, h0.w, h1.x, h1.y, h1.z, h1.w};
    float n[16]; float sq = 0.f;
#pragma unroll
    for (int i = 0; i < 4; ++i) { const f32x4 g = *(const f32x4*)(gate + 4 * 9216 + c0 + 4 * i);
        n[4 * i] = bflo(hw[2 * i]) + g.x * sum[i].x; n[4 * i + 1] = bfhi(hw[2 * i]) + g.y * sum[i].y; n[4 * i + 2] = bflo(hw[2 * i + 1]) + g.z * sum[i].z; n[4 * i + 3] = bfhi(hw[2 * i + 1]) + g.w * sum[i].w; }
#pragma unroll
    for (int i = 0; i < 16; ++i) sq += n[i] * n[i];
    u32x4 o0, o1; o0.x = pk2(n[0], n[1]); o0.y = pk2(n[2], n[3]); o0.z = pk2(n[4], n[5]); o0.w = pk2(n[6], n[7]); o1.x = pk2(n[8], n[9]); o1.y = pk2(n[10], n[11]); o1.z = pk2(n[12], n[13]); o1.w = pk2(n[14], n[15]);
    *(u32x4*)hp = o0; *(u32x4*)(hp + 8) = o1;
    if (gsn) {
#pragma unroll
        for (int i = 0; i < 4; ++i) { const f32x4 g = *(const f32x4*)(gsn + 4 * 9216 + c0 + 4 * i); n[4 * i] *= g.x; n[4 * i + 1] *= g.y; n[4 * i + 2] *= g.z; n[4 * i + 3] *= g.w; }
        o0.x = pk2(n[0], n[1]); o0.y = pk2(n[2], n[3]); o0.z = pk2(n[4], n[5]); o0.w = pk2(n[6], n[7]); o1.x = pk2(n[8], n[9]); o1.y = pk2(n[10], n[11]); o1.z = pk2(n[12], n[13]); o1.w = pk2(n[14], n[15]);
        *(u32x4*)ap = o0; *(u32x4*)(ap + 8) = o1; }
    sq += __shfl_xor(sq, 1); sq += __shfl_xor(sq, 2);
    if ((lane & 3) == 0) ((float*)(P.ws + OFF_RSQ))[grow * 16 + (lane >> 2)] = sq;
}

__device__ __forceinline__ void tile_info(int tix, int& row0, int& pos0, int& L, int& b) {
    if (tix < 256) { b = tix >> 6; pos0 = (tix & 63) * 128; row0 = b * SEQ + pos0; L = SEQ; }
    else { const int c = tix - 256; b = c >> 1; pos0 = (c & 1) * 128; row0 = NLAT + b * CTXL + pos0; L = CTXL; }
}
constexpr int SC_WG_OFF = 0, SC_CW_OFF = 36864, SC_CAR_OFF = 38144, SC_WCOMP_OFF = 42752, SC_XL_OFF = 50944, SC_GL_OFF = 67840, SC_XC_OFF = 84224;
struct ScanPre { u32x4 x[3]; u32x4 g[2]; u32x4 cf[8]; };
constexpr size_t COEF_ITEM = 65536, COEF_TAIL_ITEMS = 264;
__device__ __forceinline__ u32x4* coef_base(const Params& P, int item) {
    const size_t off = item < 1056 ? OFF_AP + (size_t)item * COEF_ITEM : (item < 1848 ? OFF_HID + (size_t)MT * 2048 * 2 + (size_t)(item - 1056) * COEF_ITEM : WS_END + (size_t)(item - 1848) * COEF_ITEM);
    return (u32x4*)(P.ws + off);
}
__device__ __forceinline__ void scan_prefetch(ScanPre& R, const Params& P, const bf16_t* pb, int tix, int h, int tid, bool final_mode) {
    int row0, pos0, L, b; tile_info(tix, row0, pos0, L, b);
    if (!final_mode) {
#pragma unroll
        for (int i = 0; i < 3; ++i) { const int idx = tid + 512 * i, r = idx >> 3, pc = idx & 7, pos = pos0 - 2 + r; R.x[i] = (u32x4){0u, 0u, 0u, 0u};
            if (idx < 131 * 8 && pos >= 0 && pos < L) R.x[i] = *(const u32x4*)(pb + (size_t)(row0 - 2 + r) * 2048 + h * 64 + pc * 8); }
    } else {
#pragma unroll
        for (int i = 0; i < 2; ++i) { const int idx = tid + 512 * i, r = idx >> 3, pc = idx & 7; R.g[i] = *(const u32x4*)(pb + (size_t)(row0 + r) * 2048 + 512 + h * 64 + pc * 8); }
        const u32x4* cb = coef_base(P, tix * 8 + h) + tid;
#pragma unroll
        for (int i = 0; i < 8; ++i) R.cf[i] = cb[i * 512];
    }
}
__device__ __forceinline__ void scan_group(const Params& P, int l, int wgI, bool final_mode, bool with_ctx, LAS unsigned char* lds) {
    const int tid = opaque_tid(), w = __builtin_amdgcn_readfirstlane(tid >> 6), lane = tid & 63, fr = lane & 15, fq = lane >> 4;
    const int h = wgI & 7, grp = wgI >> 3, gb = grp >> 3, j0 = (grp & 7) * 8;
    const int ctix = 256 + (wgI >> 3);
    const bool has_ctx = with_ctx && wgI < 64;
    const bf16_t* pb = (const bf16_t*)(P.ws + OFF_HID);
    float* summ = (float*)(P.ws + OFF_SUM);
    LAS f32x2* wcomp = (LAS f32x2*)(lds + SC_WCOMP_OFF); LAS float* car = (LAS float*)(lds + SC_CAR_OFF); LAS float* cw = (LAS float*)(lds + SC_CW_OFF);
    __syncthreads();
    if (!final_mode) { const bf16_t* wg = (const bf16_t*)(P.ws + OFF_WG);
      for (int idx = tid; idx < 2048; idx += 512) { const int mat = idx >> 9, e = (idx >> 3) & 63, pc = idx & 7;
          *(LAS u32x4*)(lds + SC_WG_OFF + (mat * 64 + e) * 144 + pc * 16) = *(const u32x4*)(wg + ((size_t)((l * 2 + (mat >> 1)) * 2 + (mat & 1)) * 8 + h) * 4096 + e * 64 + pc * 8); }
      if (tid < 320) { const int k = tid >> 6, ch = tid & 63; cw[tid] = k < 4 ? P.in[I_CONVW][(l * 4 + k) * 512 + h * 64 + ch] : P.in[I_CONVB][l * 512 + h * 64 + ch]; } }
    float brv[2][4], biv[2][4], sp8[2][4];
#pragma unroll
    for (int dir = 0; dir < 2; ++dir)
#pragma unroll
        for (int eb = 0; eb < 4; ++eb) { const int pidx = (l * 2 + dir) * 512 + h * 64 + eb * 16 + fr;
            brv[dir][eb] = -1.4426950408889634f * P.in[I_BR][pidx]; biv[dir][eb] = -1.4426950408889634f * P.in[I_BI][pidx]; sp8[dir][eb] = 8.0f * 1.4426950408889634f * log1pf(__expf(-P.in[I_LAM][pidx])); }
    if (final_mode) {
        LAS float* T = (LAS float*)(lds + SC_XL_OFF);
        { float tv[33];
#pragma unroll
          for (int i = 0; i < 33; ++i) { const int idx = tid + 512 * i; const int ch = idx & 63, ab = (idx >> 6) & 1, dir = (idx >> 7) & 1, k = idx >> 8;
              const int t = k < 2 ? 256 + 2 * gb + (dir == 0 ? k : 1 - k) : gb * 64 + (dir == 0 ? (k - 2) : (63 - (k - 2)));
              tv[i] = summ[((size_t)(t * 2 + dir) * 2 + ab) * 512 + h * 64 + ch]; }
#pragma unroll
          for (int i = 0; i < 33; ++i) { const int idx = tid + 512 * i; const int ch = idx & 63, ab = (idx >> 6) & 1, dir = (idx >> 7) & 1, k = idx >> 8;
              T[((dir * 66 + k) * 2 + ab) * 64 + ch] = tv[i]; } }
        __syncthreads();
        if (tid < 128) { const int dir = tid >> 6, ch = tid & 63; float s = 0.f;
#pragma unroll 6
            for (int k = 0; k < 66; ++k) {
                if (k >= 2) { const int i = (dir == 0 ? (k - 2) : (63 - (k - 2))) - j0; if (i >= 0 && i < 8) car[(dir * 9 + i) * 64 + ch] = s; }
                s = T[((dir * 66 + k) * 2 + 0) * 64 + ch] * s + T[((dir * 66 + k) * 2 + 1) * 64 + ch]; }
            float cs = 0.f;
            if (has_ctx) { const int cj = (ctix - 256) & 1; if (dir == 0 && cj == 1) cs = summ[((size_t)((ctix - 1) * 2 + 0) * 2 + 1) * 512 + h * 64 + ch]; if (dir == 1 && cj == 0) cs = summ[((size_t)((ctix + 1) * 2 + 1) * 2 + 1) * 512 + h * 64 + ch]; }
            car[(dir * 9 + 8) * 64 + ch] = cs; }
        __syncthreads();
    }
    const int nitems = 8 + (has_ctx ? 1 : 0);
    ScanPre R; scan_prefetch(R, P, pb, grp * 8, h, tid, final_mode);
#pragma unroll 1
    for (int it = 0; it < nitems; ++it) {
        const int tix = it < 8 ? grp * 8 + it : ctix;
        int row0, pos0, L, b; tile_info(tix, row0, pos0, L, b);
        if (!final_mode) {
#pragma unroll
        for (int i = 0; i < 3; ++i) { const int idx = tid + 512 * i; if (idx < 131 * 8) *(LAS u32x4*)(lds + SC_XL_OFF + (idx >> 3) * 128 + (idx & 7) * 16) = R.x[i]; }
        } else {
#pragma unroll
            for (int i = 0; i < 2; ++i) { const int idx = tid + 512 * i; *(LAS u32x4*)(lds + SC_GL_OFF + (idx >> 3) * 128 + (idx & 7) * 16) = R.g[i]; } }
        __syncthreads();
        if (it + 1 < nitems && !final_mode) scan_prefetch(R, P, pb, it + 1 < 8 ? grp * 8 + it + 1 : ctix, h, tid, final_mode);
        if (!final_mode) { const int q = tid >> 2, c4 = tid & 3; float a[16];
#pragma unroll
          for (int i = 0; i < 4; ++i) { const f32x4 bv = *(const LAS f32x4*)(cw + 256 + c4 * 16 + 4 * i); a[4 * i] = bv.x; a[4 * i + 1] = bv.y; a[4 * i + 2] = bv.z; a[4 * i + 3] = bv.w; }
#pragma unroll
          for (int k = 0; k < 4; ++k) {
              const u32x4 x0 = *(const LAS u32x4*)(lds + SC_XL_OFF + (q + k) * 128 + c4 * 32), x1 = *(const LAS u32x4*)(lds + SC_XL_OFF + (q + k) * 128 + c4 * 32 + 16);
              const unsigned xs[8] = {x0.x, x0.y, x0.z, x0.w, x1.x, x1.y, x1.z, x1.w};
#pragma unroll
              for (int i = 0; i < 4; ++i) { const f32x4 wv = *(const LAS f32x4*)(cw + k * 64 + c4 * 16 + 4 * i);
                  a[4 * i] += wv.x * bflo(xs[2 * i]); a[4 * i + 1] += wv.y * bfhi(xs[2 * i]); a[4 * i + 2] += wv.z * bflo(xs[2 * i + 1]); a[4 * i + 3] += wv.w * bfhi(xs[2 * i + 1]); } }
          LAS float* xo = (LAS float*)(lds + SC_XC_OFF + q * 272 + c4 * 64);
#pragma unroll
          for (int i = 0; i < 4; ++i) *(LAS f32x4*)(xo + 4 * i) = (f32x4){a[4 * i], a[4 * i + 1], a[4 * i + 2], a[4 * i + 3]}; }
        __syncthreads();
        bf16x8 af[2] = {};
        if (!final_mode) {
#pragma unroll
        for (int ks = 0; ks < 2; ++ks) { const LAS float* xr = (const LAS float*)(lds + SC_XC_OFF + (16 * w + fr) * 272) + ks * 32 + fq * 8;
            const f32x4 v0 = *(const LAS f32x4*)xr, v1 = *(const LAS f32x4*)(xr + 4);
            u32x4 t; t.x = pk2(v0.x, v0.y); t.y = pk2(v0.z, v0.w); t.z = pk2(v1.x, v1.y); t.w = pk2(v1.z, v1.w); af[ks] = __builtin_bit_cast(bf16x8, t); }
        }
        float ca[2][4][4], cbv[2][4][4], Ae[2][4], Be[2][4];
#pragma unroll
        for (int dir = 0; dir < 2; ++dir) {
#pragma unroll
            for (int eb = 0; eb < 4; ++eb) {
              if (!final_mode) {
                f32x4 pr = (f32x4){0.f, 0.f, 0.f, 0.f}, pi = pr;
#pragma unroll
                for (int ks = 0; ks < 2; ++ks) {
                    const bf16x8 br = *(const LAS bf16x8*)(lds + SC_WG_OFF + ((dir * 2 + 0) * 64 + eb * 16 + fr) * 144 + ks * 64 + fq * 16);
                    const bf16x8 bi = *(const LAS bf16x8*)(lds + SC_WG_OFF + ((dir * 2 + 1) * 64 + eb * 16 + fr) * 144 + ks * 64 + fq * 16);
                    pr = __builtin_amdgcn_mfma_f32_16x16x32_bf16(af[ks], br, pr, 0, 0, 0);
                    pi = __builtin_amdgcn_mfma_f32_16x16x32_bf16(af[ks], bi, pi, 0, 0, 0);
                }
                float la[4], ig[4], xv[4];
#pragma unroll
                for (int j = 0; j < 4; ++j) {
                    const float r = __builtin_amdgcn_rcpf(1.0f + __builtin_amdgcn_exp2f(pr[j] + brv[dir][eb])); ig[j] = __builtin_amdgcn_rcpf(1.0f + __builtin_amdgcn_exp2f(pi[j] + biv[dir][eb]));
                    xv[j] = *(const LAS float*)(lds + SC_XC_OFF + (16 * w + 4 * fq + j) * 272 + (eb * 16 + fr) * 4);
                    la[j] = -r * sp8[dir][eb]; }
                u32x4 pk; pk.x = pk2(la[0], la[1]); pk.y = pk2(la[2], la[3]);
                la[0] = bflo(pk.x); la[1] = bfhi(pk.x); la[2] = bflo(pk.y); la[3] = bfhi(pk.y);
                float bq[4];
#pragma unroll
                for (int j = 0; j < 4; ++j) { const float av = __builtin_amdgcn_exp2f(la[j]); ca[dir][eb][j] = av;
                    bq[j] = __builtin_amdgcn_sqrtf(__builtin_fmaf(-av, av, 1.0f)) * ig[j] * xv[j]; }
                pk.z = pk2(bq[0], bq[1]); pk.w = pk2(bq[2], bq[3]);
                cbv[dir][eb][0] = bflo(pk.z); cbv[dir][eb][1] = bfhi(pk.z); cbv[dir][eb][2] = bflo(pk.w); cbv[dir][eb][3] = bfhi(pk.w);
                coef_base(P, tix * 8 + h)[(dir * 4 + eb) * 512 + tid] = pk;
              } else {
                const u32x4 pk = R.cf[dir * 4 + eb];
                ca[dir][eb][0] = __builtin_amdgcn_exp2f(bflo(pk.x)); ca[dir][eb][1] = __builtin_amdgcn_exp2f(bfhi(pk.x)); ca[dir][eb][2] = __builtin_amdgcn_exp2f(bflo(pk.y)); ca[dir][eb][3] = __builtin_amdgcn_exp2f(bfhi(pk.y));
                cbv[dir][eb][0] = bflo(pk.z); cbv[dir][eb][1] = bfhi(pk.z); cbv[dir][eb][2] = bflo(pk.w); cbv[dir][eb][3] = bfhi(pk.w);
              }
                float A = 1.f, B = 0.f;
                if (dir == 0) {
#pragma unroll
                    for (int j = 0; j < 4; ++j) { B = ca[dir][eb][j] * B + cbv[dir][eb][j]; A *= ca[dir][eb][j]; }
                    float Ap = __shfl_up(A, 16), Bp = __shfl_up(B, 16); if (fq >= 1) { B = A * Bp + B; A = A * Ap; }
                    Ap = __shfl_up(A, 32); Bp = __shfl_up(B, 32); if (fq >= 2) { B = A * Bp + B; A = A * Ap; }
                    float ae = __shfl_up(A, 16), be = __shfl_up(B, 16); if (fq == 0) { ae = 1.f; be = 0.f; }
                    Ae[dir][eb] = ae; Be[dir][eb] = be;
                    if (fq == 3) wcomp[(0 * 8 + w) * 64 + eb * 16 + fr] = (f32x2){A, B};
                } else {
#pragma unroll
                    for (int j = 3; j >= 0; --j) { B = ca[dir][eb][j] * B + cbv[dir][eb][j]; A *= ca[dir][eb][j]; }
                    float Ap = __shfl_down(A, 16), Bp = __shfl_down(B, 16); if (fq <= 2) { B = A * Bp + B; A = A * Ap; }
                    Ap = __shfl_down(A, 32); Bp = __shfl_down(B, 32); if (fq <= 1) { B = A * Bp + B; A = A * Ap; }
                    float ae = __shfl_down(A, 16), be = __shfl_down(B, 16); if (fq == 3) { ae = 1.f; be = 0.f; }
                    Ae[dir][eb] = ae; Be[dir][eb] = be;
                    if (fq == 0) wcomp[(1 * 8 + w) * 64 + eb * 16 + fr] = (f32x2){A, B};
                }
            }
        }
        if (final_mode && it + 1 < nitems) scan_prefetch(R, P, pb, it + 1 < 8 ? grp * 8 + it + 1 : ctix, h, tid, final_mode);
        __syncthreads();
        if (!final_mode) {
            if (w == 0) {
                float A = 1.f, B = 0.f;
#pragma unroll
                for (int v = 0; v < 8; ++v) { const f32x2 cv = wcomp[(0 * 8 + v) * 64 + lane]; B = cv.x * B + cv.y; A = cv.x * A; }
                float* sp = summ + ((size_t)(tix * 2 + 0) * 2) * 512 + h * 64 + lane; sp[0] = A; sp[512] = B;
                A = 1.f; B = 0.f;
#pragma unroll
                for (int v = 7; v >= 0; --v) { const f32x2 cv = wcomp[(1 * 8 + v) * 64 + lane]; B = cv.x * B + cv.y; A = cv.x * A; }
                sp = summ + ((size_t)(tix * 2 + 1) * 2) * 512 + h * 64 + lane; sp[0] = A; sp[512] = B;
            }
        } else {
#pragma unroll
            for (int eb = 0; eb < 4; ++eb) {
                const int c = eb * 16 + fr;
                float s = car[(0 * 9 + it) * 64 + c];
#pragma unroll
                for (int v = 0; v < 7; ++v) { const f32x2 cv = wcomp[(0 * 8 + v) * 64 + c]; if (v < w) s = cv.x * s + cv.y; }
                s = Ae[0][eb] * s + Be[0][eb];
                float hf[4];
#pragma unroll
                for (int j = 0; j < 4; ++j) { s = ca[0][eb][j] * s + cbv[0][eb][j]; hf[j] = s; }
                s = car[(1 * 9 + it) * 64 + c];
#pragma unroll
                for (int v = 7; v > 0; --v) { const f32x2 cv = wcomp[(1 * 8 + v) * 64 + c]; if (v > w) s = cv.x * s + cv.y; }
                s = Ae[1][eb] * s + Be[1][eb];
#pragma unroll
                for (int j = 3; j >= 0; --j) { s = ca[1][eb][j] * s + cbv[1][eb][j]; hf[j] += s; }
#pragma unroll
                for (int j = 0; j < 4; ++j) {
                    const int q = 16 * w + 4 * fq + j;
                    const float g = bflo((unsigned)*(const LAS bf16_t*)(lds + SC_GL_OFF + q * 128 + c * 2));
                    const float ge = g * sigmoidf_(1.5957691216f * (g + 0.044715f * g * g * g));
                    *(LAS bf16_t*)(lds + SC_XC_OFF + q * 128 + c * 2) = (bf16_t)(pk2(hf[j] * ge, 0.f) & 0xffffu);
                }
            }
            __syncthreads();
            bf16_t* yb = (bf16_t*)(P.ws + OFF_Y);
#pragma unroll
            for (int i = 0; i < 2; ++i) { const int idx = tid + 512 * i, r = idx >> 3, pc = idx & 7;
                *(u32x4*)(yb + (size_t)(row0 + r) * D + h * 64 + pc * 8) = *(const LAS u32x4*)(lds + SC_XC_OFF + r * 128 + pc * 16); }
        }
    }
}
constexpr int ST_OFF = 0, VT_OFF = 1024;
__device__ __forceinline__ void sgu_item(const Params& P, int l, int tix, int g, LAS unsigned char* lds) {
    const int tid = opaque_tid(), w = __builtin_amdgcn_readfirstlane(tid >> 6), lane = tid & 63, fr = lane & 15, fq = lane >> 4;
    int row0, pos0, L, b; tile_info(tix, row0, pos0, L, b);
    const bf16_t* pb = (const bf16_t*)(P.ws + OFF_HID); bf16_t* yb = (bf16_t*)(P.ws + OFF_Y);
    LAS f32x2* stat = (LAS f32x2*)(lds + ST_OFF);
    __syncthreads();
    if (tid < 128) { const float* vp = (const float*)(P.ws + OFF_VST) + (size_t)(row0 + tid) * 16; float sm = 0.f, sq = 0.f;
#pragma unroll
        for (int i = 0; i < 4; ++i) { const f32x4 t = *(const f32x4*)(vp + 4 * i); sm += t.x + t.z; sq += t.y + t.w; }
        const float mean = sm * (1.0f / 512.0f), var = fmaxf(sq * (1.0f / 512.0f) - mean * mean, 0.f);
        stat[tid] = (f32x2){mean, rsqrtf(var + EPS)}; }
    __syncthreads();
    { const int qp = lane; const f32x2 s0 = stat[2 * qp], s1 = stat[2 * qp + 1];
#pragma unroll
      for (int it = 0; it < 2; ++it) { const int c0 = (w + 8 * it) * 8;
          const u32x4 r0 = *(const u32x4*)(pb + (size_t)(row0 + 2 * qp) * 2048 + 1536 + g * 128 + c0), r1 = *(const u32x4*)(pb + (size_t)(row0 + 2 * qp + 1) * 2048 + 1536 + g * 128 + c0);
          const float* gp = P.in[I_SGN] + l * 512 + g * 128 + c0; const f32x4 g0 = *(const f32x4*)gp, g1 = *(const f32x4*)(gp + 4);
          const float gn[8] = {g0.x, g0.y, g0.z, g0.w, g1.x, g1.y, g1.z, g1.w};
          const unsigned a[4] = {r0.x, r0.y, r0.z, r0.w}, bb[4] = {r1.x, r1.y, r1.z, r1.w};
#pragma unroll
          for (int i = 0; i < 4; ++i) {
              const float e0 = (bflo(a[i]) - s0.x) * s0.y * gn[2 * i], e1 = (bflo(bb[i]) - s1.x) * s1.y * gn[2 * i];
              const float o0 = (bfhi(a[i]) - s0.x) * s0.y * gn[2 * i + 1], o1 = (bfhi(bb[i]) - s1.x) * s1.y * gn[2 * i + 1];
              *(LAS unsigned*)(lds + VT_OFF + (c0 + 2 * i) * 272 + qp * 4) = pk2(e0, e1);
              *(LAS unsigned*)(lds + VT_OFF + (c0 + 2 * i + 1) * 272 + qp * 4) = pk2(o0, o1); } } }
    __syncthreads();
    const bf16_t* sgw = (const bf16_t*)(P.ws + OFF_SGW) + ((size_t)(l * 4 + g) * 128 + 16 * w + fr) * 128;
    bf16x8 bfr[4];
#pragma unroll
    for (int ks = 0; ks < 4; ++ks) bfr[ks] = *(const bf16x8*)(sgw + ks * 32 + fq * 8);
    const float bs = P.in[I_SGB][(l * 4 + g) * 128 + 16 * w + fr];
    const size_t prow = (size_t)(row0 + 16 * w + fr);
#pragma unroll
    for (int cb = 0; cb < 8; ++cb) {
        f32x4 acc = (f32x4){0.f, 0.f, 0.f, 0.f};
#pragma unroll
        for (int ks = 0; ks < 4; ++ks) { const bf16x8 a = *(const LAS bf16x8*)(lds + VT_OFF + (cb * 16 + fr) * 272 + (ks * 32 + fq * 8) * 2);
            acc = __builtin_amdgcn_mfma_f32_16x16x32_bf16(a, bfr[ks], acc, 0, 0, 0); }
        const int cc = g * 128 + cb * 16 + fq * 4;
        const u32x2 uu = *(const u32x2*)(pb + prow * 2048 + 1024 + cc);
        u32x2 o; o.x = pk2(bflo(uu.x) * (acc[0] + bs), bfhi(uu.x) * (acc[1] + bs)); o.y = pk2(bflo(uu.y) * (acc[2] + bs), bfhi(uu.y) * (acc[3] + bs));
        *(u32x2*)(yb + prow * D + 512 + cc) = o;
    }
}


#define XB_TMO      128
#define XB_XCNT(j)  (256  + 64 * (j))
#define XB_XSUB(j)  (1280 + 64 * (j))
#define XB_XGEN(j)  (2304 + 64 * (j))
#define XB_TOP      3328
#define XB_TOPGEN   3392
#define XCD_BAR_WORDS 3456
#define XB_SPIN_CAP (1u << 18)
__device__ __forceinline__ unsigned xb_ld(unsigned* p)              { return __hip_atomic_load(p, __ATOMIC_RELAXED, __HIP_MEMORY_SCOPE_AGENT); }
__device__ __forceinline__ unsigned xb_add(unsigned* p, unsigned v) { return __hip_atomic_fetch_add(p, v, __ATOMIC_RELAXED, __HIP_MEMORY_SCOPE_AGENT); }
__device__ __forceinline__ unsigned xb_xcc_id() { return (unsigned)__builtin_amdgcn_s_getreg((3 << 11) | 20) & 0xFu; }
#define XB_SPIN(cond, bar) do { unsigned _sp = 0; while (cond) { __builtin_amdgcn_s_sleep(1); \
    if ((++_sp & 255u) == 0u) { if (xb_ld(&(bar)[XB_TMO])) break; if (_sp > XB_SPIN_CAP) { atomicAdd(&(bar)[XB_TMO], 1u); break; } } } } while (0)
struct XcdBarrier { unsigned* bar; unsigned x; volatile LAS unsigned* st; };
__device__ __forceinline__ XcdBarrier xcd_barrier_post(unsigned* bar, volatile LAS unsigned* st) {
    XcdBarrier b; b.bar = bar; b.x = xb_xcc_id(); b.st = st;
    if (threadIdx.x == 0) (void)xb_add(&bar[XB_XCNT(b.x)], 1u);
    return b;
}
__device__ __forceinline__ void xcd_barrier_complete(unsigned* bar, unsigned x, unsigned& nloc, unsigned& nx) {
    const unsigned G = gridDim.x * gridDim.y * gridDim.z;
    unsigned sum, cnt, mine, sp = 0u;
    for (;;) {
        sum = 0u; cnt = 0u; mine = 0u;
#pragma unroll
        for (unsigned j = 0; j < 16; ++j) { const unsigned c = xb_ld(&bar[XB_XCNT(j)]); sum += c; cnt += (c > 0u) ? 1u : 0u; mine = (j == x) ? c : mine; }
        if (sum == G) break;
        __builtin_amdgcn_s_sleep(1);
        if ((++sp & 255u) == 0u) { if (xb_ld(&bar[XB_TMO])) break; if (sp > XB_SPIN_CAP) { atomicAdd(&bar[XB_TMO], 1u); break; } }
    }
    nloc = mine > 0u ? mine : 1u; nx = cnt > 0u ? cnt : 1u;
}
__device__ __forceinline__ void xcd_barrier(const XcdBarrier& b) {
    asm volatile("s_waitcnt vmcnt(0)" ::: "memory");
    __syncthreads();
    if (threadIdx.x == 0) {
        unsigned* bar = b.bar;
        __builtin_amdgcn_s_waitcnt(0);
        unsigned nloc = b.st[0], nx = b.st[1];
        if (nloc == 0u) { xcd_barrier_complete(bar, b.x, nloc, nx); b.st[0] = nloc; b.st[1] = nx; }
        const unsigned old = xb_add(&bar[XB_XSUB(b.x)], 1u);
        const unsigned gen = old / nloc;
        if (old + 1u == (gen + 1u) * nloc) {
            __builtin_amdgcn_fence(__ATOMIC_RELEASE, "agent");
            asm volatile("s_waitcnt vmcnt(0)" ::: "memory");
            const unsigned og = xb_add(&bar[XB_TOP], 1u);
            const unsigned tg = og / nx;
            if (og + 1u == (tg + 1u) * nx) xb_add(&bar[XB_TOPGEN], 1u);
            else XB_SPIN(xb_ld(&bar[XB_TOPGEN]) == tg, bar);
            __builtin_amdgcn_fence(__ATOMIC_ACQUIRE, "agent");
            xb_add(&bar[XB_XGEN(b.x)], 1u);
            asm volatile("s_waitcnt vmcnt(0)" ::: "memory");
        } else {
            XB_SPIN(xb_ld(&bar[XB_XGEN(b.x)]) == gen, bar);
            __builtin_amdgcn_fence(__ATOMIC_ACQUIRE, "agent");
            asm volatile("s_waitcnt vmcnt(0)" ::: "memory");
        }
    }
    __syncthreads();
}

__global__ void __launch_bounds__(512) fwd_mega(Params P) {
    extern __shared__ __attribute__((aligned(16))) unsigned char lds_raw[];
    LAS unsigned char* lds = (LAS unsigned char*)lds_raw;
    cg::grid_group grid = cg::this_grid();
    const int G = gridDim.x, c = blockIdx.x, tid = threadIdx.x;
    if (P.ws == nullptr) grid.sync();
    volatile LAS unsigned* xst = (volatile LAS unsigned*)(lds + 131072);
    if (tid == 0) { xst[0] = 0u; xst[1] = 0u; xst[2] = 0u; xst[3] = 0u; }
    __syncthreads();
    const XcdBarrier xb = xcd_barrier_post((unsigned*)(P.ws + OFF_BAR), xst);
    for (int it = c; it < 288; it += G) adaln_item(P, it, lds);
    { const int tw = opaque_tid(), wv = tw >> 6, ln = tw & 63; LAS float* scr = (LAS float*)(lds + 32768 + wv * 8448);
      for (int it = c * 8 + wv; it < 19968; it += G * 8) transpose_item(P, it, scr, ln); }
    { bf16_t* wg = (bf16_t*)(P.ws + OFF_WG);
      for (int i = c * 512 + tid; i < 262144; i += G * 512) { const int d = i & 63, e = (i >> 6) & 63, h = (i >> 12) & 7, gate = (i >> 15) & 1, dir = (i >> 16) & 1, l = i >> 17;
          const float* src = gate ? P.in[I_WI] : P.in[I_WR]; wg[i] = (bf16_t)(pk2(src[((size_t)((l * 2 + dir) * 8 + h) * 64 + d) * 64 + e] * -1.4426950408889634f, 0.f) & 0xffffu); }
      bf16_t* sg = (bf16_t*)(P.ws + OFF_SGW);
      for (int i = c * 512 + tid; i < 131072; i += G * 512) sg[i] = (bf16_t)(pk2(P.in[I_SGW][i], 0.f) & 0xffffu); }
    xcd_barrier(xb);
    for (int it = c; it < 416; it += G) shiftw_item(P, it, lds);
    { const int tw = opaque_tid(), wv = tw >> 6, ln = tw & 63;
      for (int row = c * 8 + wv; row < MT; row += 2 * G * 8) prep_item2(P, row, row + G * 8, row + G * 8 < MT, ln); }
    xcd_barrier(xb);
    bf16_t* AP = (bf16_t*)(P.ws + OFF_AP); bf16_t* YB = (bf16_t*)(P.ws + OFF_Y); bf16_t* HID = (bf16_t*)(P.ws + OFF_HID);
    float* RSQ = (float*)(P.ws + OFF_RSQ); float* VST = (float*)(P.ws + OFF_VST);
    const float* MODV = (const float*)(P.ws + OFF_MODV); const float* SW = (const float*)(P.ws + OFF_SW);
#pragma unroll 1
    for (int ph = 0; ph < 16; ++ph) {
        const int l = ph >> 3, st = ph & 7; const bool lastl = l == 1;
        const unsigned char* WL = P.ws + OFF_W + (size_t)l * LW_TOTAL;
        if (st == 0 || st == 6) {
            EpiSwiglu E; E.rtab = (const LAS float*)(lds + RSTD_OFF); E.vtab = (const LAS float*)(lds + VEC_OFF); E.hid = HID;
            const float* sWp = SW + (size_t)l * 5 * 13312 + (st == 0 ? 0 : 7680);
            pg8::Gemm g{AP, (const bf16_t*)(WL + (st == 0 ? LW_WIN1 : LW_WIN2)), MT, 5632, 1024};
            pg8::Order2 S; S.init(22, (st == 6 && lastl) ? 0 : 22, G, c);
            fill_tabs<1>(lds, S, RSQ, sWp, nullptr);
            pg8::gemm_phase<EpiSwiglu, pg8::Order2>(lds, g, S, E);
        } else if (st == 1 || st == 5 || st == 7) {
            EpiResid E; E.hb = (bf16_t*)(P.ws + OFF_HB);
            const int cg_ = st == 1 ? 2 : (st == 5 ? 5 : 8);
            E.gate = MODV + (size_t)(l * 5) * 9216 + cg_ * 1024;
            E.gsn = st == 1 ? MODV + (size_t)(l * 5) * 9216 + 4 * 1024 : (st == 5 ? MODV + (size_t)(l * 5) * 9216 + 7 * 1024 : (lastl ? (const float*)nullptr : MODV + (size_t)(5) * 9216 + 1 * 1024));
            E.ap = AP; E.rsq = RSQ;
            pg8::Gemm g{st == 5 ? YB : HID, (const bf16_t*)(WL + (st == 1 ? LW_WOUT1 : (st == 5 ? LW_WOUTM : LW_WOUT2))), MT, 1024, st == 5 ? 1024 : 2816};
            const int cpn = (st != 1 && lastl) ? 0 : 4; const int ks = (st != 5 && cpn) ? 11 : 1;
            E.part = (float*)(P.ws + OFF_Y);
            pg8::Order2 S; S.init(4, cpn, G, c, ks);
            E.vtab = (const LAS float*)(lds + VEC_OFF);
            fill_tabs<2>(lds, S, nullptr, E.gate, E.gsn);
            pg8::gemm_phase<EpiResid, pg8::Order2>(lds, g, S, E);
            if (ks > 1) {
                xcd_barrier(xb);
                const int tw = opaque_tid(), wv = tw >> 6, ln = tw & 63;
                for (int r = c * 8 + wv; r < NCTX; r += G * 8) ctx_fix_row(P, r, ln, ks, E.part, E.gate, E.gsn);
            }
        } else if (st == 2) {
            EpiInproj E; E.rtab = (const LAS float*)(lds + RSTD_OFF); E.vtab = (const LAS float*)(lds + VEC_OFF); E.p = HID; E.vst = VST;
            const float* sWp = SW + (size_t)l * 5 * 13312 + 5632;
            pg8::Gemm g{AP, (const bf16_t*)(WL + LW_WINM), MT, 2048, 1024};
            pg8::Order2 S; S.init(8, lastl ? 2 : 8, G, c);
            fill_tabs<3>(lds, S, RSQ, sWp, nullptr);
            pg8::gemm_phase<EpiInproj, pg8::Order2>(lds, g, S, E);
        } else if (st == 3) {
            for (int wgI = c; wgI < 256; wgI += G) scan_group(P, l, wgI, false, true, lds);
            const int nsgu = lastl ? 1024 : 1056;
            for (int it = c; it < nsgu; it += G) sgu_item(P, l, it >> 2, it & 3, lds);
        } else {
            for (int wgI = c; wgI < 256; wgI += G) scan_group(P, l, wgI, true, !lastl, lds);
        }
        xcd_barrier(xb);
    }
    for (int it = c; it < NLAT / 16; it += G) final_item(P, it);
}

extern "C" void kernel_launch(void* const* d_in, const int* in_sizes, int n_in, void* d_out, int out_size, void* d_ws, size_t ws_size, hipStream_t stream) {
    static int grid = 0;
    if (!grid) {
        if (n_in != 26 || ws_size < WS_END + COEF_TAIL_ITEMS * COEF_ITEM) { fprintf(stderr, "kernel_launch: unexpected n_in %d / ws_size %zu (need %zu)\n", n_in, ws_size, (size_t)WS_END); grid = -1; return; }
        int dev = 0, cus = 0, per_cu = 0;
        (void)hipGetDevice(&dev);
        (void)hipDeviceGetAttribute(&cus, hipDeviceAttributeMultiprocessorCount, dev);
        (void)hipFuncSetAttribute((const void*)fwd_mega, hipFuncAttributeMaxDynamicSharedMemorySize, LDS_BYTES);
        (void)hipOccupancyMaxActiveBlocksPerMultiprocessor(&per_cu, (const void*)fwd_mega, 512, LDS_BYTES);
        if (per_cu < 1) { fprintf(stderr, "kernel_launch: occupancy query says %d blocks per CU\n", per_cu); per_cu = 1; }
        grid = cus;
    }
    if (grid < 0) return;
    if (hipMemsetAsync((char*)d_ws + OFF_BAR, 0, BAR_BYTES, stream) != hipSuccess) { fprintf(stderr, "kernel_launch: memset of the barrier words failed\n"); return; }
    Params p{};
    for (int i = 0; i < 26; ++i) p.in[i] = (const float*)d_in[i];
    p.out = (float*)d_out; p.ws = (unsigned char*)d_ws;
    void* args[] = {&p};
    hipError_t e = hipLaunchCooperativeKernel((const void*)fwd_mega, dim3(grid), dim3(512), args, LDS_BYTES, stream);
    if (e != hipSuccess) fprintf(stderr, "cooperative launch failed: %s (grid %d)\n", hipGetErrorString(e), grid);
}
```

```cpp
#include <hip/hip_runtime.h>
#include <hip/hip_cooperative_groups.h>
#include <cstdio>
#include <cstdint>
namespace cg = cooperative_groups;

#define LAS __attribute__((address_space(3)))
typedef unsigned short bf16_t;
typedef short bf16x8 __attribute__((ext_vector_type(8)));
typedef float f32x4 __attribute__((ext_vector_type(4)));
typedef float f32x2 __attribute__((ext_vector_type(2)));
typedef unsigned u32x4 __attribute__((ext_vector_type(4)));
typedef unsigned u32x2 __attribute__((ext_vector_type(2)));

__device__ __forceinline__ int opaque_tid() { int t = threadIdx.x; asm volatile("" : "+v"(t)); return t; }

namespace pg8 {
constexpr int BM = 256, BK = 64, HALF = 128, HTB = HALF * BK * 2, STAGE_BYTES = 8 * HTB, NXCD = 8, WGM = 4;
__host__ __device__ __forceinline__ int lds_byte(int r, int c) { const int st = (r >> 4) * 2 + (c >> 5), rr = r & 15, cc = c & 31, ob = rr * 64 + cc * 2; return st * 1024 + (ob ^ (((ob >> 9) & 1) << 5)); }
__host__ __device__ __forceinline__ void stage_rc(int b, int& R, int& C) { const int st = b / 1024, sb = b % 1024, swz = sb ^ (((sb >> 9) & 1) << 5); R = (st >> 1) * 16 + swz / 64; C = (st & 1) * 32 + (swz % 64) / 2; }
__host__ __device__ __forceinline__ int perm32(int rho) { const int n = rho >> 4, i = rho & 15; return 8 * (i >> 2) + 4 * n + (i & 3); }
struct Unit { int pm, pn, kc, ui; };
struct Gemm { const bf16_t* A; const bf16_t* Bt; int M, N, K; };

struct Order2 {
    int nN, nlat, cpn, total, G, c, ks;
    __device__ __forceinline__ void init(int nN_, int cpn_, int G_, int c_, int ks_ = 1) { nN = nN_; nlat = 128 * nN_; cpn = cpn_; ks = ks_; total = nlat + 4 * cpn_ * ks_; G = G_; c = c_; }
    __device__ __forceinline__ bool next(int i, Unit& u) const {
        const long L = (long)i * G + c; if (L >= total) return false;
        int pm, pn, kc = -1;
        if (L >= nlat) { int r = (int)L - nlat; if (ks > 1) { kc = r % ks; r /= ks; } pm = 128 + r / cpn; pn = r % cpn; }
        else { int wgid = (int)L; { const int q = nlat / NXCD, xcd = wgid % NXCD, off = wgid / NXCD; wgid = xcd * q + off; }
            const int nig = WGM * nN, gid = wgid / nig, fm = gid * WGM; pm = fm + ((wgid % nig) % WGM); pn = (wgid % nig) / WGM; }
        u.pm = pm; u.pn = pn; u.kc = kc; u.ui = i; return true;
    }
    __device__ __forceinline__ void a_ready(const Unit&) const {}
    __device__ __forceinline__ void done(const Unit&) const {}
};

template <class Epi, class Sched>
__device__ __forceinline__ void gemm_phase(LAS unsigned char* lds, const Gemm g, const Sched& S, const Epi& E) {
    const int tid = opaque_tid(), wid = __builtin_amdgcn_readfirstlane(tid >> 6), lane = tid & 63, wr = wid >> 2, wc = wid & 3, fr = lane & 15, fq = lane >> 4;
    const int K = g.K, ntf = K / BK, nts = S.ks > 1 ? ntf / S.ks : ntf;
    unsigned voffA[2], voffB[2];
#pragma unroll
    for (int i = 0; i < 2; ++i) { int R, C; stage_rc(tid * 16 + i * 8192, R, C); const int Rb = Epi::PERM ? ((R & ~31) + perm32(R & 31)) : R;
        voffA[i] = (unsigned)(R * K + C) * 2u; voffB[i] = (unsigned)(Rb * K + C) * 2u; }
    const size_t kstep = (size_t)(BK * 2);
    const size_t hstep = (size_t)HALF * K * 2;
    const size_t tstep = 2 * hstep;
    const unsigned ldsw = (unsigned)wid * 1024u;
    const int aoff = lds_byte(wr * 64 + fr, fq * 8), boff = lds_byte(wc * 32 + fr, fq * 8);
#define PG8_SA(b, h) (((b) * 2 + (h)) * HTB)
#define PG8_SB(b, h) ((4 + (b) * 2 + (h)) * HTB)
#define PG8_STAGE(bufoff, gbase, voff) do { _Pragma("unroll") for (int _i = 0; _i < 2; ++_i) \
        __builtin_amdgcn_global_load_lds((const unsigned*)((const char*)(gbase) + (voff)[_i]), (LAS unsigned*)(lds + (bufoff) + ldsw + _i * 8192), 16, 0, 0); } while (0)
#define PG8_LDA(dst, b, h) do { _Pragma("unroll") for (int m = 0; m < 4; ++m) _Pragma("unroll") for (int k = 0; k < 2; ++k) dst[m][k] = *(const LAS bf16x8*)(lds + PG8_SA(b, h) + aoff + m * 2048 + k * 1024); } while (0)
#define PG8_LDB(dst, b, h) do { _Pragma("unroll") for (int n = 0; n < 2; ++n) _Pragma("unroll") for (int k = 0; k < 2; ++k) dst[n][k] = *(const LAS bf16x8*)(lds + PG8_SB(b, h) + boff + n * 2048 + k * 1024); } while (0)
#define PG8_MMA(ai, bj, At, Bt) do { __builtin_amdgcn_s_setprio(1); _Pragma("unroll") for (int m = 0; m < 4; ++m) _Pragma("unroll") for (int n = 0; n < 2; ++n) _Pragma("unroll") for (int k = 0; k < 2; ++k) \
        acc[ai][bj][m][n] = __builtin_amdgcn_mfma_f32_16x16x32_bf16(Bt[n][k], At[m][k], acc[ai][bj][m][n], 0, 0, 0); __builtin_amdgcn_s_setprio(0); } while (0)
#define PG8_WAIT_V(n) asm volatile("s_waitcnt vmcnt(" #n ")" ::: "memory")
#define PG8_WAIT_L(n) asm volatile("s_waitcnt lgkmcnt(" #n ")" ::: "memory")
#define PG8_BAR __builtin_amdgcn_s_barrier()
#define PG8_SCHED __builtin_amdgcn_sched_barrier(0)
    Unit cur, nxt; int ui = 0;
    if (!S.next(0, cur)) return;
    f32x4 acc[2][2][4][2];
#pragma unroll
    for (int a = 0; a < 2; ++a)
#pragma unroll
        for (int b = 0; b < 2; ++b)
#pragma unroll
            for (int m = 0; m < 4; ++m)
#pragma unroll
                for (int n = 0; n < 2; ++n) acc[a][b][m][n] = (f32x4){0.f, 0.f, 0.f, 0.f};
    bf16x8 At[4][2], B0[2][2], B1[2][2];
    const char* cA = (const char*)g.A + (size_t)cur.pm * tstep + (cur.kc > 0 ? (size_t)cur.kc * nts * kstep : 0); const char* cB = (const char*)g.Bt + (size_t)cur.pn * tstep + (cur.kc > 0 ? (size_t)cur.kc * nts * kstep : 0);
    S.a_ready(cur);
    PG8_STAGE(PG8_SB(0, 0), cB, voffB); PG8_STAGE(PG8_SB(0, 1), cB + hstep, voffB); PG8_STAGE(PG8_SA(0, 0), cA, voffA); PG8_STAGE(PG8_SA(0, 1), cA + hstep, voffA);
    if (wr == 1) PG8_BAR;
    PG8_WAIT_V(2); PG8_BAR;
    PG8_STAGE(PG8_SB(1, 0), cB + kstep, voffB); PG8_STAGE(PG8_SA(1, 0), cA + kstep, voffA); PG8_STAGE(PG8_SB(1, 1), cB + hstep + kstep, voffB);
    PG8_WAIT_V(6); PG8_BAR;
    for (;;) {
        const bool has_next = S.next(ui + 1, nxt);
        const size_t nko = (has_next && nxt.kc > 0) ? (size_t)nxt.kc * nts * kstep : 0;
        const char* nA = has_next ? (const char*)g.A + (size_t)nxt.pm * tstep + nko : cA; const char* nB = has_next ? (const char*)g.Bt + (size_t)nxt.pn * tstep + nko : cB;
        const int nt = cur.kc >= 0 ? nts : ntf;
        for (int t = 0; t < nt; t += 2) {
            const bool last = (t == nt - 2);
            const char* a1 = cA + (size_t)(t + 1) * kstep;
            const char* a2 = last ? nA : cA + (size_t)(t + 2) * kstep; const char* b2 = last ? nB : cB + (size_t)(t + 2) * kstep;
            const char* a3 = a2 + kstep; const char* b3 = b2 + kstep;
            PG8_LDB(B0, 0, 0); PG8_LDB(B1, 0, 1); PG8_SCHED; PG8_LDA(At, 0, 0); PG8_STAGE(PG8_SA(1, 1), a1 + hstep, voffA);
            PG8_WAIT_V(8); PG8_WAIT_L(0); PG8_BAR; PG8_MMA(0, 0, At, B0); PG8_MMA(0, 1, At, B1); PG8_BAR; PG8_SCHED;
            PG8_LDA(At, 0, 1); PG8_STAGE(PG8_SB(0, 0), b2, voffB); PG8_STAGE(PG8_SB(0, 1), b2 + hstep, voffB); PG8_STAGE(PG8_SA(0, 0), a2, voffA);
            PG8_WAIT_V(8); PG8_WAIT_L(0); PG8_BAR; PG8_MMA(1, 0, At, B0); PG8_MMA(1, 1, At, B1); PG8_BAR; PG8_SCHED;
            PG8_LDB(B0, 1, 0); PG8_LDB(B1, 1, 1); PG8_SCHED; PG8_LDA(At, 1, 0); PG8_STAGE(PG8_SA(0, 1), a2 + hstep, voffA);
            PG8_WAIT_V(8); PG8_WAIT_L(0); PG8_BAR; PG8_MMA(0, 0, At, B0); PG8_MMA(0, 1, At, B1); PG8_BAR; PG8_SCHED;
            PG8_LDA(At, 1, 1); PG8_STAGE(PG8_SB(1, 0), b3, voffB); PG8_STAGE(PG8_SB(1, 1), b3 + hstep, voffB); PG8_STAGE(PG8_SA(1, 0), a3, voffA);
            PG8_WAIT_V(8); PG8_WAIT_L(0); PG8_BAR; PG8_MMA(1, 0, At, B0); PG8_MMA(1, 1, At, B1); PG8_BAR; PG8_SCHED;
        }
        if (wr == 0) PG8_BAR;
        E(acc, cur, wr, wc, fr, fq);
        if (!has_next) break;
#pragma unroll
        for (int a = 0; a < 2; ++a)
#pragma unroll
            for (int b = 0; b < 2; ++b)
#pragma unroll
                for (int m = 0; m < 4; ++m)
#pragma unroll
                    for (int n = 0; n < 2; ++n) acc[a][b][m][n] = (f32x4){0.f, 0.f, 0.f, 0.f};
        cur = nxt; cA = nA; cB = nB; ++ui;
        if (wr == 1) PG8_BAR;
    }
    PG8_WAIT_V(0);
    PG8_BAR;
#undef PG8_SA
#undef PG8_SB
#undef PG8_STAGE
#undef PG8_LDA
#undef PG8_LDB
#undef PG8_MMA
#undef PG8_WAIT_V
#undef PG8_WAIT_L
#undef PG8_BAR
#undef PG8_SCHED
}
}

constexpr int D = 1024, NB = 4, SEQ = 8192, CTXL = 256, DFF = 2816, NLAT = NB * SEQ, NCTX = NB * CTXL, MT = NLAT + NCTX;
constexpr float EPS = 1e-6f;
constexpr size_t OFF_HB = 0;
constexpr size_t OFF_AP = OFF_HB + (size_t)MT * D * 2;
constexpr size_t OFF_Y = OFF_AP + (size_t)MT * D * 2;
constexpr size_t OFF_HID = OFF_Y + (size_t)MT * D * 2;
constexpr size_t OFF_W = OFF_HID + (size_t)MT * DFF * 2;
constexpr size_t LW_WIN1 = 0, LW_WOUT1 = 11534336, LW_WINM = 17301504, LW_WOUTM = 21495808, LW_WIN2 = 23592960, LW_WOUT2 = 35127296, LW_TOTAL = 40894464;
constexpr size_t OFF_WG = OFF_W + 2 * LW_TOTAL;
constexpr size_t OFF_SGW = OFF_WG + 524288;
constexpr size_t OFF_MODV = OFF_SGW + 262144;
constexpr size_t OFF_SW = OFF_MODV + 368640;
constexpr size_t OFF_RSQ = OFF_SW + 532480;
constexpr size_t OFF_VST = OFF_RSQ + (size_t)MT * 16 * 4;
constexpr size_t OFF_SUM = OFF_VST + (size_t)MT * 16 * 4;
constexpr size_t OFF_BAR = OFF_SUM + (size_t)264 * 2048 * 4;
constexpr size_t BAR_BYTES = 16384;
constexpr size_t WS_END = OFF_BAR + BAR_BYTES;
constexpr int RSTD_OFF = 131072 + 16;
constexpr int VEC_OFF = RSTD_OFF + 12 * 256 * 4;
constexpr int LDS_BYTES = VEC_OFF + 12288;

struct Params { const float* in[26]; float* out; unsigned char* ws; };
enum { I_X = 0, I_C, I_CTX, I_CCTX, I_WADA, I_BADA, I_G1, I_W1IN, I_W1OUT, I_GMIX, I_WINM, I_CONVW, I_CONVB, I_WR, I_BR, I_WI, I_BI, I_LAM, I_SGN, I_SGW, I_SGB, I_WOUTM, I_G2, I_W2IN, I_W2OUT, I_GF };

__device__ __forceinline__ unsigned pk2(float lo, float hi) { unsigned r; asm("v_cvt_pk_bf16_f32 %0, %1, %2" : "=v"(r) : "v"(lo), "v"(hi)); return r; }
__device__ __forceinline__ float bflo(unsigned w) { return __uint_as_float(w << 16); }
__device__ __forceinline__ float bfhi(unsigned w) { return __uint_as_float(w & 0xffff0000u); }
__device__ __forceinline__ float sigmoidf_(float v) { return __builtin_amdgcn_rcpf(1.0f + __expf(-v)); }

__device__ __forceinline__ void rows_rstd(const LAS float* tab, int ui, int rl0, float (&rstd)[2][4]) {
#pragma unroll
    for (int ai = 0; ai < 2; ++ai)
#pragma unroll
        for (int m = 0; m < 4; ++m) rstd[ai][m] = tab[ui * 256 + rl0 + ai * 128 + m * 16];
}
template <int MODE, class Sched> __device__ __forceinline__ void fill_tabs(LAS unsigned char* lds, const Sched& S, const float* rsq, const float* v0, const float* v1) {
    const int tid = opaque_tid(); LAS float* tab = (LAS float*)(lds + RSTD_OFF); LAS float* vec = (LAS float*)(lds + VEC_OFF);
    for (int i = 0; i < 12; ++i) { pg8::Unit u; if (!S.next(i, u)) break;
        const int s = u.pm < 128 ? (u.pm >> 5) : 4;
        if (MODE != 2) {
            if (tid < 256) { const float* p = rsq + ((size_t)u.pm * 256 + tid) * 16; float t = 0.f;
#pragma unroll
                for (int j = 0; j < 4; ++j) { const f32x4 v = *(const f32x4*)(p + 4 * j); t += (v.x + v.y) + (v.z + v.w); }
                tab[i * 256 + tid] = rsqrtf(t * (1.0f / 1024.0f) + EPS); }
            else { const int t = tid - 256;
                vec[i * 256 + t] = MODE == 1 ? v0[s * 13312 + (t < 128 ? u.pn * 128 + t : 2816 + u.pn * 128 + (t - 128))] : v0[s * 13312 + u.pn * 256 + t]; }
        } else if (u.kc < 0 && i < 6) {
            vec[i * 512 + tid] = tid < 256 ? v0[s * 9216 + u.pn * 256 + tid] : (v1 ? v1[s * 9216 + u.pn * 256 + tid - 256] : 0.f);
        }
    }
    __syncthreads();
}
struct EpiSwiglu {
    static constexpr bool PERM = true;
    const LAS float* rtab; const LAS float* vtab; bf16_t* hid;
    __device__ __forceinline__ void operator()(const f32x4 (&acc)[2][2][4][2], const pg8::Unit& u, int wr, int wc, int fr_, int fq_) const {
        int fr = fr_, fq = fq_; asm volatile("" : "+v"(fr), "+v"(fq));
        const int s = u.pm < 128 ? (u.pm >> 5) : 4;
        const int row0 = u.pm * 256 + wr * 64 + fr, jc = u.pn * 128 + wc * 32 + fq * 8;
        const LAS float* swp = vtab + u.ui * 256 + wc * 32 + fq * 8;
        const f32x4 g0 = *(const LAS f32x4*)swp, g1 = *(const LAS f32x4*)(swp + 4), u0 = *(const LAS f32x4*)(swp + 128), u1 = *(const LAS f32x4*)(swp + 132);
        float rs[2][4]; rows_rstd(rtab, u.ui, wr * 64 + fr, rs);
#pragma unroll
        for (int ai = 0; ai < 2; ++ai)
#pragma unroll
            for (int m = 0; m < 4; ++m) {
                const int row = row0 + ai * 128 + m * 16; const float rstd = rs[ai][m];
                f32x4 g[2], up[2], e[2];
                g[0] = acc[ai][0][m][0] * rstd + g0; g[1] = acc[ai][0][m][1] * rstd + g1; up[0] = acc[ai][1][m][0] * rstd + u0; up[1] = acc[ai][1][m][1] * rstd + u1;
#pragma unroll
                for (int h = 0; h < 2; ++h) { const f32x4 t = g[h] * -1.4426950408889634f;
                    e[h] = (f32x4){__builtin_amdgcn_exp2f(t.x), __builtin_amdgcn_exp2f(t.y), __builtin_amdgcn_exp2f(t.z), __builtin_amdgcn_exp2f(t.w)}; }
#pragma unroll
                for (int h = 0; h < 2; ++h) { const f32x4 d = e[h] + 1.0f;
                    e[h] = (f32x4){__builtin_amdgcn_rcpf(d.x), __builtin_amdgcn_rcpf(d.y), __builtin_amdgcn_rcpf(d.z), __builtin_amdgcn_rcpf(d.w)}; }
#pragma unroll
                for (int h = 0; h < 2; ++h) g[h] = (g[h] * up[h]) * e[h];
                u32x4 w; w.x = pk2(g[0].x, g[0].y); w.y = pk2(g[0].z, g[0].w); w.z = pk2(g[1].x, g[1].y); w.w = pk2(g[1].z, g[1].w);
                __builtin_nontemporal_store(w, (u32x4*)(hid + (size_t)row * DFF + jc));
            }
    }
};
struct EpiResid {
    static constexpr bool PERM = true;
    bf16_t* hb; const float* gate; const float* gsn; const LAS float* vtab; bf16_t* ap; float* rsq; float* part;
    __device__ __forceinline__ void operator()(const f32x4 (&acc)[2][2][4][2], const pg8::Unit& u, int wr, int wc, int fr_, int fq_) const {
        int fr = fr_, fq = fq_; asm volatile("" : "+v"(fr), "+v"(fq));
        const int cb0 = u.pn * 256 + wc * 32 + fq * 8;
        if (u.kc >= 0) {
            float* pp = part + ((size_t)u.kc * NCTX + (size_t)(u.pm - 128) * 256 + wr * 64 + fr) * D + cb0;
#pragma unroll
            for (int ai = 0; ai < 2; ++ai)
#pragma unroll
                for (int m = 0; m < 4; ++m)
#pragma unroll
                    for (int bj = 0; bj < 2; ++bj) { float* q = pp + (size_t)(ai * 128 + m * 16) * D + bj * 128; *(f32x4*)q = acc[ai][bj][m][0]; *(f32x4*)(q + 4) = acc[ai][bj][m][1]; }
            return;
        }
        const int s = u.pm < 128 ? (u.pm >> 5) : 4;
        f32x4 gt[2][2], gn[2][2];
#pragma unroll
        for (int bj = 0; bj < 2; ++bj) { const LAS float* gp = vtab + u.ui * 512 + bj * 128 + wc * 32 + fq * 8; gt[bj][0] = *(const LAS f32x4*)gp; gt[bj][1] = *(const LAS f32x4*)(gp + 4);
            gn[bj][0] = *(const LAS f32x4*)(gp + 256); gn[bj][1] = *(const LAS f32x4*)(gp + 260); }
        bf16_t* hbase = hb + ((size_t)u.pm * 256 + wr * 64 + fr) * D + cb0;
        u32x4 hv[2][2];
#pragma unroll
        for (int bj = 0; bj < 2; ++bj) hv[0][bj] = *(const u32x4*)(hbase + bj * 128);
#pragma unroll
        for (int it = 0; it < 8; ++it) {
            const int ai = it >> 2, m = it & 3;
            const size_t roff = (size_t)(ai * 128 + m * 16) * D; const size_t grow = (size_t)u.pm * 256 + ai * 128 + wr * 64 + m * 16 + fr;
            if (it < 7) { const size_t rn = (size_t)(((it + 1) >> 2) * 128 + ((it + 1) & 3) * 16) * D;
#pragma unroll
                for (int bj = 0; bj < 2; ++bj) hv[(it + 1) & 1][bj] = *(const u32x4*)(hbase + rn + bj * 128); }
            float sq = 0.f;
#pragma unroll
            for (int bj = 0; bj < 2; ++bj) {
                const u32x4 r = hv[it & 1][bj];
                const f32x4 o0 = (f32x4){bflo(r.x), bfhi(r.x), bflo(r.y), bfhi(r.y)}, o1 = (f32x4){bflo(r.z), bfhi(r.z), bflo(r.w), bfhi(r.w)};
                const f32x4 n0 = o0 + gt[bj][0] * acc[ai][bj][m][0], n1 = o1 + gt[bj][1] * acc[ai][bj][m][1];
                u32x4 hw; hw.x = pk2(n0.x, n0.y); hw.y = pk2(n0.z, n0.w); hw.z = pk2(n1.x, n1.y); hw.w = pk2(n1.z, n1.w);
                *(u32x4*)(hbase + roff + bj * 128) = hw;
                sq += (n0.x * n0.x + n0.y * n0.y) + (n0.z * n0.z + n0.w * n0.w) + (n1.x * n1.x + n1.y * n1.y) + (n1.z * n1.z + n1.w * n1.w);
                if (gsn) { const f32x4 a0 = n0 * gn[bj][0], a1 = n1 * gn[bj][1]; u32x4 w; w.x = pk2(a0.x, a0.y); w.y = pk2(a0.z, a0.w); w.z = pk2(a1.x, a1.y); w.w = pk2(a1.z, a1.w);
                    *(u32x4*)(ap + grow * D + cb0 + bj * 128) = w; }
            }
            sq += __shfl_xor(sq, 16); sq += __shfl_xor(sq, 32);
            if (fq == 0) rsq[grow * 16 + u.pn * 4 + wc] = sq;
        }
    }
};
struct EpiInproj {
    static constexpr bool PERM = true;
    const LAS float* rtab; const LAS float* vtab; bf16_t* p; float* vst;
    __device__ __forceinline__ void operator()(const f32x4 (&acc)[2][2][4][2], const pg8::Unit& u, int wr, int wc, int fr_, int fq_) const {
        int fr = fr_, fq = fq_; asm volatile("" : "+v"(fr), "+v"(fq));
        const int s = u.pm < 128 ? (u.pm >> 5) : 4;
        const int row0 = u.pm * 256 + wr * 64 + fr, cb0 = u.pn * 256 + wc * 32 + fq * 8;
        f32x4 sw[2][2];
#pragma unroll
        for (int bj = 0; bj < 2; ++bj) { const LAS float* sp = vtab + u.ui * 256 + bj * 128 + wc * 32 + fq * 8; sw[bj][0] = *(const LAS f32x4*)sp; sw[bj][1] = *(const LAS f32x4*)(sp + 4); }
        const bool isv = u.pn >= 6;
        float rs[2][4]; rows_rstd(rtab, u.ui, wr * 64 + fr, rs);
#pragma unroll
        for (int ai = 0; ai < 2; ++ai)
#pragma unroll
            for (int m = 0; m < 4; ++m) {
                const int row = row0 + ai * 128 + m * 16; const float rstd = rs[ai][m];
                float sm = 0.f, sq = 0.f;
#pragma unroll
                for (int bj = 0; bj < 2; ++bj) {
                    const f32x4 v0 = acc[ai][bj][m][0] * rstd + sw[bj][0], v1 = acc[ai][bj][m][1] * rstd + sw[bj][1];
                    u32x4 w; w.x = pk2(v0.x, v0.y); w.y = pk2(v0.z, v0.w); w.z = pk2(v1.x, v1.y); w.w = pk2(v1.z, v1.w);
                    __builtin_nontemporal_store(w, (u32x4*)(p + (size_t)row * 2048 + cb0 + bj * 128));
                    sm += (v0.x + v0.y) + (v0.z + v0.w) + (v1.x + v1.y) + (v1.z + v1.w);
                    sq += (v0.x * v0.x + v0.y * v0.y) + (v0.z * v0.z + v0.w * v0.w) + (v1.x * v1.x + v1.y * v1.y) + (v1.z * v1.z + v1.w * v1.w);
                }
                if (isv) { sm += __shfl_xor(sm, 16); sm += __shfl_xor(sm, 32); sq += __shfl_xor(sq, 16); sq += __shfl_xor(sq, 32);
                    if (fq == 0) { float* vp = vst + (size_t)row * 16 + ((u.pn - 6) * 4 + wc) * 2; vp[0] = sm; vp[1] = sq; } }
            }
    }
};

__device__ __forceinline__ void gemv5_partial(const float* __restrict__ W, int ldw, int col, int k0, const LAS float* vin, float (&acc)[5]) {
#pragma unroll
    for (int s = 0; s < 5; ++s) acc[s] = 0.f;
#pragma unroll 32
    for (int k = k0; k < k0 + 128; ++k) { const float w = W[(size_t)k * ldw + col];
#pragma unroll
        for (int s = 0; s < 5; ++s) acc[s] += vin[s * 1024 + k] * w; }
}
__device__ __forceinline__ void adaln_item(const Params& P, int it, LAS unsigned char* lds) {
    const int tid = opaque_tid(), w = tid >> 6, lane = tid & 63;
    LAS float* vin = (LAS float*)lds; LAS float* red = (LAS float*)(lds + 20480);
    const int l = it / 144, c0 = (it % 144) * 64;
    for (int idx = tid; idx < 5120; idx += 512) { const int s = idx >> 10, k = idx & 1023; const float cv = s < 4 ? P.in[I_C][s * 1024 + k] : P.in[I_CCTX][k]; vin[idx] = cv / (1.0f + __expf(-cv)); }
    __syncthreads();
    float acc[5]; gemv5_partial(P.in[I_WADA] + (size_t)l * 1024 * 9216, 9216, c0 + lane, w * 128, vin, acc);
#pragma unroll
    for (int s = 0; s < 5; ++s) red[(w * 5 + s) * 64 + lane] = acc[s];
    __syncthreads();
    if (tid < 320) { const int s = tid >> 6; float m = 0.f;
#pragma unroll
        for (int v = 0; v < 8; ++v) m += red[(v * 5 + s) * 64 + lane];
        const int n = c0 + lane, chunk = n >> 10, k = n & 1023; m += P.in[I_BADA][l * 9216 + n];
        float val = m;
        if (chunk == 1) val = P.in[I_G1][l * 1024 + k] * (1.0f + m); else if (chunk == 4) val = P.in[I_GMIX][l * 1024 + k] * (1.0f + m); else if (chunk == 7) val = P.in[I_G2][l * 1024 + k] * (1.0f + m);
        else if (chunk == 2 || chunk == 8) val = 0.5f * m;
        ((float*)(P.ws + OFF_MODV))[((l * 5 + s) * 9 + chunk) * 1024 + k] = val; }
    __syncthreads();
}
__device__ __forceinline__ void shiftw_item(const Params& P, int it, LAS unsigned char* lds) {
    const int tid = opaque_tid(), w = tid >> 6, lane = tid & 63;
    LAS float* vin = (LAS float*)lds; LAS float* red = (LAS float*)(lds + 20480);
    const int l = it / 208; int r = it % 208; const float* W; int ldw, c0, off, chunk;
    if (r < 88) { W = P.in[I_W1IN] + (size_t)l * 1024 * 5632; ldw = 5632; c0 = r * 64; off = 0; chunk = 0; }
    else if (r < 120) { W = P.in[I_WINM] + (size_t)l * 1024 * 2048; ldw = 2048; c0 = (r - 88) * 64; off = 5632; chunk = 3; }
    else { W = P.in[I_W2IN] + (size_t)l * 1024 * 5632; ldw = 5632; c0 = (r - 120) * 64; off = 7680; chunk = 6; }
    const float* modv = (const float*)(P.ws + OFF_MODV);
    for (int idx = tid; idx < 5120; idx += 512) { const int s = idx >> 10, k = idx & 1023; vin[idx] = modv[((l * 5 + s) * 9 + chunk) * 1024 + k]; }
    __syncthreads();
    float acc[5]; gemv5_partial(W, ldw, c0 + lane, w * 128, vin, acc);
#pragma unroll
    for (int s = 0; s < 5; ++s) red[(w * 5 + s) * 64 + lane] = acc[s];
    __syncthreads();
    if (tid < 320) { const int s = tid >> 6; float m = 0.f;
#pragma unroll
        for (int v = 0; v < 8; ++v) m += red[(v * 5 + s) * 64 + lane];
        ((float*)(P.ws + OFF_SW))[(l * 5 + s) * 13312 + off + c0 + lane] = m; }
    __syncthreads();
}
__device__ __forceinline__ void transpose_item(const Params& P, int it, LAS float* scr, int lane) {
    const int l = it / 9984; int r = it % 9984; const float* W; int K, N; size_t dst; bool perm = false;
    if (r < 2816) { W = P.in[I_W1IN] + (size_t)l * 1024 * 5632; K = 1024; N = 5632; dst = LW_WIN1; perm = true; }
    else if ((r -= 2816) < 1408) { W = P.in[I_W1OUT] + (size_t)l * 2816 * 1024; K = 2816; N = 1024; dst = LW_WOUT1; }
    else if ((r -= 1408) < 1024) { W = P.in[I_WINM] + (size_t)l * 1024 * 2048; K = 1024; N = 2048; dst = LW_WINM; }
    else if ((r -= 1024) < 512) { W = P.in[I_WOUTM] + (size_t)l * 1024 * 1024; K = 1024; N = 1024; dst = LW_WOUTM; }
    else if ((r -= 512) < 2816) { W = P.in[I_W2IN] + (size_t)l * 1024 * 5632; K = 1024; N = 5632; dst = LW_WIN2; perm = true; }
    else { r -= 2816; W = P.in[I_W2OUT] + (size_t)l * 2816 * 1024; K = 2816; N = 1024; dst = LW_WOUT2; }
    const int ntn = N / 32, k0 = (r / ntn) * 64, n0 = (r % ntn) * 32;
    const int r0 = perm ? (((n0 % 2816) / 128) * 256 + (n0 / 2816) * 128 + (n0 % 128)) : n0;
    bf16_t* Bt = (bf16_t*)(P.ws + OFF_W + (size_t)l * LW_TOTAL + dst);
    float v[32];
#pragma unroll
    for (int i = 0; i < 32; ++i) { const int kk = 2 * i + (lane >> 5); v[i] = W[(size_t)(k0 + kk) * N + n0 + (lane & 31)]; }
#pragma unroll
    for (int i = 0; i < 32; ++i) { const int kk = 2 * i + (lane >> 5); scr[kk * 33 + (lane & 31)] = v[i]; }
    asm volatile("s_waitcnt lgkmcnt(0)" ::: "memory");
    const int c = lane & 7;
#pragma unroll
    for (int j = 0; j < 4; ++j) { const int n = (lane >> 3) + 8 * j; const LAS float* t = scr + (8 * c) * 33 + n;
        u32x4 o; o.x = pk2(t[0], t[33]); o.y = pk2(t[66], t[99]); o.z = pk2(t[132], t[165]); o.w = pk2(t[198], t[231]);
        *(u32x4*)(Bt + (size_t)(r0 + n) * K + k0 + 8 * c) = o; }
    asm volatile("s_waitcnt lgkmcnt(0)" ::: "memory");
}
__device__ __forceinline__ void prep_item2(const Params& P, int rowA, int rowB, bool hasB, int lane) {
    const int rows[2] = {rowA, hasB ? rowB : rowA};
    f32x4 v[2][4], g[2][4];
#pragma unroll
    for (int q = 0; q < 2; ++q) { const int row = rows[q]; const int s = row < NLAT ? (row >> 13) : 4;
        const float* src = row < NLAT ? P.in[I_X] + (size_t)row * D : P.in[I_CTX] + (size_t)(row - NLAT) * D;
        const float* gs = (const float*)(P.ws + OFF_MODV) + ((0 * 5 + s) * 9 + 1) * 1024;
#pragma unroll
        for (int j = 0; j < 4; ++j) { const int c = (lane + 64 * j) * 4; v[q][j] = *(const f32x4*)(src + c); g[q][j] = *(const f32x4*)(gs + c); } }
#pragma unroll
    for (int q = 0; q < 2; ++q) { if (q == 1 && !hasB) break; const int row = rows[q];
        bf16_t* ap = (bf16_t*)(P.ws + OFF_AP) + (size_t)row * D; bf16_t* hbp = (bf16_t*)(P.ws + OFF_HB) + (size_t)row * D;
        float sq = 0.f;
#pragma unroll
        for (int j = 0; j < 4; ++j) { const int c = (lane + 64 * j) * 4; const f32x4 x = v[q][j], gg = g[q][j];
            sq += (x.x * x.x + x.y * x.y) + (x.z * x.z + x.w * x.w);
            u32x2 o; o.x = pk2(x.x * gg.x, x.y * gg.y); o.y = pk2(x.z * gg.z, x.w * gg.w); *(u32x2*)(ap + c) = o;
            u32x2 hh; hh.x = pk2(x.x, x.y); hh.y = pk2(x.z, x.w); *(u32x2*)(hbp + c) = hh; }
#pragma unroll
        for (int o = 1; o < 64; o <<= 1) sq += __shfl_xor(sq, o);
        if (lane < 16) ((float*)(P.ws + OFF_RSQ))[(size_t)row * 16 + lane] = lane == 0 ? sq : 0.f; }
}
__device__ __forceinline__ void final_item(const Params& P, int it) {
    const int tid = opaque_tid(), w = tid >> 6, lane = tid & 63;
    const float* g = P.in[I_GF];
    u32x2 r[2][4]; f32x4 gg[4]; float t[2];
#pragma unroll
    for (int j = 0; j < 4; ++j) gg[j] = *(const f32x4*)(g + (lane + 64 * j) * 4);
#pragma unroll
    for (int q = 0; q < 2; ++q) { const int row = it * 16 + 2 * w + q;
        t[q] = ((const float*)(P.ws + OFF_RSQ))[(size_t)row * 16 + (lane & 15)];
        const bf16_t* hp = (const bf16_t*)(P.ws + OFF_HB) + (size_t)row * D;
#pragma unroll
        for (int j = 0; j < 4; ++j) r[q][j] = *(const u32x2*)(hp + (lane + 64 * j) * 4); }
#pragma unroll
    for (int q = 0; q < 2; ++q) { const int row = it * 16 + 2 * w + q; float tt = t[q];
        tt += __shfl_xor(tt, 1); tt += __shfl_xor(tt, 2); tt += __shfl_xor(tt, 4); tt += __shfl_xor(tt, 8);
        const float rstd = rsqrtf(tt * (1.0f / 1024.0f) + EPS);
        float* op = P.out + (size_t)row * D;
#pragma unroll
        for (int j = 0; j < 4; ++j) { const int c = (lane + 64 * j) * 4; *(f32x4*)(op + c) = (f32x4){bflo(r[q][j].x), bfhi(r[q][j].x), bflo(r[q][j].y), bfhi(r[q][j].y)} * rstd * gg[j]; } }
}

__device__ __forceinline__ void ctx_fix_row(const Params& P, int r, int lane, int ks, const float* part, const float* gate, const float* gsn) {
    const int c0 = lane * 16; const size_t grow = (size_t)NLAT + r;
    f32x4 sum[4];
#pragma unroll
    for (int i = 0; i < 4; ++i) sum[i] = (f32x4){0.f, 0.f, 0.f, 0.f};
    for (int k = 0; k < ks; ++k) { const float* pp = part + ((size_t)k * NCTX + r) * D + c0;
#pragma unroll
        for (int i = 0; i < 4; ++i) sum[i] += *(const f32x4*)(pp + 4 * i); }
    bf16_t* hp = (bf16_t*)(P.ws + OFF_HB) + grow * D + c0; bf16_t* ap = (bf16_t*)(P.ws + OFF_AP) + grow * D + c0;
    const u32x4 h0 = *(const u32x4*)hp, h1 = *(const u32x4*)(hp + 8);
    const unsigned hw[8] = {h0.x, h0.y, h0.z, h0.w, h1.x, h1.y, h1.z, h1.w};
    float n[16]; float sq = 0.f;
#pragma unroll
    for (int i = 0; i < 4; ++i) { const f32x4 g = *(const f32x4*)(gate + 4 * 9216 + c0 + 4 * i);
        n[4 * i] = bflo(hw[2 * i]) + g.x * sum[i].x; n[4 * i + 1] = bfhi(hw[2 * i]) + g.y * sum[i].y; n[4 * i + 2] = bflo(hw[2 * i + 1]) + g.z * sum[i].z; n[4 * i + 3] = bfhi(hw[2 * i + 1]) + g.w * sum[i].w; }
#pragma unroll
    for (int i = 0; i < 16; ++i) sq += n[i] * n[i];
    u32x4 o0, o1; o0.x = pk2(n[0], n[1]); o0.y = pk2(n[2], n[3]); o0.z = pk2(n[4], n[5]); o0.w = pk2(n[6], n[7]); o1.x = pk2(n[8], n[9]); o1.y = pk2(n[10], n[11]); o1.z = pk2(n[12], n[13]); o1.w = pk2(n[14], n[15]);
    *(u32x4*)hp = o0; *(u32x4*)(hp + 8) = o1;
    if (gsn) {
#pragma unroll
        for (int i = 0; i < 4; ++i) { const f32x4 g = *(const f32x4*)(gsn + 4 * 9216 + c0 + 4 * i); n[4 * i] *= g.x; n[4 * i + 1] *= g.y; n[4 * i + 2] *= g.z; n[4 * i + 3] *= g.w; }
        o0.x = pk2(n[0], n[1]); o0.y = pk2(n[2], n[3]); o0.z = pk2(n[4], n[5]); o0.w = pk2(n[6], n[7]); o1.x = pk2(n[8], n[9]); o1.y = pk2(n[10], n[11]); o1.z = pk2(n[12], n[13]); o1.w = pk2(n[14], n[15]);
        *(u32x4*)ap = o0; *(u32x4*)(ap + 8) = o1; }
    sq += __shfl_xor(sq, 1); sq += __shfl_xor(sq, 2);
    if ((lane & 3) == 0) ((float*)(P.ws + OFF_RSQ))[grow * 16 + (lane >> 2)] = sq;
}

__device__ __forceinline__ void tile_info(int tix, int& row0, int& pos0, int& L, int& b) {
    if (tix < 256) { b = tix >> 6; pos0 = (tix & 63) * 128; row0 = b * SEQ + pos0; L = SEQ; }
    else { const int c = tix - 256; b = c >> 1; pos0 = (c & 1) * 128; row0 = NLAT + b * CTXL + pos0; L = CTXL; }
}
constexpr int SC_WG_OFF = 0, SC_CW_OFF = 36864, SC_CAR_OFF = 38144, SC_WCOMP_OFF = 42752, SC_XL_OFF = 50944, SC_GL_OFF = 67840, SC_XC_OFF = 84224;
struct ScanPre { u32x4 x[3]; u32x4 g[2]; u32x4 cf[8]; };
constexpr size_t COEF_ITEM = 65536, COEF_TAIL_ITEMS = 264;
__device__ __forceinline__ u32x4* coef_base(const Params& P, int item) {
    const size_t off = item < 1056 ? OFF_AP + (size_t)item * COEF_ITEM : (item < 1848 ? OFF_HID + (size_t)MT * 2048 * 2 + (size_t)(item - 1056) * COEF_ITEM : WS_END + (size_t)(item - 1848) * COEF_ITEM);
    return (u32x4*)(P.ws + off);
}
__device__ __forceinline__ void scan_prefetch(ScanPre& R, const Params& P, const bf16_t* pb, int tix, int h, int tid, bool final_mode) {
    int row0, pos0, L, b; tile_info(tix, row0, pos0, L, b);
    if (!final_mode) {
#pragma unroll
        for (int i = 0; i < 3; ++i) { const int idx = tid + 512 * i, r = idx >> 3, pc = idx & 7, pos = pos0 - 2 + r; R.x[i] = (u32x4){0u, 0u, 0u, 0u};
            if (idx < 131 * 8 && pos >= 0 && pos < L) R.x[i] = *(const u32x4*)(pb + (size_t)(row0 - 2 + r) * 2048 + h * 64 + pc * 8); }
    } else {
#pragma unroll
        for (int i = 0; i < 2; ++i) { const int idx = tid + 512 * i, r = idx >> 3, pc = idx & 7; R.g[i] = *(const u32x4*)(pb + (size_t)(row0 + r) * 2048 + 512 + h * 64 + pc * 8); }
        const u32x4* cb = coef_base(P, tix * 8 + h) + tid;
#pragma unroll
        for (int i = 0; i < 8; ++i) R.cf[i] = cb[i * 512];
    }
}
__device__ __forceinline__ void scan_group(const Params& P, int l, int wgI, bool final_mode, bool with_ctx, LAS unsigned char* lds) {
    const int tid = opaque_tid(), w = __builtin_amdgcn_readfirstlane(tid >> 6), lane = tid & 63, fr = lane & 15, fq = lane >> 4;
    const int h = wgI & 7, grp = wgI >> 3, gb = grp >> 3, j0 = (grp & 7) * 8;
    const int ctix = 256 + (wgI >> 3);
    const bool has_ctx = with_ctx && wgI < 64;
    const bf16_t* pb = (const bf16_t*)(P.ws + OFF_HID);
    float* summ = (float*)(P.ws + OFF_SUM);
    LAS f32x2* wcomp = (LAS f32x2*)(lds + SC_WCOMP_OFF); LAS float* car = (LAS float*)(lds + SC_CAR_OFF); LAS float* cw = (LAS float*)(lds + SC_CW_OFF);
    __syncthreads();
    if (!final_mode) { const bf16_t* wg = (const bf16_t*)(P.ws + OFF_WG);
      for (int idx = tid; idx < 2048; idx += 512) { const int mat = idx >> 9, e = (idx >> 3) & 63, pc = idx & 7;
          *(LAS u32x4*)(lds + SC_WG_OFF + (mat * 64 + e) * 144 + pc * 16) = *(const u32x4*)(wg + ((size_t)((l * 2 + (mat >> 1)) * 2 + (mat & 1)) * 8 + h) * 4096 + e * 64 + pc * 8); }
      if (tid < 320) { const int k = tid >> 6, ch = tid & 63; cw[tid] = k < 4 ? P.in[I_CONVW][(l * 4 + k) * 512 + h * 64 + ch] : P.in[I_CONVB][l * 512 + h * 64 + ch]; } }
    float brv[2][4], biv[2][4], sp8[2][4];
#pragma unroll
    for (int dir = 0; dir < 2; ++dir)
#pragma unroll
        for (int eb = 0; eb < 4; ++eb) { const int pidx = (l * 2 + dir) * 512 + h * 64 + eb * 16 + fr;
            brv[dir][eb] = -1.4426950408889634f * P.in[I_BR][pidx]; biv[dir][eb] = -1.4426950408889634f * P.in[I_BI][pidx]; sp8[dir][eb] = 8.0f * 1.4426950408889634f * log1pf(__expf(-P.in[I_LAM][pidx])); }
    if (final_mode) {
        LAS float* T = (LAS float*)(lds + SC_XL_OFF);
        { float tv[33];
#pragma unroll
          for (int i = 0; i < 33; ++i) { const int idx = tid + 512 * i; const int ch = idx & 63, ab = (idx >> 6) & 1, dir = (idx >> 7) & 1, k = idx >> 8;
              const int t = k < 2 ? 256 + 2 * gb + (dir == 0 ? k : 1 - k) : gb * 64 + (dir == 0 ? (k - 2) : (63 - (k - 2)));
              tv[i] = summ[((size_t)(t * 2 + dir) * 2 + ab) * 512 + h * 64 + ch]; }
#pragma unroll
          for (int i = 0; i < 33; ++i) { const int idx = tid + 512 * i; const int ch = idx & 63, ab = (idx >> 6) & 1, dir = (idx >> 7) & 1, k = idx >> 8;
              T[((dir * 66 + k) * 2 + ab) * 64 + ch] = tv[i]; } }
        __syncthreads();
        if (tid < 128) { const int dir = tid >> 6, ch = tid & 63; float s = 0.f;
#pragma unroll 6
            for (int k = 0; k < 66; ++k) {
                if (k >= 2) { const int i = (dir == 0 ? (k - 2) : (63 - (k - 2))) - j0; if (i >= 0 && i < 8) car[(dir * 9 + i) * 64 + ch] = s; }
                s = T[((dir * 66 + k) * 2 + 0) * 64 + ch] * s + T[((dir * 66 + k) * 2 + 1) * 64 + ch]; }
            float cs = 0.f;
            if (has_ctx) { const int cj = (ctix - 256) & 1; if (dir == 0 && cj == 1) cs = summ[((size_t)((ctix - 1) * 2 + 0) * 2 + 1) * 512 + h * 64 + ch]; if (dir == 1 && cj == 0) cs = summ[((size_t)((ctix + 1) * 2 + 1) * 2 + 1) * 512 + h * 64 + ch]; }
            car[(dir * 9 + 8) * 64 + ch] = cs; }
        __syncthreads();
    }
    const int nitems = 8 + (has_ctx ? 1 : 0);
    ScanPre R; scan_prefetch(R, P, pb, grp * 8, h, tid, final_mode);
#pragma unroll 1
    for (int it = 0; it < nitems; ++it) {
        const int tix = it < 8 ? grp * 8 + it : ctix;
        int row0, pos0, L, b; tile_info(tix, row0, pos0, L, b);
        if (!final_mode) {
#pragma unroll
        for (int i = 0; i < 3; ++i) { const int idx = tid + 512 * i; if (idx < 131 * 8) *(LAS u32x4*)(lds + SC_XL_OFF + (idx >> 3) * 128 + (idx & 7) * 16) = R.x[i]; }
        } else {
#pragma unroll
            for (int i = 0; i < 2; ++i) { const int idx = tid + 512 * i; *(LAS u32x4*)(lds + SC_GL_OFF + (idx >> 3) * 128 + (idx & 7) * 16) = R.g[i]; } }
        __syncthreads();
        if (it + 1 < nitems && !final_mode) scan_prefetch(R, P, pb, it + 1 < 8 ? grp * 8 + it + 1 : ctix, h, tid, final_mode);
        if (!final_mode) { const int q = tid >> 2, c4 = tid & 3; float a[16];
#pragma unroll
          for (int i = 0; i < 4; ++i) { const f32x4 bv = *(const LAS f32x4*)(cw + 256 + c4 * 16 + 4 * i); a[4 * i] = bv.x; a[4 * i + 1] = bv.y; a[4 * i + 2] = bv.z; a[4 * i + 3] = bv.w; }
#pragma unroll
          for (int k = 0; k < 4; ++k) {
              const u32x4 x0 = *(const LAS u32x4*)(lds + SC_XL_OFF + (q + k) * 128 + c4 * 32), x1 = *(const LAS u32x4*)(lds + SC_XL_OFF + (q + k) * 128 + c4 * 32 + 16);
              const unsigned xs[8] = {x0.x, x0.y, x0.z, x0.w, x1.x, x1.y, x1.z, x1.w};
#pragma unroll
              for (int i = 0; i < 4; ++i) { const f32x4 wv = *(const LAS f32x4*)(cw + k * 64 + c4 * 16 + 4 * i);
                  a[4 * i] += wv.x * bflo(xs[2 * i]); a[4 * i + 1] += wv.y * bfhi(xs[2 * i]); a[4 * i + 2] += wv.z * bflo(xs[2 * i + 1]); a[4 * i + 3] += wv.w * bfhi(xs[2 * i + 1]); } }
          LAS float* xo = (LAS float*)(lds + SC_XC_OFF + q * 272 + c4 * 64);
#pragma unroll
          for (int i = 0; i < 4; ++i) *(LAS f32x4*)(xo + 4 * i) = (f32x4){a[4 * i], a[4 * i + 1], a[4 * i + 2], a[4 * i + 3]}; }
        __syncthreads();
        bf16x8 af[2] = {};
        if (!final_mode) {
#pragma unroll
        for (int ks = 0; ks < 2; ++ks) { const LAS float* xr = (const LAS float*)(lds + SC_XC_OFF + (16 * w + fr) * 272) + ks * 32 + fq * 8;
            const f32x4 v0 = *(const LAS f32x4*)xr, v1 = *(const LAS f32x4*)(xr + 4);
            u32x4 t; t.x = pk2(v0.x, v0.y); t.y = pk2(v0.z, v0.w); t.z = pk2(v1.x, v1.y); t.w = pk2(v1.z, v1.w); af[ks] = __builtin_bit_cast(bf16x8, t); }
        }
        float ca[2][4][4], cbv[2][4][4], Ae[2][4], Be[2][4];
#pragma unroll
        for (int dir = 0; dir < 2; ++dir) {
#pragma unroll
            for (int eb = 0; eb < 4; ++eb) {
              if (!final_mode) {
                f32x4 pr = (f32x4){0.f, 0.f, 0.f, 0.f}, pi = pr;
#pragma unroll
                for (int ks = 0; ks < 2; ++ks) {
                    const bf16x8 br = *(const LAS bf16x8*)(lds + SC_WG_OFF + ((dir * 2 + 0) * 64 + eb * 16 + fr) * 144 + ks * 64 + fq * 16);
                    const bf16x8 bi = *(const LAS bf16x8*)(lds + SC_WG_OFF + ((dir * 2 + 1) * 64 + eb * 16 + fr) * 144 + ks * 64 + fq * 16);
                    pr = __builtin_amdgcn_mfma_f32_16x16x32_bf16(af[ks], br, pr, 0, 0, 0);
                    pi = __builtin_amdgcn_mfma_f32_16x16x32_bf16(af[ks], bi, pi, 0, 0, 0);
                }
                float la[4], ig[4], xv[4];
#pragma unroll
                for (int j = 0; j < 4; ++j) {
                    const float r = __builtin_amdgcn_rcpf(1.0f + __builtin_amdgcn_exp2f(pr[j] + brv[dir][eb])); ig[j] = __builtin_amdgcn_rcpf(1.0f + __builtin_amdgcn_exp2f(pi[j] + biv[dir][eb]));
                    xv[j] = *(const LAS float*)(lds + SC_XC_OFF + (16 * w + 4 * fq + j) * 272 + (eb * 16 + fr) * 4);
                    la[j] = -r * sp8[dir][eb]; }
                u32x4 pk; pk.x = pk2(la[0], la[1]); pk.y = pk2(la[2], la[3]);
                la[0] = bflo(pk.x); la[1] = bfhi(pk.x); la[2] = bflo(pk.y); la[3] = bfhi(pk.y);
                float bq[4];
#pragma unroll
                for (int j = 0; j < 4; ++j) { const float av = __builtin_amdgcn_exp2f(la[j]); ca[dir][eb][j] = av;
                    bq[j] = __builtin_amdgcn_sqrtf(__builtin_fmaf(-av, av, 1.0f)) * ig[j] * xv[j]; }
                pk.z = pk2(bq[0], bq[1]); pk.w = pk2(bq[2], bq[3]);
                cbv[dir][eb][0] = bflo(pk.z); cbv[dir][eb][1] = bfhi(pk.z); cbv[dir][eb][2] = bflo(pk.w); cbv[dir][eb][3] = bfhi(pk.w);
                coef_base(P, tix * 8 + h)[(dir * 4 + eb) * 512 + tid] = pk;
              } else {
                const u32x4 pk = R.cf[dir * 4 + eb];
                ca[dir][eb][0] = __builtin_amdgcn_exp2f(bflo(pk.x)); ca[dir][eb][1] = __builtin_amdgcn_exp2f(bfhi(pk.x)); ca[dir][eb][2] = __builtin_amdgcn_exp2f(bflo(pk.y)); ca[dir][eb][3] = __builtin_amdgcn_exp2f(bfhi(pk.y));
                cbv[dir][eb][0] = bflo(pk.z); cbv[dir][eb][1] = bfhi(pk.z); cbv[dir][eb][2] = bflo(pk.w); cbv[dir][eb][3] = bfhi(pk.w);
              }
                float A = 1.f, B = 0.f;
                if (dir == 0) {
#pragma unroll
                    for (int j = 0; j < 4; ++j) { B = ca[dir][eb][j] * B + cbv[dir][eb][j]; A *= ca[dir][eb][j]; }
                    float Ap = __shfl_up(A, 16), Bp = __shfl_up(B, 16); if (fq >= 1) { B = A * Bp + B; A = A * Ap; }
                    Ap = __shfl_up(A, 32); Bp = __shfl_up(B, 32); if (fq >= 2) { B = A * Bp + B; A = A * Ap; }
                    float ae = __shfl_up(A, 16), be = __shfl_up(B, 16); if (fq == 0) { ae = 1.f; be = 0.f; }
                    Ae[dir][eb] = ae; Be[dir][eb] = be;
                    if (fq == 3) wcomp[(0 * 8 + w) * 64 + eb * 16 + fr] = (f32x2){A, B};
                } else {
#pragma unroll
                    for (int j = 3; j >= 0; --j) { B = ca[dir][eb][j] * B + cbv[dir][eb][j]; A *= ca[dir][eb][j]; }
                    float Ap = __shfl_down(A, 16), Bp = __shfl_down(B, 16); if (fq <= 2) { B = A * Bp + B; A = A * Ap; }
                    Ap = __shfl_down(A, 32); Bp = __shfl_down(B, 32); if (fq <= 1) { B = A * Bp + B; A = A * Ap; }
                    float ae = __shfl_down(A, 16), be = __shfl_down(B, 16); if (fq == 3) { ae = 1.f; be = 0.f; }
                    Ae[dir][eb] = ae; Be[dir][eb] = be;
                    if (fq == 0) wcomp[(1 * 8 + w) * 64 + eb * 16 + fr] = (f32x2){A, B};
                }
            }
        }
        if (final_mode && it + 1 < nitems) scan_prefetch(R, P, pb, it + 1 < 8 ? grp * 8 + it + 1 : ctix, h, tid, final_mode);
        __syncthreads();
        if (!final_mode) {
            if (w == 0) {
                float A = 1.f, B = 0.f;
#pragma unroll
                for (int v = 0; v < 8; ++v) { const f32x2 cv = wcomp[(0 * 8 + v) * 64 + lane]; B = cv.x * B + cv.y; A = cv.x * A; }
                float* sp = summ + ((size_t)(tix * 2 + 0) * 2) * 512 + h * 64 + lane; sp[0] = A; sp[512] = B;
                A = 1.f; B = 0.f;
#pragma unroll
                for (int v = 7; v >= 0; --v) { const f32x2 cv = wcomp[(1 * 8 + v) * 64 + lane]; B = cv.x * B + cv.y; A = cv.x * A; }
                sp = summ + ((size_t)(tix * 2 + 1) * 2) * 512 + h * 64 + lane; sp[0] = A; sp[512] = B;
            }
        } else {
#pragma unroll
            for (int eb = 0; eb < 4; ++eb) {
                const int c = eb * 16 + fr;
                float s = car[(0 * 9 + it) * 64 + c];
#pragma unroll
                for (int v = 0; v < 7; ++v) { const f32x2 cv = wcomp[(0 * 8 + v) * 64 + c]; if (v < w) s = cv.x * s + cv.y; }
                s = Ae[0][eb] * s + Be[0][eb];
                float hf[4];
#pragma unroll
                for (int j = 0; j < 4; ++j) { s = ca[0][eb][j] * s + cbv[0][eb][j]; hf[j] = s; }
                s = car[(1 * 9 + it) * 64 + c];
#pragma unroll
                for (int v = 7; v > 0; --v) { const f32x2 cv = wcomp[(1 * 8 + v) * 64 + c]; if (v > w) s = cv.x * s + cv.y; }
                s = Ae[1][eb] * s + Be[1][eb];
#pragma unroll
                for (int j = 3; j >= 0; --j) { s = ca[1][eb][j] * s + cbv[1][eb][j]; hf[j] += s; }
#pragma unroll
                for (int j = 0; j < 4; ++j) {
                    const int q = 16 * w + 4 * fq + j;
                    const float g = bflo((unsigned)*(const LAS bf16_t*)(lds + SC_GL_OFF + q * 128 + c * 2));
                    const float ge = g * sigmoidf_(1.5957691216f * (g + 0.044715f * g * g * g));
                    *(LAS bf16_t*)(lds + SC_XC_OFF + q * 128 + c * 2) = (bf16_t)(pk2(hf[j] * ge, 0.f) & 0xffffu);
                }
            }
            __syncthreads();
            bf16_t* yb = (bf16_t*)(P.ws + OFF_Y);
#pragma unroll
            for (int i = 0; i < 2; ++i) { const int idx = tid + 512 * i, r = idx >> 3, pc = idx & 7;
                *(u32x4*)(yb + (size_t)(row0 + r) * D + h * 64 + pc * 8) = *(const LAS u32x4*)(lds + SC_XC_OFF + r * 128 + pc * 16); }
        }
    }
}
constexpr int ST_OFF = 0, VT_OFF = 1024;
__device__ __forceinline__ void sgu_item(const Params& P, int l, int tix, int g, LAS unsigned char* lds) {
    const int tid = opaque_tid(), w = __builtin_amdgcn_readfirstlane(tid >> 6), lane = tid & 63, fr = lane & 15, fq = lane >> 4;
    int row0, pos0, L, b; tile_info(tix, row0, pos0, L, b);
    const bf16_t* pb = (const bf16_t*)(P.ws + OFF_HID); bf16_t* yb = (bf16_t*)(P.ws + OFF_Y);
    LAS f32x2* stat = (LAS f32x2*)(lds + ST_OFF);
    __syncthreads();
    if (tid < 128) { const float* vp = (const float*)(P.ws + OFF_VST) + (size_t)(row0 + tid) * 16; float sm = 0.f, sq = 0.f;
#pragma unroll
        for (int i = 0; i < 4; ++i) { const f32x4 t = *(const f32x4*)(vp + 4 * i); sm += t.x + t.z; sq += t.y + t.w; }
        const float mean = sm * (1.0f / 512.0f), var = fmaxf(sq * (1.0f / 512.0f) - mean * mean, 0.f);
        stat[tid] = (f32x2){mean, rsqrtf(var + EPS)}; }
    __syncthreads();
    { const int qp = lane; const f32x2 s0 = stat[2 * qp], s1 = stat[2 * qp + 1];
#pragma unroll
      for (int it = 0; it < 2; ++it) { const int c0 = (w + 8 * it) * 8;
          const u32x4 r0 = *(const u32x4*)(pb + (size_t)(row0 + 2 * qp) * 2048 + 1536 + g * 128 + c0), r1 = *(const u32x4*)(pb + (size_t)(row0 + 2 * qp + 1) * 2048 + 1536 + g * 128 + c0);
          const float* gp = P.in[I_SGN] + l * 512 + g * 128 + c0; const f32x4 g0 = *(const f32x4*)gp, g1 = *(const f32x4*)(gp + 4);
          const float gn[8] = {g0.x, g0.y, g0.z, g0.w, g1.x, g1.y, g1.z, g1.w};
          const unsigned a[4] = {r0.x, r0.y, r0.z, r0.w}, bb[4] = {r1.x, r1.y, r1.z, r1.w};
#pragma unroll
          for (int i = 0; i < 4; ++i) {
              const float e0 = (bflo(a[i]) - s0.x) * s0.y * gn[2 * i], e1 = (bflo(bb[i]) - s1.x) * s1.y * gn[2 * i];
              const float o0 = (bfhi(a[i]) - s0.x) * s0.y * gn[2 * i + 1], o1 = (bfhi(bb[i]) - s1.x) * s1.y * gn[2 * i + 1];
              *(LAS unsigned*)(lds + VT_OFF + (c0 + 2 * i) * 272 + qp * 4) = pk2(e0, e1);
              *(LAS unsigned*)(lds + VT_OFF + (c0 + 2 * i + 1) * 272 + qp * 4) = pk2(o0, o1); } } }
    __syncthreads();
    const bf16_t* sgw = (const bf16_t*)(P.ws + OFF_SGW) + ((size_t)(l * 4 + g) * 128 + 16 * w + fr) * 128;
    bf16x8 bfr[4];
#pragma unroll
    for (int ks = 0; ks < 4; ++ks) bfr[ks] = *(const bf16x8*)(sgw + ks * 32 + fq * 8);
    const float bs = P.in[I_SGB][(l * 4 + g) * 128 + 16 * w + fr];
    const size_t prow = (size_t)(row0 + 16 * w + fr);
#pragma unroll
    for (int cb = 0; cb < 8; ++cb) {
        f32x4 acc = (f32x4){0.f, 0.f, 0.f, 0.f};
#pragma unroll
        for (int ks = 0; ks < 4; ++ks) { const bf16x8 a = *(const LAS bf16x8*)(lds + VT_OFF + (cb * 16 + fr) * 272 + (ks * 32 + fq * 8) * 2);
            acc = __builtin_amdgcn_mfma_f32_16x16x32_bf16(a, bfr[ks], acc, 0, 0, 0); }
        const int cc = g * 128 + cb * 16 + fq * 4;
        const u32x2 uu = *(const u32x2*)(pb + prow * 2048 + 1024 + cc);
        u32x2 o; o.x = pk2(bflo(uu.x) * (acc[0] + bs), bfhi(uu.x) * (acc[1] + bs)); o.y = pk2(bflo(uu.y) * (acc[2] + bs), bfhi(uu.y) * (acc[3] + bs));
        *(u32x2*)(yb + prow * D + 512 + cc) = o;
    }
}


#define XB_TMO      128
#define XB_XCNT(j)  (256  + 64 * (j))
#define XB_XSUB(j)  (1280 + 64 * (j))
#define XB_XGEN(j)  (2304 + 64 * (j))
#define XB_TOP      3328
#define XB_TOPGEN   3392
#define XCD_BAR_WORDS 3456
#define XB_SPIN_CAP (1u << 18)
__device__ __forceinline__ unsigned xb_ld(unsigned* p)              { return __hip_atomic_load(p, __ATOMIC_RELAXED, __HIP_MEMORY_SCOPE_AGENT); }
__device__ __forceinline__ unsigned xb_add(unsigned* p, unsigned v) { return __hip_atomic_fetch_add(p, v, __ATOMIC_RELAXED, __HIP_MEMORY_SCOPE_AGENT); }
__device__ __forceinline__ unsigned xb_xcc_id() { return (unsigned)__builtin_amdgcn_s_getreg((3 << 11) | 20) & 0xFu; }
#define XB_SPIN(cond, bar) do { unsigned _sp = 0; while (cond) { __builtin_amdgcn_s_sleep(1); \
    if ((++_sp & 255u) == 0u) { if (xb_ld(&(bar)[XB_TMO])) break; if (_sp > XB_SPIN_CAP) { atomicAdd(&(bar)[XB_TMO], 1u); break; } } } } while (0)
struct XcdBarrier { unsigned* bar; unsigned x; volatile LAS unsigned* st; };
__device__ __forceinline__ XcdBarrier xcd_barrier_post(unsigned* bar, volatile LAS unsigned* st) {
    XcdBarrier b; b.bar = bar; b.x = xb_xcc_id(); b.st = st;
    if (threadIdx.x == 0) (void)xb_add(&bar[XB_XCNT(b.x)], 1u);
    return b;
}
__device__ __forceinline__ void xcd_barrier_complete(unsigned* bar, unsigned x, unsigned& nloc, unsigned& nx) {
    const unsigned G = gridDim.x * gridDim.y * gridDim.z;
    unsigned sum, cnt, mine, sp = 0u;
    for (;;) {
        sum = 0u; cnt = 0u; mine = 0u;
#pragma unroll
        for (unsigned j = 0; j < 16; ++j) { const unsigned c = xb_ld(&bar[XB_XCNT(j)]); sum += c; cnt += (c > 0u) ? 1u : 0u; mine = (j == x) ? c : mine; }
        if (sum == G) break;
        __builtin_amdgcn_s_sleep(1);
        if ((++sp & 255u) == 0u) { if (xb_ld(&bar[XB_TMO])) break; if (sp > XB_SPIN_CAP) { atomicAdd(&bar[XB_TMO], 1u); break; } }
    }
    nloc = mine > 0u ? mine : 1u; nx = cnt > 0u ? cnt : 1u;
}
__device__ __forceinline__ void xcd_barrier(const XcdBarrier& b) {
    asm volatile("s_waitcnt vmcnt(0)" ::: "memory");
    __syncthreads();
    if (threadIdx.x == 0) {
        unsigned* bar = b.bar;
        __builtin_amdgcn_s_waitcnt(0);
        unsigned nloc = b.st[0], nx = b.st[1];
        if (nloc == 0u) { xcd_barrier_complete(bar, b.x, nloc, nx); b.st[0] = nloc; b.st[1] = nx; }
        const unsigned old = xb_add(&bar[XB_XSUB(b.x)], 1u);
        const unsigned gen = old / nloc;
        if (old + 1u == (gen + 1u) * nloc) {
            __builtin_amdgcn_fence(__ATOMIC_RELEASE, "agent");
            asm volatile("s_waitcnt vmcnt(0)" ::: "memory");
            const unsigned og = xb_add(&bar[XB_TOP], 1u);
            const unsigned tg = og / nx;
            if (og + 1u == (tg + 1u) * nx) xb_add(&bar[XB_TOPGEN], 1u);
            else XB_SPIN(xb_ld(&bar[XB_TOPGEN]) == tg, bar);
            __builtin_amdgcn_fence(__ATOMIC_ACQUIRE, "agent");
            xb_add(&bar[XB_XGEN(b.x)], 1u);
            asm volatile("s_waitcnt vmcnt(0)" ::: "memory");
        } else {
            XB_SPIN(xb_ld(&bar[XB_XGEN(b.x)]) == gen, bar);
            __builtin_amdgcn_fence(__ATOMIC_ACQUIRE, "agent");
            asm volatile("s_waitcnt vmcnt(0)" ::: "memory");
        }
    }
    __syncthreads();
}

__global__ void __launch_bounds__(512) fwd_mega(Params P) {
    extern __shared__ __attribute__((aligned(16))) unsigned char lds_raw[];
    LAS unsigned char* lds = (LAS unsigned char*)lds_raw;
    cg::grid_group grid = cg::this_grid();
    const int G = gridDim.x, c = blockIdx.x, tid = threadIdx.x;
    if (P.ws == nullptr) grid.sync();
    volatile LAS unsigned* xst = (volatile LAS unsigned*)(lds + 131072);
    if (tid == 0) { xst[0] = 0u; xst[1] = 0u; xst[2] = 0u; xst[3] = 0u; }
    __syncthreads();
    const XcdBarrier xb = xcd_barrier_post((unsigned*)(P.ws + OFF_BAR), xst);
    for (int it = c; it < 288; it += G) adaln_item(P, it, lds);
    { const int tw = opaque_tid(), wv = tw >> 6, ln = tw & 63; LAS float* scr = (LAS float*)(lds + 32768 + wv * 8448);
      for (int it = c * 8 + wv; it < 19968; it += G * 8) transpose_item(P, it, scr, ln); }
    { bf16_t* wg = (bf16_t*)(P.ws + OFF_WG);
      for (int i = c * 512 + tid; i < 262144; i += G * 512) { const int d = i & 63, e = (i >> 6) & 63, h = (i >> 12) & 7, gate = (i >> 15) & 1, dir = (i >> 16) & 1, l = i >> 17;
          const float* src = gate ? P.in[I_WI] : P.in[I_WR]; wg[i] = (bf16_t)(pk2(src[((size_t)((l * 2 + dir) * 8 + h) * 64 + d) * 64 + e] * -1.4426950408889634f, 0.f) & 0xffffu); }
      bf16_t* sg = (bf16_t*)(P.ws + OFF_SGW);
      for (int i = c * 512 + tid; i < 131072; i += G * 512) sg[i] = (bf16_t)(pk2(P.in[I_SGW][i], 0.f) & 0xffffu); }
    xcd_barrier(xb);
    for (int it = c; it < 416; it += G) shiftw_item(P, it, lds);
    { const int tw = opaque_tid(), wv = tw >> 6, ln = tw & 63;
      for (int row = c * 8 + wv; row < MT; row += 2 * G * 8) prep_item2(P, row, row + G * 8, row + G * 8 < MT, ln); }
    xcd_barrier(xb);
    bf16_t* AP = (bf16_t*)(P.ws + OFF_AP); bf16_t* YB = (bf16_t*)(P.ws + OFF_Y); bf16_t* HID = (bf16_t*)(P.ws + OFF_HID);
    float* RSQ = (float*)(P.ws + OFF_RSQ); float* VST = (float*)(P.ws + OFF_VST);
    const float* MODV = (const float*)(P.ws + OFF_MODV); const float* SW = (const float*)(P.ws + OFF_SW);
#pragma unroll 1
    for (int ph = 0; ph < 16; ++ph) {
        const int l = ph >> 3, st = ph & 7; const bool lastl = l == 1;
        const unsigned char* WL = P.ws + OFF_W + (size_t)l * LW_TOTAL;
        if (st == 0 || st == 6) {
            EpiSwiglu E; E.rtab = (const LAS float*)(lds + RSTD_OFF); E.vtab = (const LAS float*)(lds + VEC_OFF); E.hid = HID;
            const float* sWp = SW + (size_t)l * 5 * 13312 + (st == 0 ? 0 : 7680);
            pg8::Gemm g{AP, (const bf16_t*)(WL + (st == 0 ? LW_WIN1 : LW_WIN2)), MT, 5632, 1024};
            pg8::Order2 S; S.init(22, (st == 6 && lastl) ? 0 : 22, G, c);
            fill_tabs<1>(lds, S, RSQ, sWp, nullptr);
            pg8::gemm_phase<EpiSwiglu, pg8::Order2>(lds, g, S, E);
        } else if (st == 1 || st == 5 || st == 7) {
            EpiResid E; E.hb = (bf16_t*)(P.ws + OFF_HB);
            const int cg_ = st == 1 ? 2 : (st == 5 ? 5 : 8);
            E.gate = MODV + (size_t)(l * 5) * 9216 + cg_ * 1024;
            E.gsn = st == 1 ? MODV + (size_t)(l * 5) * 9216 + 4 * 1024 : (st == 5 ? MODV + (size_t)(l * 5) * 9216 + 7 * 1024 : (lastl ? (const float*)nullptr : MODV + (size_t)(5) * 9216 + 1 * 1024));
            E.ap = AP; E.rsq = RSQ;
            pg8::Gemm g{st == 5 ? YB : HID, (const bf16_t*)(WL + (st == 1 ? LW_WOUT1 : (st == 5 ? LW_WOUTM : LW_WOUT2))), MT, 1024, st == 5 ? 1024 : 2816};
            const int cpn = (st != 1 && lastl) ? 0 : 4; const int ks = (st != 5 && cpn) ? 11 : 1;
            E.part = (float*)(P.ws + OFF_Y);
            pg8::Order2 S; S.init(4, cpn, G, c, ks);
            E.vtab = (const LAS float*)(lds + VEC_OFF);
            fill_tabs<2>(lds, S, nullptr, E.gate, E.gsn);
            pg8::gemm_phase<EpiResid, pg8::Order2>(lds, g, S, E);
            if (ks > 1) {
                xcd_barrier(xb);
                const int tw = opaque_tid(), wv = tw >> 6, ln = tw & 63;
                for (int r = c * 8 + wv; r < NCTX; r += G * 8) ctx_fix_row(P, r, ln, ks, E.part, E.gate, E.gsn);
            }
        } else if (st == 2) {
            EpiInproj E; E.rtab = (const LAS float*)(lds + RSTD_OFF); E.vtab = (const LAS float*)(lds + VEC_OFF); E.p = HID; E.vst = VST;
            const float* sWp = SW + (size_t)l * 5 * 13312 + 5632;
            pg8::Gemm g{AP, (const bf16_t*)(WL + LW_WINM), MT, 2048, 1024};
            pg8::Order2 S; S.init(8, lastl ? 2 : 8, G, c);
            fill_tabs<3>(lds, S, RSQ, sWp, nullptr);
            pg8::gemm_phase<EpiInproj, pg8::Order2>(lds, g, S, E);
        } else if (st == 3) {
            for (int wgI = c; wgI < 256; wgI += G) scan_group(P, l, wgI, false, true, lds);
            const int nsgu = lastl ? 1024 : 1056;
            for (int it = c; it < nsgu; it += G) sgu_item(P, l, it >> 2, it & 3, lds);
        } else {
            for (int wgI = c; wgI < 256; wgI += G) scan_group(P, l, wgI, true, !lastl, lds);
        }
        xcd_barrier(xb);
    }
    for (int it = c; it < NLAT / 16; it += G) final_item(P, it);
}

extern "C" void kernel_launch(void* const* d_in, const int* in_sizes, int n_in, void* d_out, int out_size, void* d_ws, size_t ws_size, hipStream_t stream) {
    static int grid = 0;
    if (!grid) {
        if (n_in != 26 || ws_size < WS_END + COEF_TAIL_ITEMS * COEF_ITEM) { fprintf(stderr, "kernel_launch: unexpected n_in %d / ws_size %zu (need %zu)\n", n_in, ws_size, (size_t)WS_END); grid = -1; return; }
        int dev = 0, cus = 0, per_cu = 0;
        (void)hipGetDevice(&dev);
        (void)hipDeviceGetAttribute(&cus, hipDeviceAttributeMultiprocessorCount, dev);
        (void)hipFuncSetAttribute((const void*)fwd_mega, hipFuncAttributeMaxDynamicSharedMemorySize, LDS_BYTES);
        (void)hipOccupancyMaxActiveBlocksPerMultiprocessor(&per_cu, (const void*)fwd_mega, 512, LDS_BYTES);
        if (per_cu < 1) { fprintf(stderr, "kernel_launch: occupancy query says %d blocks per CU\n", per_cu); per_cu = 1; }
        grid = cus;
    }
    if (grid < 0) return;
    if (hipMemsetAsync((char*)d_ws + OFF_BAR, 0, BAR_BYTES, stream) != hipSuccess) { fprintf(stderr, "kernel_launch: memset of the barrier words failed\n"); return; }
    Params p{};
    for (int i = 0; i < 26; ++i) p.in[i] = (const float*)d_in[i];
    p.out = (float*)d_out; p.ws = (unsigned char*)d_ws;
    void* args[] = {&p};
    hipError_t e = hipLaunchCooperativeKernel((const void*)fwd_mega, dim3(grid), dim3(512), args, LDS_BYTES, stream);
    if (e != hipSuccess) fprintf(stderr, "cooperative launch failed: %s (grid %d)\n", hipGetErrorString(e), grid);
}
```

```cpp
#include <hip/hip_runtime.h>
#include <hip/hip_cooperative_groups.h>
#include <cstdio>
#include <cstdint>
namespace cg = cooperative_groups;

#define LAS __attribute__((address_space(3)))
typedef unsigned short bf16_t;
typedef short bf16x8 __attribute__((ext_vector_type(8)));
typedef float f32x4 __attribute__((ext_vector_type(4)));
typedef float f32x2 __attribute__((ext_vector_type(2)));
typedef unsigned u32x4 __attribute__((ext_vector_type(4)));
typedef unsigned u32x2 __attribute__((ext_vector_type(2)));

__device__ __forceinline__ int opaque_tid() { int t = threadIdx.x; asm volatile("" : "+v"(t)); return t; }

namespace pg8 {
constexpr int BM = 256, BK = 64, HALF = 128, HTB = HALF * BK * 2, STAGE_BYTES = 8 * HTB, NXCD = 8, WGM = 4;
__host__ __device__ __forceinline__ int lds_byte(int r, int c) { const int st = (r >> 4) * 2 + (c >> 5), rr = r & 15, cc = c & 31, ob = rr * 64 + cc * 2; return st * 1024 + (ob ^ (((ob >> 9) & 1) << 5)); }
__host__ __device__ __forceinline__ void stage_rc(int b, int& R, int& C) { const int st = b / 1024, sb = b % 1024, swz = sb ^ (((sb >> 9) & 1) << 5); R = (st >> 1) * 16 + swz / 64; C = (st & 1) * 32 + (swz % 64) / 2; }
__host__ __device__ __forceinline__ int perm32(int rho) { const int n = rho >> 4, i = rho & 15; return 8 * (i >> 2) + 4 * n + (i & 3); }
struct Unit { int pm, pn, kc, ui; };
struct Gemm { const bf16_t* A; const bf16_t* Bt; int M, N, K; };

struct Order2 {
    int nN, nlat, cpn, total, G, c, ks;
    __device__ __forceinline__ void init(int nN_, int cpn_, int G_, int c_, int ks_ = 1) { nN = nN_; nlat = 128 * nN_; cpn = cpn_; ks = ks_; total = nlat + 4 * cpn_ * ks_; G = G_; c = c_; }
    __device__ __forceinline__ bool next(int i, Unit& u) const {
        const long L = (long)i * G + c; if (L >= total) return false;
        int pm, pn, kc = -1;
        if (L >= nlat) { int r = (int)L - nlat; if (ks > 1) { kc = r % ks; r /= ks; } pm = 128 + r / cpn; pn = r % cpn; }
        else { int wgid = (int)L; { const int q = nlat / NXCD, xcd = wgid % NXCD, off = wgid / NXCD; wgid = xcd * q + off; }
            const int nig = WGM * nN, gid = wgid / nig, fm = gid * WGM; pm = fm + ((wgid % nig) % WGM); pn = (wgid % nig) / WGM; }
        u.pm = pm; u.pn = pn; u.kc = kc; u.ui = i; return true;
    }
    __device__ __forceinline__ void a_ready(const Unit&) const {}
    __device__ __forceinline__ void done(const Unit&) const {}
};

template <class Epi, class Sched>
__device__ __forceinline__ void gemm_phase(LAS unsigned char* lds, const Gemm g, const Sched& S, const Epi& E) {
    const int tid = opaque_tid(), wid = __builtin_amdgcn_readfirstlane(tid >> 6), lane = tid & 63, wr = wid >> 2, wc = wid & 3, fr = lane & 15, fq = lane >> 4;
    const int K = g.K, ntf = K / BK, nts = S.ks > 1 ? ntf / S.ks : ntf;
    unsigned voffA[2], voffB[2];
#pragma unroll
    for (int i = 0; i < 2; ++i) { int R, C; stage_rc(tid * 16 + i * 8192, R, C); const int Rb = Epi::PERM ? ((R & ~31) + perm32(R & 31)) : R;
        voffA[i] = (unsigned)(R * K + C) * 2u; voffB[i] = (unsigned)(Rb * K + C) * 2u; }
    const size_t kstep = (size_t)(BK * 2);
    const size_t hstep = (size_t)HALF * K * 2;
    const size_t tstep = 2 * hstep;
    const unsigned ldsw = (unsigned)wid * 1024u;
    const int aoff = lds_byte(wr * 64 + fr, fq * 8), boff = lds_byte(wc * 32 + fr, fq * 8);
#define PG8_SA(b, h) (((b) * 2 + (h)) * HTB)
#define PG8_SB(b, h) ((4 + (b) * 2 + (h)) * HTB)
#define PG8_STAGE(bufoff, gbase, voff) do { _Pragma("unroll") for (int _i = 0; _i < 2; ++_i) \
        __builtin_amdgcn_global_load_lds((const unsigned*)((const char*)(gbase) + (voff)[_i]), (LAS unsigned*)(lds + (bufoff) + ldsw + _i * 8192), 16, 0, 0); } while (0)
#define PG8_LDA(dst, b, h) do { _Pragma("unroll") for (int m = 0; m < 4; ++m) _Pragma("unroll") for (int k = 0; k < 2; ++k) dst[m][k] = *(const LAS bf16x8*)(lds + PG8_SA(b, h) + aoff + m * 2048 + k * 1024); } while (0)
#define PG8_LDB(dst, b, h) do { _Pragma("unroll") for (int n = 0; n < 2; ++n) _Pragma("unroll") for (int k = 0; k < 2; ++k) dst[n][k] = *(const LAS bf16x8*)(lds + PG8_SB(b, h) + boff + n * 2048 + k * 1024); } while (0)
#define PG8_MMA(ai, bj, At, Bt) do { __builtin_amdgcn_s_setprio(1); _Pragma("unroll") for (int m = 0; m < 4; ++m) _Pragma("unroll") for (int n = 0; n < 2; ++n) _Pragma("unroll") for (int k = 0; k < 2; ++k) \
        acc[ai][bj][m][n] = __builtin_amdgcn_mfma_f32_16x16x32_bf16(Bt[n][k], At[m][k], acc[ai][bj][m][n], 0, 0, 0); __builtin_amdgcn_s_setprio(0); } while (0)
#define PG8_WAIT_V(n) asm volatile("s_waitcnt vmcnt(" #n ")" ::: "memory")
#define PG8_WAIT_L(n) asm volatile("s_waitcnt lgkmcnt(" #n ")" ::: "memory")
#define PG8_BAR __builtin_amdgcn_s_barrier()
#define PG8_SCHED __builtin_amdgcn_sched_barrier(0)
    Unit cur, nxt; int ui = 0;
    if (!S.next(0, cur)) return;
    f32x4 acc[2][2][4][2];
#pragma unroll
    for (int a = 0; a < 2; ++a)
#pragma unroll
        for (int b = 0; b < 2; ++b)
#pragma unroll
            for (int m = 0; m < 4; ++m)
#pragma unroll
                for (int n = 0; n < 2; ++n) acc[a][b][m][n] = (f32x4){0.f, 0.f, 0.f, 0.f};
    bf16x8 At[4][2], B0[2][2], B1[2][2];
    const char* cA = (const char*)g.A + (size_t)cur.pm * tstep + (cur.kc > 0 ? (size_t)cur.kc * nts * kstep : 0); const char* cB = (const char*)g.Bt + (size_t)cur.pn * tstep + (cur.kc > 0 ? (size_t)cur.kc * nts * kstep : 0);
    S.a_ready(cur);
    PG8_STAGE(PG8_SB(0, 0), cB, voffB); PG8_STAGE(PG8_SB(0, 1), cB + hstep, voffB); PG8_STAGE(PG8_SA(0, 0), cA, voffA); PG8_STAGE(PG8_SA(0, 1), cA + hstep, voffA);
    if (wr == 1) PG8_BAR;
    PG8_WAIT_V(2); PG8_BAR;
    PG8_STAGE(PG8_SB(1, 0), cB + kstep, voffB); PG8_STAGE(PG8_SA(1, 0), cA + kstep, voffA); PG8_STAGE(PG8_SB(1, 1), cB + hstep + kstep, voffB);
    PG8_WAIT_V(6); PG8_BAR;
    for (;;) {
        const bool has_next = S.next(ui + 1, nxt);
        const size_t nko = (has_next && nxt.kc > 0) ? (size_t)nxt.kc * nts * kstep : 0;
        const char* nA = has_next ? (const char*)g.A + (size_t)nxt.pm * tstep + nko : cA; const char* nB = has_next ? (const char*)g.Bt + (size_t)nxt.pn * tstep + nko : cB;
        const int nt = cur.kc >= 0 ? nts : ntf;
        for (int t = 0; t < nt; t += 2) {
            const bool last = (t == nt - 2);
            const char* a1 = cA + (size_t)(t + 1) * kstep;
            const char* a2 = last ? nA : cA + (size_t)(t + 2) * kstep; const char* b2 = last ? nB : cB + (size_t)(t + 2) * kstep;
            const char* a3 = a2 + kstep; const char* b3 = b2 + kstep;
            PG8_LDB(B0, 0, 0); PG8_LDB(B1, 0, 1); PG8_SCHED; PG8_LDA(At, 0, 0); PG8_STAGE(PG8_SA(1, 1), a1 + hstep, voffA);
            PG8_WAIT_V(8); PG8_WAIT_L(0); PG8_BAR; PG8_MMA(0, 0, At, B0); PG8_MMA(0, 1, At, B1); PG8_BAR; PG8_SCHED;
            PG8_LDA(At, 0, 1); PG8_STAGE(PG8_SB(0, 0), b2, voffB); PG8_STAGE(PG8_SB(0, 1), b2 + hstep, voffB); PG8_STAGE(PG8_SA(0, 0), a2, voffA);
            PG8_WAIT_V(8); PG8_WAIT_L(0); PG8_BAR; PG8_MMA(1, 0, At, B0); PG8_MMA(1, 1, At, B1); PG8_BAR; PG8_SCHED;
            PG8_LDB(B0, 1, 0); PG8_LDB(B1, 1, 1); PG8_SCHED; PG8_LDA(At, 1, 0); PG8_STAGE(PG8_SA(0, 1), a2 + hstep, voffA);
            PG8_WAIT_V(8); PG8_WAIT_L(0); PG8_BAR; PG8_MMA(0, 0, At, B0); PG8_MMA(0, 1, At, B1); PG8_BAR; PG8_SCHED;
            PG8_LDA(At, 1, 1); PG8_STAGE(PG8_SB(1, 0), b3, voffB); PG8_STAGE(PG8_SB(1, 1), b3 + hstep, voffB); PG8_STAGE(PG8_SA(1, 0), a3, voffA);
            PG8_WAIT_V(8); PG8_WAIT_L(0); PG8_BAR; PG8_MMA(1, 0, At, B0); PG8_MMA(1, 1, At, B1); PG8_BAR; PG8_SCHED;
        }
        if (wr == 0) PG8_BAR;
        E(acc, cur, wr, wc, fr, fq);
        if (!has_next) break;
#pragma unroll
        for (int a = 0; a < 2; ++a)
#pragma unroll
            for (int b = 0; b < 2; ++b)
#pragma unroll
                for (int m = 0; m < 4; ++m)
#pragma unroll
                    for (int n = 0; n < 2; ++n) acc[a][b][m][n] = (f32x4){0.f, 0.f, 0.f, 0.f};
        cur = nxt; cA = nA; cB = nB; ++ui;
        if (wr == 1) PG8_BAR;
    }
    PG8_WAIT_V(0);
    PG8_BAR;
#undef PG8_SA
#undef PG8_SB
#undef PG8_STAGE
#undef PG8_LDA
#undef PG8_LDB
#undef PG8_MMA
#undef PG8_WAIT_V
#undef PG8_WAIT_L
#undef PG8_BAR
#undef PG8_SCHED
}
}

constexpr int D = 1024, NB = 4, SEQ = 8192, CTXL = 256, DFF = 2816, NLAT = NB * SEQ, NCTX = NB * CTXL, MT = NLAT + NCTX;
constexpr float EPS = 1e-6f;
constexpr size_t OFF_HB = 0;
constexpr size_t OFF_AP = OFF_HB + (size_t)MT * D * 2;
constexpr size_t OFF_Y = OFF_AP + (size_t)MT * D * 2;
constexpr size_t OFF_HID = OFF_Y + (size_t)MT * D * 2;
constexpr size_t OFF_W = OFF_HID + (size_t)MT * DFF * 2;
constexpr size_t LW_WIN1 = 0, LW_WOUT1 = 11534336, LW_WINM = 17301504, LW_WOUTM = 21495808, LW_WIN2 = 23592960, LW_WOUT2 = 35127296, LW_TOTAL = 40894464;
constexpr size_t OFF_WG = OFF_W + 2 * LW_TOTAL;
constexpr size_t OFF_SGW = OFF_WG + 524288;
constexpr size_t OFF_MODV = OFF_SGW + 262144;
constexpr size_t OFF_SW = OFF_MODV + 368640;
constexpr size_t OFF_RSQ = OFF_SW + 532480;
constexpr size_t OFF_VST = OFF_RSQ + (size_t)MT * 16 * 4;
constexpr size_t OFF_SUM = OFF_VST + (size_t)MT * 16 * 4;
constexpr size_t OFF_BAR = OFF_SUM + (size_t)264 * 2048 * 4;
constexpr size_t BAR_BYTES = 16384;
constexpr size_t WS_END = OFF_BAR + BAR_BYTES;
constexpr int RSTD_OFF = 131072 + 16;
constexpr int VEC_OFF = RSTD_OFF + 12 * 256 * 4;
constexpr int LDS_BYTES = VEC_OFF + 12288;

struct Params { const float* in[26]; float* out; unsigned char* ws; };
enum { I_X = 0, I_C, I_CTX, I_CCTX, I_WADA, I_BADA, I_G1, I_W1IN, I_W1OUT, I_GMIX, I_WINM, I_CONVW, I_CONVB, I_WR, I_BR, I_WI, I_BI, I_LAM, I_SGN, I_SGW, I_SGB, I_WOUTM, I_G2, I_W2IN, I_W2OUT, I_GF };

__device__ __forceinline__ unsigned pk2(float lo, float hi) { unsigned r; asm("v_cvt_pk_bf16_f32 %0, %1, %2" : "=v"(r) : "v"(lo), "v"(hi)); return r; }
__device__ __forceinline__ float bflo(unsigned w) { return __uint_as_float(w << 16); }
__device__ __forceinline__ float bfhi(unsigned w) { return __uint_as_float(w & 0xffff0000u); }
__device__ __forceinline__ float sigmoidf_(float v) { return __builtin_amdgcn_rcpf(1.0f + __expf(-v)); }

__device__ __forceinline__ void rows_rstd(const LAS float* tab, int ui, int rl0, float (&rstd)[2][4]) {
#pragma unroll
    for (int ai = 0; ai < 2; ++ai)
#pragma unroll
        for (int m = 0; m < 4; ++m) rstd[ai][m] = tab[ui * 256 + rl0 + ai * 128 + m * 16];
}
template <int MODE, class Sched> __device__ __forceinline__ void fill_tabs(LAS unsigned char* lds, const Sched& S, const float* rsq, const float* v0, const float* v1) {
    const int tid = opaque_tid(); LAS float* tab = (LAS float*)(lds + RSTD_OFF); LAS float* vec = (LAS float*)(lds + VEC_OFF);
    for (int i = 0; i < 12; ++i) { pg8::Unit u; if (!S.next(i, u)) break;
        const int s = u.pm < 128 ? (u.pm >> 5) : 4;
        if (MODE != 2) {
            if (tid < 256) { const float* p = rsq + ((size_t)u.pm * 256 + tid) * 16; float t = 0.f;
#pragma unroll
                for (int j = 0; j < 4; ++j) { const f32x4 v = *(const f32x4*)(p + 4 * j); t += (v.x + v.y) + (v.z + v.w); }
                tab[i * 256 + tid] = rsqrtf(t * (1.0f / 1024.0f) + EPS); }
            else { const int t = tid - 256;
                vec[i * 256 + t] = MODE == 1 ? v0[s * 13312 + (t < 128 ? u.pn * 128 + t : 2816 + u.pn * 128 + (t - 128))] : v0[s * 13312 + u.pn * 256 + t]; }
        } else if (u.kc < 0 && i < 6) {
            vec[i * 512 + tid] = tid < 256 ? v0[s * 9216 + u.pn * 256 + tid] : (v1 ? v1[s * 9216 + u.pn * 256 + tid - 256] : 0.f);
        }
    }
    __syncthreads();
}
struct EpiSwiglu {
    static constexpr bool PERM = true;
    const LAS float* rtab; const LAS float* vtab; bf16_t* hid;
    __device__ __forceinline__ void operator()(const f32x4 (&acc)[2][2][4][2], const pg8::Unit& u, int wr, int wc, int fr_, int fq_) const {
        int fr = fr_, fq = fq_; asm volatile("" : "+v"(fr), "+v"(fq));
        const int s = u.pm < 128 ? (u.pm >> 5) : 4;
        const int row0 = u.pm * 256 + wr * 64 + fr, jc = u.pn * 128 + wc * 32 + fq * 8;
        const LAS float* swp = vtab + u.ui * 256 + wc * 32 + fq * 8;
        const f32x4 g0 = *(const LAS f32x4*)swp, g1 = *(const LAS f32x4*)(swp + 4), u0 = *(const LAS f32x4*)(swp + 128), u1 = *(const LAS f32x4*)(swp + 132);
        float rs[2][4]; rows_rstd(rtab, u.ui, wr * 64 + fr, rs);
#pragma unroll
        for (int ai = 0; ai < 2; ++ai)
#pragma unroll
            for (int m = 0; m < 4; ++m) {
                const int row = row0 + ai * 128 + m * 16; const float rstd = rs[ai][m];
                f32x4 g[2], up[2], e[2];
                g[0] = acc[ai][0][m][0] * rstd + g0; g[1] = acc[ai][0][m][1] * rstd + g1; up[0] = acc[ai][1][m][0] * rstd + u0; up[1] = acc[ai][1][m][1] * rstd + u1;
#pragma unroll
                for (int h = 0; h < 2; ++h) { const f32x4 t = g[h] * -1.4426950408889634f;
                    e[h] = (f32x4){__builtin_amdgcn_exp2f(t.x), __builtin_amdgcn_exp2f(t.y), __builtin_amdgcn_exp2f(t.z), __builtin_amdgcn_exp2f(t.w)}; }
#pragma unroll
                for (int h = 0; h < 2; ++h) { const f32x4 d = e[h] + 1.0f;
                    e[h] = (f32x4){__builtin_amdgcn_rcpf(d.x), __builtin_amdgcn_rcpf(d.y), __builtin_amdgcn_rcpf(d.z), __builtin_amdgcn_rcpf(d.w)}; }
#pragma unroll
                for (int h = 0; h < 2; ++h) g[h] = (g[h] * up[h]) * e[h];
                u32x4 w; w.x = pk2(g[0].x, g[0].y); w.y = pk2(g[0].z, g[0].w); w.z = pk2(g[1].x, g[1].y); w.w = pk2(g[1].z, g[1].w);
                __builtin_nontemporal_store(w, (u32x4*)(hid + (size_t)row * DFF + jc));
            }
    }
};
struct EpiResid {
    static constexpr bool PERM = true;
    bf16_t* hb; const float* gate; const float* gsn; const LAS float* vtab; bf16_t* ap; float* rsq; float* part;
    __device__ __forceinline__ void operator()(const f32x4 (&acc)[2][2][4][2], const pg8::Unit& u, int wr, int wc, int fr_, int fq_) const {
        int fr = fr_, fq = fq_; asm volatile("" : "+v"(fr), "+v"(fq));
        const int cb0 = u.pn * 256 + wc * 32 + fq * 8;
        if (u.kc >= 0) {
            float* pp = part + ((size_t)u.kc * NCTX + (size_t)(u.pm - 128) * 256 + wr * 64 + fr) * D + cb0;
#pragma unroll
            for (int ai = 0; ai < 2; ++ai)
#pragma unroll
                for (int m = 0; m < 4; ++m)
#pragma unroll
                    for (int bj = 0; bj < 2; ++bj) { float* q = pp + (size_t)(ai * 128 + m * 16) * D + bj * 128; *(f32x4*)q = acc[ai][bj][m][0]; *(f32x4*)(q + 4) = acc[ai][bj][m][1]; }
            return;
        }
        const int s = u.pm < 128 ? (u.pm >> 5) : 4;
        f32x4 gt[2][2], gn[2][2];
#pragma unroll
        for (int bj = 0; bj < 2; ++bj) { const LAS float* gp = vtab + u.ui * 512 + bj * 128 + wc * 32 + fq * 8; gt[bj][0] = *(const LAS f32x4*)gp; gt[bj][1] = *(const LAS f32x4*)(gp + 4);
            gn[bj][0] = *(const LAS f32x4*)(gp + 256); gn[bj][1] = *(const LAS f32x4*)(gp + 260); }
        bf16_t* hbase = hb + ((size_t)u.pm * 256 + wr * 64 + fr) * D + cb0;
        u32x4 hv[2][2];
#pragma unroll
        for (int bj = 0; bj < 2; ++bj) hv[0][bj] = *(const u32x4*)(hbase + bj * 128);
#pragma unroll
        for (int it = 0; it < 8; ++it) {
            const int ai = it >> 2, m = it & 3;
            const size_t roff = (size_t)(ai * 128 + m * 16) * D; const size_t grow = (size_t)u.pm * 256 + ai * 128 + wr * 64 + m * 16 + fr;
            if (it < 7) { const size_t rn = (size_t)(((it + 1) >> 2) * 128 + ((it + 1) & 3) * 16) * D;
#pragma unroll
                for (int bj = 0; bj < 2; ++bj) hv[(it + 1) & 1][bj] = *(const u32x4*)(hbase + rn + bj * 128); }
            float sq = 0.f;
#pragma unroll
            for (int bj = 0; bj < 2; ++bj) {
                const u32x4 r = hv[it & 1][bj];
                const f32x4 o0 = (f32x4){bflo(r.x), bfhi(r.x), bflo(r.y), bfhi(r.y)}, o1 = (f32x4){bflo(r.z), bfhi(r.z), bflo(r.w), bfhi(r.w)};
                const f32x4 n0 = o0 + gt[bj][0] * acc[ai][bj][m][0], n1 = o1 + gt[bj][1] * acc[ai][bj][m][1];
                u32x4 hw; hw.x = pk2(n0.x, n0.y); hw.y = pk2(n0.z, n0.w); hw.z = pk2(n1.x, n1.y); hw.w = pk2(n1.z, n1.w);
                *(u32x4*)(hbase + roff + bj * 128) = hw;
                sq += (n0.x * n0.x + n0.y * n0.y) + (n0.z * n0.z + n0.w * n0.w) + (n1.x * n1.x + n1.y * n1.y) + (n1.z * n1.z + n1.w * n1.w);
                if (gsn) { const f32x4 a0 = n0 * gn[bj][0], a1 = n1 * gn[bj][1]; u32x4 w; w.x = pk2(a0.x, a0.y); w.y = pk2(a0.z, a0.w); w.z = pk2(a1.x, a1.y); w.w = pk2(a1.z, a1.w);
                    *(u32x4*)(ap + grow * D + cb0 + bj * 128) = w; }
            }
            sq += __shfl_xor(sq, 16); sq += __shfl_xor(sq, 32);
            if (fq == 0) rsq[grow * 16 + u.pn * 4 + wc] = sq;
        }
    }
};
struct EpiInproj {
    static constexpr bool PERM = true;
    const LAS float* rtab; const LAS float* vtab; bf16_t* p; float* vst;
    __device__ __forceinline__ void operator()(const f32x4 (&acc)[2][2][4][2], const pg8::Unit& u, int wr, int wc, int fr_, int fq_) const {
        int fr = fr_, fq = fq_; asm volatile("" : "+v"(fr), "+v"(fq));
        const int s = u.pm < 128 ? (u.pm >> 5) : 4;
        const int row0 = u.pm * 256 + wr * 64 + fr, cb0 = u.pn * 256 + wc * 32 + fq * 8;
        f32x4 sw[2][2];
#pragma unroll
        for (int bj = 0; bj < 2; ++bj) { const LAS float* sp = vtab + u.ui * 256 + bj * 128 + wc * 32 + fq * 8; sw[bj][0] = *(const LAS f32x4*)sp; sw[bj][1] = *(const LAS f32x4*)(sp + 4); }
        const bool isv = u.pn >= 6;
        float rs[2][4]; rows_rstd(rtab, u.ui, wr * 64 + fr, rs);
#pragma unroll
        for (int ai = 0; ai < 2; ++ai)
#pragma unroll
            for (int m = 0; m < 4; ++m) {
                const int row = row0 + ai * 128 + m * 16; const float rstd = rs[ai][m];
                float sm = 0.f, sq = 0.f;
#pragma unroll
                for (int bj = 0; bj < 2; ++bj) {
                    const f32x4 v0 = acc[ai][bj][m][0] * rstd + sw[bj][0], v1 = acc[ai][bj][m][1] * rstd + sw[bj][1];
                    u32x4 w; w.x = pk2(v0.x, v0.y); w.y = pk2(v0.z, v0.w); w.z = pk2(v1.x, v1.y); w.w = pk2(v1.z, v1.w);
                    __builtin_nontemporal_store(w, (u32x4*)(p + (size_t)row * 2048 + cb0 + bj * 128));
                    sm += (v0.x + v0.y) + (v0.z + v0.w) + (v1.x + v1.y) + (v1.z + v1.w);
                    sq += (v0.x * v0.x + v0.y * v0.y) + (v0.z * v0.z + v0.w * v0.w) + (v1.x * v1.x + v1.y * v1.y) + (v1.z * v1.z + v1.w * v1.w);
                }
                if (isv) { sm += __shfl_xor(sm, 16); sm += __shfl_xor(sm, 32); sq += __shfl_xor(sq, 16); sq += __shfl_xor(sq, 32);
                    if (fq == 0) { float* vp = vst + (size_t)row * 16 + ((u.pn - 6) * 4 + wc) * 2; vp[0] = sm; vp[1] = sq; } }
            }
    }
};

__device__ __forceinline__ void gemv5_partial(const float* __restrict__ W, int ldw, int col, int k0, const LAS float* vin, float (&acc)[5]) {
#pragma unroll
    for (int s = 0; s < 5; ++s) acc[s] = 0.f;
#pragma unroll 32
    for (int k = k0; k < k0 + 128; ++k) { const float w = W[(size_t)k * ldw + col];
#pragma unroll
        for (int s = 0; s < 5; ++s) acc[s] += vin[s * 1024 + k] * w; }
}
__device__ __forceinline__ void adaln_item(const Params& P, int it, LAS unsigned char* lds) {
    const int tid = opaque_tid(), w = tid >> 6, lane = tid & 63;
    LAS float* vin = (LAS float*)lds; LAS float* red = (LAS float*)(lds + 20480);
    const int l = it / 144, c0 = (it % 144) * 64;
    for (int idx = tid; idx < 5120; idx += 512) { const int s = idx >> 10, k = idx & 1023; const float cv = s < 4 ? P.in[I_C][s * 1024 + k] : P.in[I_CCTX][k]; vin[idx] = cv / (1.0f + __expf(-cv)); }
    __syncthreads();
    float acc[5]; gemv5_partial(P.in[I_WADA] + (size_t)l * 1024 * 9216, 9216, c0 + lane, w * 128, vin, acc);
#pragma unroll
    for (int s = 0; s < 5; ++s) red[(w * 5 + s) * 64 + lane] = acc[s];
    __syncthreads();
    if (tid < 320) { const int s = tid >> 6; float m = 0.f;
#pragma unroll
        for (int v = 0; v < 8; ++v) m += red[(v * 5 + s) * 64 + lane];
        const int n = c0 + lane, chunk = n >> 10, k = n & 1023; m += P.in[I_BADA][l * 9216 + n];
        float val = m;
        if (chunk == 1) val = P.in[I_G1][l * 1024 + k] * (1.0f + m); else if (chunk == 4) val = P.in[I_GMIX][l * 1024 + k] * (1.0f + m); else if (chunk == 7) val = P.in[I_G2][l * 1024 + k] * (1.0f + m);
        else if (chunk == 2 || chunk == 8) val = 0.5f * m;
        ((float*)(P.ws + OFF_MODV))[((l * 5 + s) * 9 + chunk) * 1024 + k] = val; }
    __syncthreads();
}
__device__ __forceinline__ void shiftw_item(const Params& P, int it, LAS unsigned char* lds) {
    const int tid = opaque_tid(), w = tid >> 6, lane = tid & 63;
    LAS float* vin = (LAS float*)lds; LAS float* red = (LAS float*)(lds + 20480);
    const int l = it / 208; int r = it % 208; const float* W; int ldw, c0, off, chunk;
    if (r < 88) { W = P.in[I_W1IN] + (size_t)l * 1024 * 5632; ldw = 5632; c0 = r * 64; off = 0; chunk = 0; }
    else if (r < 120) { W = P.in[I_WINM] + (size_t)l * 1024 * 2048; ldw = 2048; c0 = (r - 88) * 64; off = 5632; chunk = 3; }
    else { W = P.in[I_W2IN] + (size_t)l * 1024 * 5632; ldw = 5632; c0 = (r - 120) * 64; off = 7680; chunk = 6; }
    const float* modv = (const float*)(P.ws + OFF_MODV);
    for (int idx = tid; idx < 5120; idx += 512) { const int s = idx >> 10, k = idx & 1023; vin[idx] = modv[((l * 5 + s) * 9 + chunk) * 1024 + k]; }
    __syncthreads();
    float acc[5]; gemv5_partial(W, ldw, c0 + lane, w * 128, vin, acc);
#pragma unroll
    for (int s = 0; s < 5; ++s) red[(w * 5 + s) * 64 + lane] = acc[s];
    __syncthreads();
    if (tid < 320) { const int s = tid >> 6; float m = 0.f;
#pragma unroll
        for (int v = 0; v < 8; ++v) m += red[(v * 5 + s) * 64 + lane];
        ((float*)(P.ws + OFF_SW))[(l * 5 + s) * 13312 + off + c0 + lane] = m; }
    __syncthreads();
}
__device__ __forceinline__ void transpose_item(const Params& P, int it, LAS float* scr, int lane) {
    const int l = it / 9984; int r = it % 9984; const float* W; int K, N; size_t dst; bool perm = false;
    if (r < 2816) { W = P.in[I_W1IN] + (size_t)l * 1024 * 5632; K = 1024; N = 5632; dst = LW_WIN1; perm = true; }
    else if ((r -= 2816) < 1408) { W = P.in[I_W1OUT] + (size_t)l * 2816 * 1024; K = 2816; N = 1024; dst = LW_WOUT1; }
    else if ((r -= 1408) < 1024) { W = P.in[I_WINM] + (size_t)l * 1024 * 2048; K = 1024; N = 2048; dst = LW_WINM; }
    else if ((r -= 1024) < 512) { W = P.in[I_WOUTM] + (size_t)l * 1024 * 1024; K = 1024; N = 1024; dst = LW_WOUTM; }
    else if ((r -= 512) < 2816) { W = P.in[I_W2IN] + (size_t)l * 1024 * 5632; K = 1024; N = 5632; dst = LW_WIN2; perm = true; }
    else { r -= 2816; W = P.in[I_W2OUT] + (size_t)l * 2816 * 1024; K = 2816; N = 1024; dst = LW_WOUT2; }
    const int ntn = N / 32, k0 = (r / ntn) * 64, n0 = (r % ntn) * 32;
    const int r0 = perm ? (((n0 % 2816) / 128) * 256 + (n0 / 2816) * 128 + (n0 % 128)) : n0;
    bf16_t* Bt = (bf16_t*)(P.ws + OFF_W + (size_t)l * LW_TOTAL + dst);
    float v[32];
#pragma unroll
    for (int i = 0; i < 32; ++i) { const int kk = 2 * i + (lane >> 5); v[i] = W[(size_t)(k0 + kk) * N + n0 + (lane & 31)]; }
#pragma unroll
    for (int i = 0; i < 32; ++i) { const int kk = 2 * i + (lane >> 5); scr[kk * 33 + (lane & 31)] = v[i]; }
    asm volatile("s_waitcnt lgkmcnt(0)" ::: "memory");
    const int c = lane & 7;
#pragma unroll
    for (int j = 0; j < 4; ++j) { const int n = (lane >> 3) + 8 * j; const LAS float* t = scr + (8 * c) * 33 + n;
        u32x4 o; o.x = pk2(t[0], t[33]); o.y = pk2(t[66], t[99]); o.z = pk2(t[132], t[165]); o.w = pk2(t[198], t[231]);
        *(u32x4*)(Bt + (size_t)(r0 + n) * K + k0 + 8 * c) = o; }
    asm volatile("s_waitcnt lgkmcnt(0)" ::: "memory");
}
__device__ __forceinline__ void prep_item2(const Params& P, int rowA, int rowB, bool hasB, int lane) {
    const int rows[2] = {rowA, hasB ? rowB : rowA};
    f32x4 v[2][4], g[2][4];
#pragma unroll
    for (int q = 0; q < 2; ++q) { const int row = rows[q]; const int s = row < NLAT ? (row >> 13) : 4;
        const float* src = row < NLAT ? P.in[I_X] + (size_t)row * D : P.in[I_CTX] + (size_t)(row - NLAT) * D;
        const float* gs = (const float*)(P.ws + OFF_MODV) + ((0 * 5 + s) * 9 + 1) * 1024;
#pragma unroll
        for (int j = 0; j < 4; ++j) { const int c = (lane + 64 * j) * 4; v[q][j] = *(const f32x4*)(src + c); g[q][j] = *(const f32x4*)(gs + c); } }
#pragma unroll
    for (int q = 0; q < 2; ++q) { if (q == 1 && !hasB) break; const int row = rows[q];
        bf16_t* ap = (bf16_t*)(P.ws + OFF_AP) + (size_t)row * D; bf16_t* hbp = (bf16_t*)(P.ws + OFF_HB) + (size_t)row * D;
        float sq = 0.f;
#pragma unroll
        for (int j = 0; j < 4; ++j) { const int c = (lane + 64 * j) * 4; const f32x4 x = v[q][j], gg = g[q][j];
            sq += (x.x * x.x + x.y * x.y) + (x.z * x.z + x.w * x.w);
            u32x2 o; o.x = pk2(x.x * gg.x, x.y * gg.y); o.y = pk2(x.z * gg.z, x.w * gg.w); *(u32x2*)(ap + c) = o;
            u32x2 hh; hh.x = pk2(x.x, x.y); hh.y = pk2(x.z, x.w); *(u32x2*)(hbp + c) = hh; }
#pragma unroll
        for (int o = 1; o < 64; o <<= 1) sq += __shfl_xor(sq, o);
        if (lane < 16) ((float*)(P.ws + OFF_RSQ))[(size_t)row * 16 + lane] = lane == 0 ? sq : 0.f; }
}
__device__ __forceinline__ void final_item(const Params& P, int it) {
    const int tid = opaque_tid(), w = tid >> 6, lane = tid & 63;
    const float* g = P.in[I_GF];
    u32x2 r[2][4]; f32x4 gg[4]; float t[2];
#pragma unroll
    for (int j = 0; j < 4; ++j) gg[j] = *(const f32x4*)(g + (lane + 64 * j) * 4);
#pragma unroll
    for (int q = 0; q < 2; ++q) { const int row = it * 16 + 2 * w + q;
        t[q] = ((const float*)(P.ws + OFF_RSQ))[(size_t)row * 16 + (lane & 15)];
        const bf16_t* hp = (const bf16_t*)(P.ws + OFF_HB) + (size_t)row * D;
#pragma unroll
        for (int j = 0; j < 4; ++j) r[q][j] = *(const u32x2*)(hp + (lane + 64 * j) * 4); }
#pragma unroll
    for (int q = 0; q < 2; ++q) { const int row = it * 16 + 2 * w + q; float tt = t[q];
        tt += __shfl_xor(tt, 1); tt += __shfl_xor(tt, 2); tt += __shfl_xor(tt, 4); tt += __shfl_xor(tt, 8);
        const float rstd = rsqrtf(tt * (1.0f / 1024.0f) + EPS);
        float* op = P.out + (size_t)row * D;
#pragma unroll
        for (int j = 0; j < 4; ++j) { const int c = (lane + 64 * j) * 4; __builtin_nontemporal_store((f32x4){bflo(r[q][j].x), bfhi(r[q][j].x), bflo(r[q][j].y), bfhi(r[q][j].y)} * rstd * gg[j], (f32x4*)(op + c)); } }
}

__device__ __forceinline__ void ctx_fix_row(const Params& P, int r, int lane, int ks, const float* part, const float* gate, const float* gsn) {
    const int c0 = lane * 16; const size_t grow = (size_t)NLAT + r;
    f32x4 sum[4];
#pragma unroll
    for (int i = 0; i < 4; ++i) sum[i] = (f32x4){0.f, 0.f, 0.f, 0.f};
    for (int k = 0; k < ks; ++k) { const float* pp = part + ((size_t)k * NCTX + r) * D + c0;
#pragma unroll
        for (int i = 0; i < 4; ++i) sum[i] += *(const f32x4*)(pp + 4 * i); }
    bf16_t* hp = (bf16_t*)(P.ws + OFF_HB) + grow * D + c0; bf16_t* ap = (bf16_t*)(P.ws + OFF_AP) + grow * D + c0;
    const u32x4 h0 = *(const u32x4*)hp, h1 = *(const u32x4*)(hp + 8);
    const unsigned hw[8] = {h0.x, h0.y, h0.z, h0.w, h1.x, h1.y, h1.z, h1.w};
    float n[16]; float sq = 0.f;
#pragma unroll
    for (int i = 0; i < 4; ++i) { const f32x4 g = *(const f32x4*)(gate + 4 * 9216 + c0 + 4 * i);
        n[4 * i] = bflo(hw[2 * i]) + g.x * sum[i].x; n[4 * i + 1] = bfhi(hw[2 * i]) + g.y * sum[i].y; n[4 * i + 2] = bflo(hw[2 * i + 1]) + g.z * sum[i].z; n[4 * i + 3] = bfhi(hw[2 * i + 1]) + g.w * sum[i].w; }
#pragma unroll
    for (int i = 0; i < 16; ++i) sq += n[i] * n[i];
    u32x4 o0, o1; o0.x = pk2(n[0], n[1]); o0.y = pk2(n[2], n[3]); o0.z = pk2(n[4], n[5]); o0.w = pk2(n[6], n[7]); o1.x = pk2(n[8], n[9]); o1.y = pk2(n[10], n[11]); o1.z = pk2(n[12], n[13]); o1.w = pk2(n[14], n[15]);
    *(u32x4*)hp = o0; *(u32x4*)(hp + 8) = o1;
    if (gsn) {
#pragma unroll
        for (int i = 0; i < 4; ++i) { const f32x4 g = *(const f32x4*)(gsn + 4 * 9216 + c0 + 4 * i); n[4 * i] *= g.x; n[4 * i + 1] *= g.y; n[4 * i + 2] *= g.z; n[4 * i + 3] *= g.w; }
        o0.x = pk2(n[0], n[1]); o0.y = pk2(n[2], n[3]); o0.z = pk2(n[4], n[5]); o0.w = pk2(n[6], n[7]); o1.x = pk2(n[8], n[9]); o1.y = pk2(n[10], n[11]); o1.z = pk2(n[12], n[13]); o1.w = pk2(n[14], n[15]);
        *(u32x4*)ap = o0; *(u32x4*)(ap + 8) = o1; }
    sq += __shfl_xor(sq, 1); sq += __shfl_xor(sq, 2);
    if ((lane & 3) == 0) ((float*)(P.ws + OFF_RSQ))[grow * 16 + (lane >> 2)] = sq;
}

__device__ __forceinline__ void tile_info(int tix, int& row0, int& pos0, int& L, int& b) {
    if (tix < 256) { b = tix >> 6; pos0 = (tix & 63) * 128; row0 = b * SEQ + pos0; L = SEQ; }
    else { const int c = tix - 256; b = c >> 1; pos0 = (c & 1) * 128; row0 = NLAT + b * CTXL + pos0; L = CTXL; }
}
constexpr int SC_WG_OFF = 0, SC_CW_OFF = 36864, SC_CAR_OFF = 38144, SC_WCOMP_OFF = 42752, SC_XL_OFF = 50944, SC_GL_OFF = 67840, SC_XC_OFF = 84224;
struct ScanPre { u32x4 x[3]; u32x4 g[2]; u32x4 cf[8]; };
constexpr size_t COEF_ITEM = 65536, COEF_TAIL_ITEMS = 264;
__device__ __forceinline__ u32x4* coef_base(const Params& P, int item) {
    const size_t off = item < 1056 ? OFF_AP + (size_t)item * COEF_ITEM : (item < 1848 ? OFF_HID + (size_t)MT * 2048 * 2 + (size_t)(item - 1056) * COEF_ITEM : WS_END + (size_t)(item - 1848) * COEF_ITEM);
    return (u32x4*)(P.ws + off);
}
__device__ __forceinline__ void scan_prefetch(ScanPre& R, const Params& P, const bf16_t* pb, int tix, int h, int tid, bool final_mode) {
    int row0, pos0, L, b; tile_info(tix, row0, pos0, L, b);
    if (!final_mode) {
#pragma unroll
        for (int i = 0; i < 3; ++i) { const int idx = tid + 512 * i, r = idx >> 3, pc = idx & 7, pos = pos0 - 2 + r; R.x[i] = (u32x4){0u, 0u, 0u, 0u};
            if (idx < 131 * 8 && pos >= 0 && pos < L) R.x[i] = *(const u32x4*)(pb + (size_t)(row0 - 2 + r) * 2048 + h * 64 + pc * 8); }
    } else {
#pragma unroll
        for (int i = 0; i < 2; ++i) { const int idx = tid + 512 * i, r = idx >> 3, pc = idx & 7; R.g[i] = *(const u32x4*)(pb + (size_t)(row0 + r) * 2048 + 512 + h * 64 + pc * 8); }
        const u32x4* cb = coef_base(P, tix * 8 + h) + tid;
#pragma unroll
        for (int i = 0; i < 8; ++i) R.cf[i] = cb[i * 512];
    }
}
__device__ __forceinline__ void scan_group(const Params& P, int l, int wgI, bool final_mode, bool with_ctx, LAS unsigned char* lds) {
    const int tid = opaque_tid(), w = __builtin_amdgcn_readfirstlane(tid >> 6), lane = tid & 63, fr = lane & 15, fq = lane >> 4;
    const int h = wgI & 7, grp = wgI >> 3, gb = grp >> 3, j0 = (grp & 7) * 8;
    const int ctix = 256 + (wgI >> 3);
    const bool has_ctx = with_ctx && wgI < 64;
    const bf16_t* pb = (const bf16_t*)(P.ws + OFF_HID);
    float* summ = (float*)(P.ws + OFF_SUM);
    LAS f32x2* wcomp = (LAS f32x2*)(lds + SC_WCOMP_OFF); LAS float* car = (LAS float*)(lds + SC_CAR_OFF); LAS float* cw = (LAS float*)(lds + SC_CW_OFF);
    __syncthreads();
    if (!final_mode) { const bf16_t* wg = (const bf16_t*)(P.ws + OFF_WG);
      for (int idx = tid; idx < 2048; idx += 512) { const int mat = idx >> 9, e = (idx >> 3) & 63, pc = idx & 7;
          *(LAS u32x4*)(lds + SC_WG_OFF + (mat * 64 + e) * 144 + pc * 16) = *(const u32x4*)(wg + ((size_t)((l * 2 + (mat >> 1)) * 2 + (mat & 1)) * 8 + h) * 4096 + e * 64 + pc * 8); }
      if (tid < 320) { const int k = tid >> 6, ch = tid & 63; cw[tid] = k < 4 ? P.in[I_CONVW][(l * 4 + k) * 512 + h * 64 + ch] : P.in[I_CONVB][l * 512 + h * 64 + ch]; } }
    float brv[2][4], biv[2][4], sp8[2][4];
#pragma unroll
    for (int dir = 0; dir < 2; ++dir)
#pragma unroll
        for (int eb = 0; eb < 4; ++eb) { const int pidx = (l * 2 + dir) * 512 + h * 64 + eb * 16 + fr;
            brv[dir][eb] = -1.4426950408889634f * P.in[I_BR][pidx]; biv[dir][eb] = -1.4426950408889634f * P.in[I_BI][pidx]; sp8[dir][eb] = 8.0f * 1.4426950408889634f * log1pf(__expf(-P.in[I_LAM][pidx])); }
    if (final_mode) {
        LAS float* T = (LAS float*)(lds + SC_XL_OFF);
        { float tv[33];
#pragma unroll
          for (int i = 0; i < 33; ++i) { const int idx = tid + 512 * i; const int ch = idx & 63, ab = (idx >> 6) & 1, dir = (idx >> 7) & 1, k = idx >> 8;
              const int t = k < 2 ? 256 + 2 * gb + (dir == 0 ? k : 1 - k) : gb * 64 + (dir == 0 ? (k - 2) : (63 - (k - 2)));
              tv[i] = summ[((size_t)(t * 2 + dir) * 2 + ab) * 512 + h * 64 + ch]; }
#pragma unroll
          for (int i = 0; i < 33; ++i) { const int idx = tid + 512 * i; const int ch = idx & 63, ab = (idx >> 6) & 1, dir = (idx >> 7) & 1, k = idx >> 8;
              T[((dir * 66 + k) * 2 + ab) * 64 + ch] = tv[i]; } }
        __syncthreads();
        if (tid < 128) { const int dir = tid >> 6, ch = tid & 63; float s = 0.f;
#pragma unroll 6
            for (int k = 0; k < 66; ++k) {
                if (k >= 2) { const int i = (dir == 0 ? (k - 2) : (63 - (k - 2))) - j0; if (i >= 0 && i < 8) car[(dir * 9 + i) * 64 + ch] = s; }
                s = T[((dir * 66 + k) * 2 + 0) * 64 + ch] * s + T[((dir * 66 + k) * 2 + 1) * 64 + ch]; }
            float cs = 0.f;
            if (has_ctx) { const int cj = (ctix - 256) & 1; if (dir == 0 && cj == 1) cs = summ[((size_t)((ctix - 1) * 2 + 0) * 2 + 1) * 512 + h * 64 + ch]; if (dir == 1 && cj == 0) cs = summ[((size_t)((ctix + 1) * 2 + 1) * 2 + 1) * 512 + h * 64 + ch]; }
            car[(dir * 9 + 8) * 64 + ch] = cs; }
        __syncthreads();
    }
    const int nitems = 8 + (has_ctx ? 1 : 0);
    ScanPre R; scan_prefetch(R, P, pb, grp * 8, h, tid, final_mode);
#pragma unroll 1
    for (int it = 0; it < nitems; ++it) {
        const int tix = it < 8 ? grp * 8 + it : ctix;
        int row0, pos0, L, b; tile_info(tix, row0, pos0, L, b);
        if (!final_mode) {
#pragma unroll
        for (int i = 0; i < 3; ++i) { const int idx = tid + 512 * i; if (idx < 131 * 8) *(LAS u32x4*)(lds + SC_XL_OFF + (idx >> 3) * 128 + (idx & 7) * 16) = R.x[i]; }
        } else {
#pragma unroll
            for (int i = 0; i < 2; ++i) { const int idx = tid + 512 * i; *(LAS u32x4*)(lds + SC_GL_OFF + (idx >> 3) * 128 + (idx & 7) * 16) = R.g[i]; } }
        __syncthreads();
        if (it + 1 < nitems && !final_mode) scan_prefetch(R, P, pb, it + 1 < 8 ? grp * 8 + it + 1 : ctix, h, tid, final_mode);
        if (!final_mode) { const int q = tid >> 2, c4 = tid & 3; float a[16];
#pragma unroll
          for (int i = 0; i < 4; ++i) { const f32x4 bv = *(const LAS f32x4*)(cw + 256 + c4 * 16 + 4 * i); a[4 * i] = bv.x; a[4 * i + 1] = bv.y; a[4 * i + 2] = bv.z; a[4 * i + 3] = bv.w; }
#pragma unroll
          for (int k = 0; k < 4; ++k) {
              const u32x4 x0 = *(const LAS u32x4*)(lds + SC_XL_OFF + (q + k) * 128 + c4 * 32), x1 = *(const LAS u32x4*)(lds + SC_XL_OFF + (q + k) * 128 + c4 * 32 + 16);
              const unsigned xs[8] = {x0.x, x0.y, x0.z, x0.w, x1.x, x1.y, x1.z, x1.w};
#pragma unroll
              for (int i = 0; i < 4; ++i) { const f32x4 wv = *(const LAS f32x4*)(cw + k * 64 + c4 * 16 + 4 * i);
                  a[4 * i] += wv.x * bflo(xs[2 * i]); a[4 * i + 1] += wv.y * bfhi(xs[2 * i]); a[4 * i + 2] += wv.z * bflo(xs[2 * i + 1]); a[4 * i + 3] += wv.w * bfhi(xs[2 * i + 1]); } }
          LAS float* xo = (LAS float*)(lds + SC_XC_OFF + q * 272 + c4 * 64);
#pragma unroll
          for (int i = 0; i < 4; ++i) *(LAS f32x4*)(xo + 4 * i) = (f32x4){a[4 * i], a[4 * i + 1], a[4 * i + 2], a[4 * i + 3]}; }
        __syncthreads();
        bf16x8 af[2] = {};
        if (!final_mode) {
#pragma unroll
        for (int ks = 0; ks < 2; ++ks) { const LAS float* xr = (const LAS float*)(lds + SC_XC_OFF + (16 * w + fr) * 272) + ks * 32 + fq * 8;
            const f32x4 v0 = *(const LAS f32x4*)xr, v1 = *(const LAS f32x4*)(xr + 4);
            u32x4 t; t.x = pk2(v0.x, v0.y); t.y = pk2(v0.z, v0.w); t.z = pk2(v1.x, v1.y); t.w = pk2(v1.z, v1.w); af[ks] = __builtin_bit_cast(bf16x8, t); }
        }
        float ca[2][4][4], cbv[2][4][4], Ae[2][4], Be[2][4];
#pragma unroll
        for (int dir = 0; dir < 2; ++dir) {
#pragma unroll
            for (int eb = 0; eb < 4; ++eb) {
              if (!final_mode) {
                f32x4 pr = (f32x4){0.f, 0.f, 0.f, 0.f}, pi = pr;
#pragma unroll
                for (int ks = 0; ks < 2; ++ks) {
                    const bf16x8 br = *(const LAS bf16x8*)(lds + SC_WG_OFF + ((dir * 2 + 0) * 64 + eb * 16 + fr) * 144 + ks * 64 + fq * 16);
                    const bf16x8 bi = *(const LAS bf16x8*)(lds + SC_WG_OFF + ((dir * 2 + 1) * 64 + eb * 16 + fr) * 144 + ks * 64 + fq * 16);
                    pr = __builtin_amdgcn_mfma_f32_16x16x32_bf16(af[ks], br, pr, 0, 0, 0);
                    pi = __builtin_amdgcn_mfma_f32_16x16x32_bf16(af[ks], bi, pi, 0, 0, 0);
                }
                float la[4], ig[4], xv[4];
#pragma unroll
                for (int j = 0; j < 4; ++j) {
                    const float r = __builtin_amdgcn_rcpf(1.0f + __builtin_amdgcn_exp2f(pr[j] + brv[dir][eb])); ig[j] = __builtin_amdgcn_rcpf(1.0f + __builtin_amdgcn_exp2f(pi[j] + biv[dir][eb]));
                    xv[j] = *(const LAS float*)(lds + SC_XC_OFF + (16 * w + 4 * fq + j) * 272 + (eb * 16 + fr) * 4);
                    la[j] = -r * sp8[dir][eb]; }
                u32x4 pk; pk.x = pk2(la[0], la[1]); pk.y = pk2(la[2], la[3]);
                la[0] = bflo(pk.x); la[1] = bfhi(pk.x); la[2] = bflo(pk.y); la[3] = bfhi(pk.y);
                float bq[4];
#pragma unroll
                for (int j = 0; j < 4; ++j) { const float av = __builtin_amdgcn_exp2f(la[j]); ca[dir][eb][j] = av;
                    bq[j] = __builtin_amdgcn_sqrtf(__builtin_fmaf(-av, av, 1.0f)) * ig[j] * xv[j]; }
                pk.z = pk2(bq[0], bq[1]); pk.w = pk2(bq[2], bq[3]);
                cbv[dir][eb][0] = bflo(pk.z); cbv[dir][eb][1] = bfhi(pk.z); cbv[dir][eb][2] = bflo(pk.w); cbv[dir][eb][3] = bfhi(pk.w);
                __builtin_nontemporal_store(pk, coef_base(P, tix * 8 + h) + (dir * 4 + eb) * 512 + tid);
              } else {
                const u32x4 pk = R.cf[dir * 4 + eb];
                ca[dir][eb][0] = __builtin_amdgcn_exp2f(bflo(pk.x)); ca[dir][eb][1] = __builtin_amdgcn_exp2f(bfhi(pk.x)); ca[dir][eb][2] = __builtin_amdgcn_exp2f(bflo(pk.y)); ca[dir][eb][3] = __builtin_amdgcn_exp2f(bfhi(pk.y));
                cbv[dir][eb][0] = bflo(pk.z); cbv[dir][eb][1] = bfhi(pk.z); cbv[dir][eb][2] = bflo(pk.w); cbv[dir][eb][3] = bfhi(pk.w);
              }
                float A = 1.f, B = 0.f;
                if (dir == 0) {
#pragma unroll
                    for (int j = 0; j < 4; ++j) { B = ca[dir][eb][j] * B + cbv[dir][eb][j]; A *= ca[dir][eb][j]; }
                    float Ap = __shfl_up(A, 16), Bp = __shfl_up(B, 16); if (fq >= 1) { B = A * Bp + B; A = A * Ap; }
                    Ap = __shfl_up(A, 32); Bp = __shfl_up(B, 32); if (fq >= 2) { B = A * Bp + B; A = A * Ap; }
                    float ae = __shfl_up(A, 16), be = __shfl_up(B, 16); if (fq == 0) { ae = 1.f; be = 0.f; }
                    Ae[dir][eb] = ae; Be[dir][eb] = be;
                    if (fq == 3) wcomp[(0 * 8 + w) * 64 + eb * 16 + fr] = (f32x2){A, B};
                } else {
#pragma unroll
                    for (int j = 3; j >= 0; --j) { B = ca[dir][eb][j] * B + cbv[dir][eb][j]; A *= ca[dir][eb][j]; }
                    float Ap = __shfl_down(A, 16), Bp = __shfl_down(B, 16); if (fq <= 2) { B = A * Bp + B; A = A * Ap; }
                    Ap = __shfl_down(A, 32); Bp = __shfl_down(B, 32); if (fq <= 1) { B = A * Bp + B; A = A * Ap; }
                    float ae = __shfl_down(A, 16), be = __shfl_down(B, 16); if (fq == 3) { ae = 1.f; be = 0.f; }
                    Ae[dir][eb] = ae; Be[dir][eb] = be;
                    if (fq == 0) wcomp[(1 * 8 + w) * 64 + eb * 16 + fr] = (f32x2){A, B};
                }
            }
        }
        if (final_mode && it + 1 < nitems) scan_prefetch(R, P, pb, it + 1 < 8 ? grp * 8 + it + 1 : ctix, h, tid, final_mode);
        __syncthreads();
        if (!final_mode) {
            if (w == 0) {
                float A = 1.f, B = 0.f;
#pragma unroll
                for (int v = 0; v < 8; ++v) { const f32x2 cv = wcomp[(0 * 8 + v) * 64 + lane]; B = cv.x * B + cv.y; A = cv.x * A; }
                float* sp = summ + ((size_t)(tix * 2 + 0) * 2) * 512 + h * 64 + lane; sp[0] = A; sp[512] = B;
                A = 1.f; B = 0.f;
#pragma unroll
                for (int v = 7; v >= 0; --v) { const f32x2 cv = wcomp[(1 * 8 + v) * 64 + lane]; B = cv.x * B + cv.y; A = cv.x * A; }
                sp = summ + ((size_t)(tix * 2 + 1) * 2) * 512 + h * 64 + lane; sp[0] = A; sp[512] = B;
            }
        } else {
#pragma unroll
            for (int eb = 0; eb < 4; ++eb) {
                const int c = eb * 16 + fr;
                float s = car[(0 * 9 + it) * 64 + c];
#pragma unroll
                for (int v = 0; v < 7; ++v) { const f32x2 cv = wcomp[(0 * 8 + v) * 64 + c]; if (v < w) s = cv.x * s + cv.y; }
                s = Ae[0][eb] * s + Be[0][eb];
                float hf[4];
#pragma unroll
                for (int j = 0; j < 4; ++j) { s = ca[0][eb][j] * s + cbv[0][eb][j]; hf[j] = s; }
                s = car[(1 * 9 + it) * 64 + c];
#pragma unroll
                for (int v = 7; v > 0; --v) { const f32x2 cv = wcomp[(1 * 8 + v) * 64 + c]; if (v > w) s = cv.x * s + cv.y; }
                s = Ae[1][eb] * s + Be[1][eb];
#pragma unroll
                for (int j = 3; j >= 0; --j) { s = ca[1][eb][j] * s + cbv[1][eb][j]; hf[j] += s; }
#pragma unroll
                for (int j = 0; j < 4; ++j) {
                    const int q = 16 * w + 4 * fq + j;
                    const float g = bflo((unsigned)*(const LAS bf16_t*)(lds + SC_GL_OFF + q * 128 + c * 2));
                    const float ge = g * sigmoidf_(1.5957691216f * (g + 0.044715f * g * g * g));
                    *(LAS bf16_t*)(lds + SC_XC_OFF + q * 128 + c * 2) = (bf16_t)(pk2(hf[j] * ge, 0.f) & 0xffffu);
                }
            }
            __syncthreads();
            bf16_t* yb = (bf16_t*)(P.ws + OFF_Y);
#pragma unroll
            for (int i = 0; i < 2; ++i) { const int idx = tid + 512 * i, r = idx >> 3, pc = idx & 7;
                *(u32x4*)(yb + (size_t)(row0 + r) * D + h * 64 + pc * 8) = *(const LAS u32x4*)(lds + SC_XC_OFF + r * 128 + pc * 16); }
        }
    }
}
constexpr int ST_OFF = 0, VT_OFF = 1024;
__device__ __forceinline__ void sgu_item(const Params& P, int l, int tix, int g, LAS unsigned char* lds) {
    const int tid = opaque_tid(), w = __builtin_amdgcn_readfirstlane(tid >> 6), lane = tid & 63, fr = lane & 15, fq = lane >> 4;
    int row0, pos0, L, b; tile_info(tix, row0, pos0, L, b);
    const bf16_t* pb = (const bf16_t*)(P.ws + OFF_HID); bf16_t* yb = (bf16_t*)(P.ws + OFF_Y);
    LAS f32x2* stat = (LAS f32x2*)(lds + ST_OFF);
    __syncthreads();
    if (tid < 128) { const float* vp = (const float*)(P.ws + OFF_VST) + (size_t)(row0 + tid) * 16; float sm = 0.f, sq = 0.f;
#pragma unroll
        for (int i = 0; i < 4; ++i) { const f32x4 t = *(const f32x4*)(vp + 4 * i); sm += t.x + t.z; sq += t.y + t.w; }
        const float mean = sm * (1.0f / 512.0f), var = fmaxf(sq * (1.0f / 512.0f) - mean * mean, 0.f);
        stat[tid] = (f32x2){mean, rsqrtf(var + EPS)}; }
    __syncthreads();
    { const int qp = lane; const f32x2 s0 = stat[2 * qp], s1 = stat[2 * qp + 1];
#pragma unroll
      for (int it = 0; it < 2; ++it) { const int c0 = (w + 8 * it) * 8;
          const u32x4 r0 = *(const u32x4*)(pb + (size_t)(row0 + 2 * qp) * 2048 + 1536 + g * 128 + c0), r1 = *(const u32x4*)(pb + (size_t)(row0 + 2 * qp + 1) * 2048 + 1536 + g * 128 + c0);
          const float* gp = P.in[I_SGN] + l * 512 + g * 128 + c0; const f32x4 g0 = *(const f32x4*)gp, g1 = *(const f32x4*)(gp + 4);
          const float gn[8] = {g0.x, g0.y, g0.z, g0.w, g1.x, g1.y, g1.z, g1.w};
          const unsigned a[4] = {r0.x, r0.y, r0.z, r0.w}, bb[4] = {r1.x, r1.y, r1.z, r1.w};
#pragma unroll
          for (int i = 0; i < 4; ++i) {
              const float e0 = (bflo(a[i]) - s0.x) * s0.y * gn[2 * i], e1 = (bflo(bb[i]) - s1.x) * s1.y * gn[2 * i];
              const float o0 = (bfhi(a[i]) - s0.x) * s0.y * gn[2 * i + 1], o1 = (bfhi(bb[i]) - s1.x) * s1.y * gn[2 * i + 1];
              *(LAS unsigned*)(lds + VT_OFF + (c0 + 2 * i) * 272 + qp * 4) = pk2(e0, e1);
              *(LAS unsigned*)(lds + VT_OFF + (c0 + 2 * i + 1) * 272 + qp * 4) = pk2(o0, o1); } } }
    __syncthreads();
    const bf16_t* sgw = (const bf16_t*)(P.ws + OFF_SGW) + ((size_t)(l * 4 + g) * 128 + 16 * w + fr) * 128;
    bf16x8 bfr[4];
#pragma unroll
    for (int ks = 0; ks < 4; ++ks) bfr[ks] = *(const bf16x8*)(sgw + ks * 32 + fq * 8);
    const float bs = P.in[I_SGB][(l * 4 + g) * 128 + 16 * w + fr];
    const size_t prow = (size_t)(row0 + 16 * w + fr);
#pragma unroll
    for (int cb = 0; cb < 8; ++cb) {
        f32x4 acc = (f32x4){0.f, 0.f, 0.f, 0.f};
#pragma unroll
        for (int ks = 0; ks < 4; ++ks) { const bf16x8 a = *(const LAS bf16x8*)(lds + VT_OFF + (cb * 16 + fr) * 272 + (ks * 32 + fq * 8) * 2);
            acc = __builtin_amdgcn_mfma_f32_16x16x32_bf16(a, bfr[ks], acc, 0, 0, 0); }
        const int cc = g * 128 + cb * 16 + fq * 4;
        const u32x2 uu = *(const u32x2*)(pb + prow * 2048 + 1024 + cc);
        u32x2 o; o.x = pk2(bflo(uu.x) * (acc[0] + bs), bfhi(uu.x) * (acc[1] + bs)); o.y = pk2(bflo(uu.y) * (acc[2] + bs), bfhi(uu.y) * (acc[3] + bs));
        *(u32x2*)(yb + prow * D + 512 + cc) = o;
    }
}


#define XB_TMO      128
#define XB_XCNT(j)  (256  + 64 * (j))
#define XB_XSUB(j)  (1280 + 64 * (j))
#define XB_XGEN(j)  (2304 + 64 * (j))
#define XB_TOP      3328
#define XB_TOPGEN   3392
#define XCD_BAR_WORDS 3456
#define XB_SPIN_CAP (1u << 18)
__device__ __forceinline__ unsigned xb_ld(unsigned* p)              { return __hip_atomic_load(p, __ATOMIC_RELAXED, __HIP_MEMORY_SCOPE_AGENT); }
__device__ __forceinline__ unsigned xb_add(unsigned* p, unsigned v) { return __hip_atomic_fetch_add(p, v, __ATOMIC_RELAXED, __HIP_MEMORY_SCOPE_AGENT); }
__device__ __forceinline__ unsigned xb_xcc_id() { return (unsigned)__builtin_amdgcn_s_getreg((3 << 11) | 20) & 0xFu; }
#define XB_SPIN(cond, bar) do { unsigned _sp = 0; while (cond) { __builtin_amdgcn_s_sleep(1); \
    if ((++_sp & 255u) == 0u) { if (xb_ld(&(bar)[XB_TMO])) break; if (_sp > XB_SPIN_CAP) { atomicAdd(&(bar)[XB_TMO], 1u); break; } } } } while (0)
struct XcdBarrier { unsigned* bar; unsigned x; volatile LAS unsigned* st; };
__device__ __forceinline__ XcdBarrier xcd_barrier_post(unsigned* bar, volatile LAS unsigned* st) {
    XcdBarrier b; b.bar = bar; b.x = xb_xcc_id(); b.st = st;
    if (threadIdx.x == 0) (void)xb_add(&bar[XB_XCNT(b.x)], 1u);
    return b;
}
__device__ __forceinline__ void xcd_barrier_complete(unsigned* bar, unsigned x, unsigned& nloc, unsigned& nx) {
    const unsigned G = gridDim.x * gridDim.y * gridDim.z;
    unsigned sum, cnt, mine, sp = 0u;
    for (;;) {
        sum = 0u; cnt = 0u; mine = 0u;
#pragma unroll
        for (unsigned j = 0; j < 16; ++j) { const unsigned c = xb_ld(&bar[XB_XCNT(j)]); sum += c; cnt += (c > 0u) ? 1u : 0u; mine = (j == x) ? c : mine; }
        if (sum == G) break;
        __builtin_amdgcn_s_sleep(1);
        if ((++sp & 255u) == 0u) { if (xb_ld(&bar[XB_TMO])) break; if (sp > XB_SPIN_CAP) { atomicAdd(&bar[XB_TMO], 1u); break; } }
    }
    nloc = mine > 0u ? mine : 1u; nx = cnt > 0u ? cnt : 1u;
}
__device__ __forceinline__ void xcd_barrier(const XcdBarrier& b) {
    asm volatile("s_waitcnt vmcnt(0)" ::: "memory");
    __syncthreads();
    if (threadIdx.x == 0) {
        unsigned* bar = b.bar;
        __builtin_amdgcn_s_waitcnt(0);
        unsigned nloc = b.st[0], nx = b.st[1];
        if (nloc == 0u) { xcd_barrier_complete(bar, b.x, nloc, nx); b.st[0] = nloc; b.st[1] = nx; }
        const unsigned old = xb_add(&bar[XB_XSUB(b.x)], 1u);
        const unsigned gen = old / nloc;
        if (old + 1u == (gen + 1u) * nloc) {
            __builtin_amdgcn_fence(__ATOMIC_RELEASE, "agent");
            asm volatile("s_waitcnt vmcnt(0)" ::: "memory");
            const unsigned og = xb_add(&bar[XB_TOP], 1u);
            const unsigned tg = og / nx;
            if (og + 1u == (tg + 1u) * nx) xb_add(&bar[XB_TOPGEN], 1u);
            else XB_SPIN(xb_ld(&bar[XB_TOPGEN]) == tg, bar);
            __builtin_amdgcn_fence(__ATOMIC_ACQUIRE, "agent");
            xb_add(&bar[XB_XGEN(b.x)], 1u);
            asm volatile("s_waitcnt vmcnt(0)" ::: "memory");
        } else {
            XB_SPIN(xb_ld(&bar[XB_XGEN(b.x)]) == gen, bar);
            __builtin_amdgcn_fence(__ATOMIC_ACQUIRE, "agent");
            asm volatile("s_waitcnt vmcnt(0)" ::: "memory");
        }
    }
    __syncthreads();
}

__global__ void __launch_bounds__(512) fwd_mega(Params P) {
    extern __shared__ __attribute__((aligned(16))) unsigned char lds_raw[];
    LAS unsigned char* lds = (LAS unsigned char*)lds_raw;
    cg::grid_group grid = cg::this_grid();
    const int G = gridDim.x, c = blockIdx.x, tid = threadIdx.x;
    if (P.ws == nullptr) grid.sync();
    volatile LAS unsigned* xst = (volatile LAS unsigned*)(lds + 131072);
    if (tid == 0) { xst[0] = 0u; xst[1] = 0u; xst[2] = 0u; xst[3] = 0u; }
    __syncthreads();
    const XcdBarrier xb = xcd_barrier_post((unsigned*)(P.ws + OFF_BAR), xst);
    for (int it = c; it < 288; it += G) adaln_item(P, it, lds);
    { const int tw = opaque_tid(), wv = tw >> 6, ln = tw & 63; LAS float* scr = (LAS float*)(lds + 32768 + wv * 8448);
      for (int it = c * 8 + wv; it < 19968; it += G * 8) transpose_item(P, it, scr, ln); }
    { bf16_t* wg = (bf16_t*)(P.ws + OFF_WG);
      for (int i = c * 512 + tid; i < 262144; i += G * 512) { const int d = i & 63, e = (i >> 6) & 63, h = (i >> 12) & 7, gate = (i >> 15) & 1, dir = (i >> 16) & 1, l = i >> 17;
          const float* src = gate ? P.in[I_WI] : P.in[I_WR]; wg[i] = (bf16_t)(pk2(src[((size_t)((l * 2 + dir) * 8 + h) * 64 + d) * 64 + e] * -1.4426950408889634f, 0.f) & 0xffffu); }
      bf16_t* sg = (bf16_t*)(P.ws + OFF_SGW);
      for (int i = c * 512 + tid; i < 131072; i += G * 512) sg[i] = (bf16_t)(pk2(P.in[I_SGW][i], 0.f) & 0xffffu); }
    xcd_barrier(xb);
    for (int it = c; it < 416; it += G) shiftw_item(P, it, lds);
    { const int tw = opaque_tid(), wv = tw >> 6, ln = tw & 63;
      for (int row = c * 8 + wv; row < MT; row += 2 * G * 8) prep_item2(P, row, row + G * 8, row + G * 8 < MT, ln); }
    xcd_barrier(xb);
    bf16_t* AP = (bf16_t*)(P.ws + OFF_AP); bf16_t* YB = (bf16_t*)(P.ws + OFF_Y); bf16_t* HID = (bf16_t*)(P.ws + OFF_HID);
    float* RSQ = (float*)(P.ws + OFF_RSQ); float* VST = (float*)(P.ws + OFF_VST);
    const float* MODV = (const float*)(P.ws + OFF_MODV); const float* SW = (const float*)(P.ws + OFF_SW);
#pragma unroll 1
    for (int ph = 0; ph < 16; ++ph) {
        const int l = ph >> 3, st = ph & 7; const bool lastl = l == 1;
        const unsigned char* WL = P.ws + OFF_W + (size_t)l * LW_TOTAL;
        if (st == 0 || st == 6) {
            EpiSwiglu E; E.rtab = (const LAS float*)(lds + RSTD_OFF); E.vtab = (const LAS float*)(lds + VEC_OFF); E.hid = HID;
            const float* sWp = SW + (size_t)l * 5 * 13312 + (st == 0 ? 0 : 7680);
            pg8::Gemm g{AP, (const bf16_t*)(WL + (st == 0 ? LW_WIN1 : LW_WIN2)), MT, 5632, 1024};
            pg8::Order2 S; S.init(22, (st == 6 && lastl) ? 0 : 22, G, c);
            fill_tabs<1>(lds, S, RSQ, sWp, nullptr);
            pg8::gemm_phase<EpiSwiglu, pg8::Order2>(lds, g, S, E);
        } else if (st == 1 || st == 5 || st == 7) {
            EpiResid E; E.hb = (bf16_t*)(P.ws + OFF_HB);
            const int cg_ = st == 1 ? 2 : (st == 5 ? 5 : 8);
            E.gate = MODV + (size_t)(l * 5) * 9216 + cg_ * 1024;
            E.gsn = st == 1 ? MODV + (size_t)(l * 5) * 9216 + 4 * 1024 : (st == 5 ? MODV + (size_t)(l * 5) * 9216 + 7 * 1024 : (lastl ? (const float*)nullptr : MODV + (size_t)(5) * 9216 + 1 * 1024));
            E.ap = AP; E.rsq = RSQ;
            pg8::Gemm g{st == 5 ? YB : HID, (const bf16_t*)(WL + (st == 1 ? LW_WOUT1 : (st == 5 ? LW_WOUTM : LW_WOUT2))), MT, 1024, st == 5 ? 1024 : 2816};
            const int cpn = (st != 1 && lastl) ? 0 : 4; const int ks = (st != 5 && cpn) ? 11 : 1;
            E.part = (float*)(P.ws + OFF_Y);
            pg8::Order2 S; S.init(4, cpn, G, c, ks);
            E.vtab = (const LAS float*)(lds + VEC_OFF);
            fill_tabs<2>(lds, S, nullptr, E.gate, E.gsn);
            pg8::gemm_phase<EpiResid, pg8::Order2>(lds, g, S, E);
            if (ks > 1) {
                xcd_barrier(xb);
                const int tw = opaque_tid(), wv = tw >> 6, ln = tw & 63;
                for (int r = c * 8 + wv; r < NCTX; r += G * 8) ctx_fix_row(P, r, ln, ks, E.part, E.gate, E.gsn);
            }
        } else if (st == 2) {
            EpiInproj E; E.rtab = (const LAS float*)(lds + RSTD_OFF); E.vtab = (const LAS float*)(lds + VEC_OFF); E.p = HID; E.vst = VST;
            const float* sWp = SW + (size_t)l * 5 * 13312 + 5632;
            pg8::Gemm g{AP, (const bf16_t*)(WL + LW_WINM), MT, 2048, 1024};
            pg8::Order2 S; S.init(8, lastl ? 2 : 8, G, c);
            fill_tabs<3>(lds, S, RSQ, sWp, nullptr);
            pg8::gemm_phase<EpiInproj, pg8::Order2>(lds, g, S, E);
        } else if (st == 3) {
            for (int wgI = c; wgI < 256; wgI += G) scan_group(P, l, wgI, false, true, lds);
            const int nsgu = lastl ? 1024 : 1056;
            for (int it = c; it < nsgu; it += G) sgu_item(P, l, it >> 2, it & 3, lds);
        } else {
            for (int wgI = c; wgI < 256; wgI += G) scan_group(P, l, wgI, true, !lastl, lds);
        }
        xcd_barrier(xb);
    }
    for (int it = c; it < NLAT / 16; it += G) final_item(P, it);
}

extern "C" void kernel_launch(void* const* d_in, const int* in_sizes, int n_in, void* d_out, int out_size, void* d_ws, size_t ws_size, hipStream_t stream) {
    static int grid = 0;
    if (!grid) {
        if (n_in != 26 || ws_size < WS_END + COEF_TAIL_ITEMS * COEF_ITEM) { fprintf(stderr, "kernel_launch: unexpected n_in %d / ws_size %zu (need %zu)\n", n_in, ws_size, (size_t)WS_END); grid = -1; return; }
        int dev = 0, cus = 0, per_cu = 0;
        (void)hipGetDevice(&dev);
        (void)hipDeviceGetAttribute(&cus, hipDeviceAttributeMultiprocessorCount, dev);
        (void)hipFuncSetAttribute((const void*)fwd_mega, hipFuncAttributeMaxDynamicSharedMemorySize, LDS_BYTES);
        (void)hipOccupancyMaxActiveBlocksPerMultiprocessor(&per_cu, (const void*)fwd_mega, 512, LDS_BYTES);
        if (per_cu < 1) { fprintf(stderr, "kernel_launch: occupancy query says %d blocks per CU\n", per_cu); per_cu = 1; }
        grid = cus;
    }
    if (grid < 0) return;
    if (hipMemsetAsync((char*)d_ws + OFF_BAR, 0, BAR_BYTES, stream) != hipSuccess) { fprintf(stderr, "kernel_launch: memset of the barrier words failed\n"); return; }
    Params p{};
    for (int i = 0; i < 26; ++i) p.in[i] = (const float*)d_in[i];
    p.out = (float*)d_out; p.ws = (unsigned char*)d_ws;
    void* args[] = {&p};
    hipError_t e = hipLaunchCooperativeKernel((const void*)fwd_mega, dim3(grid), dim3(512), args, LDS_BYTES, stream);
    if (e != hipSuccess) fprintf(stderr, "cooperative launch failed: %s (grid %d)\n", hipGetErrorString(e), grid);
}
```
